# Optimizing an MI355X kernel written in HIP

```python
import math, functools
import jax, jax.numpy as jnp
from jax import lax
import numpy as np

D_MODEL = 1024
BATCH = 2
SEQ = 8192
DEPTH = 1
DEC_BATCH = 32
DEC_SEQ = 1
PAST_LEN = 8192
PAGE_SIZE = 128

GLA_HEADS = 4
GLA_DK = D_MODEL // 8
GLA_DV = D_MODEL // 4
GLA_GATE_RANK = 16
GLA_TAU = 16.0
GLA_CHUNK = 64
NSA_HEADS = 16
NSA_KV_GROUPS = 4
NSA_GROUP_HEADS = NSA_HEADS // NSA_KV_GROUPS
NSA_DH = D_MODEL // NSA_HEADS
CMP_LEN = 32
CMP_STRIDE = 16
CMP_RATIO = CMP_LEN // CMP_STRIDE
CMP_HIDDEN = 2 * NSA_DH
SLC_BLOCK = 64
SLC_RATIO = SLC_BLOCK // CMP_STRIDE
SLC_TOPK = 16
WINDOW = 512
NSA_QBLK = 128
FORCE_SCORE = 1.0e4
D_FF = 2816
CONV_W = 3
PLE_DIM = 256
EPS = 1e-6

kernel_name = 'hybrid_gla_nsa_convffn_decode_step'


def _in_sizes():
    kv = 2 * NSA_KV_GROUPS * NSA_DH
    return (GLA_HEADS * GLA_DK, GLA_HEADS * GLA_DK, GLA_HEADS * GLA_DV, GLA_HEADS * GLA_DV, GLA_GATE_RANK,
            NSA_HEADS * NSA_DH, kv, kv, kv, NSA_HEADS * 3, 2 * D_MODEL)


def _split_points():
    return [int(v) for v in np.cumsum(_in_sizes())[:-1]]


def rms_norm(x, g):
    xf = x.astype(jnp.float32)
    y = xf * lax.rsqrt(jnp.mean(xf * xf, axis=-1, keepdims=True) + EPS)
    return (y * g.astype(jnp.float32)).astype(x.dtype)


def masked_softmax(s, mask):
    s = jnp.where(mask, s.astype(jnp.float32), -jnp.inf)
    m = jnp.max(s, axis=-1, keepdims=True)
    m = jnp.where(jnp.isfinite(m), m, 0.0)
    e = jnp.exp(s - m)
    d = jnp.sum(e, axis=-1, keepdims=True)
    return e / jnp.where(d > 0, d, 1.0)


def gla_scan(q, k, v, log_a, s0):
    B, L, H, DK = q.shape
    C = math.gcd(L, GLA_CHUNK)
    n = L // C

    def to_chunks(a):
        return a.reshape(B, n, C, H, a.shape[-1]).transpose(1, 0, 3, 2, 4)

    causal = jnp.tril(jnp.ones((C, C), bool))

    def step(S, inp):
        qc, kc, vc, lac = inp
        b = lax.cumsum(lac, axis=2)
        o = jnp.einsum('bhtd,bhde->bhte', qc * jnp.exp(b), S)
        diff = b[:, :, :, None, :] - b[:, :, None, :, :]
        decay = jnp.exp(jnp.where(causal[:, :, None], diff, -jnp.inf))
        A = jnp.einsum('bhtd,bhsd,bhtsd->bhts', qc, kc, decay)
        o = o + jnp.einsum('bhts,bhse->bhte', A, vc)
        b_last = b[:, :, -1:, :]
        S = jnp.exp(b_last[:, :, 0, :])[..., None] * S + jnp.einsum('bhsd,bhse->bhde', kc * jnp.exp(b_last - b), vc)
        return S, o

    S, o = lax.scan(step, s0, (to_chunks(q), to_chunks(k), to_chunks(v), to_chunks(log_a)))
    o = o.transpose(1, 0, 3, 2, 4).reshape(B, L, H, v.shape[-1])
    return o, S


def gla_mixer(gq, gk, gv, gr, ga, s0, w_gate_up, b_gate, g_norm, w_o):
    B, L, _ = gq.shape
    f32 = jnp.float32
    q = gq.astype(f32).reshape(B, L, GLA_HEADS, GLA_DK) * (GLA_DK ** -0.5)
    k = gk.astype(f32).reshape(B, L, GLA_HEADS, GLA_DK)
    v = gv.astype(f32).reshape(B, L, GLA_HEADS, GLA_DV)
    log_a = jax.nn.log_sigmoid((ga @ w_gate_up + b_gate).astype(f32)).reshape(B, L, GLA_HEADS, GLA_DK) / GLA_TAU
    o, S = gla_scan(q, k, v, log_a, s0.astype(f32))
    o = o * lax.rsqrt(jnp.mean(o * o, axis=-1, keepdims=True) + EPS) * g_norm.astype(f32).reshape(GLA_HEADS, GLA_DV)
    o = o.reshape(B, L, GLA_HEADS * GLA_DV).astype(gq.dtype) * jax.nn.silu(gr)
    return o @ w_o, S


def compress(kv, w1, b1, w2, b2, pe):
    B, L = kv.shape[:2]
    n_chunk = L // CMP_STRIDE
    n_cmp = n_chunk - CMP_RATIO + 1
    chunks = kv[:, :n_chunk * CMP_STRIDE].reshape(B, n_chunk, CMP_STRIDE, NSA_KV_GROUPS, 2, NSA_DH)
    blocks = jnp.concatenate([chunks[:, j:j + n_cmp] for j in range(CMP_RATIO)], axis=2)
    blocks = blocks + pe[:, None]
    flat = blocks.transpose(0, 1, 3, 4, 2, 5).reshape(B, n_cmp, NSA_KV_GROUPS, 2, CMP_LEN * NSA_DH)
    hid = jax.nn.gelu(jnp.einsum('bngcf,cfh->bngch', flat, w1) + b1)
    return jnp.einsum('bngch,chd->bngcd', hid, w2) + b2


def block_importance(imp, n_slc):
    n_cmp = imp.shape[-1]
    left = CMP_RATIO - 1
    right = max(SLC_RATIO * (n_slc + 1) - left - n_cmp, 0)
    padded = jnp.pad(imp, [(0, 0)] * (imp.ndim - 1) + [(left, right)])
    terms = [padded[..., m - n + left: m - n + left + SLC_RATIO * n_slc: SLC_RATIO]
             for m in range(SLC_RATIO) for n in range(CMP_RATIO)]
    return sum(terms[1:], terms[0])


def nsa_core(q, t, kvc, slc_gather, n_slc, kvw, pos_w, gate):
    dt = q.dtype
    n_cmp = kvc.shape[1]
    s_c = jnp.einsum('bqgrd,bngd->bgrqn', q, kvc[..., 0, :])
    c_mask = (jnp.arange(n_cmp) * CMP_STRIDE + CMP_LEN - 1)[None, :] <= t[:, None]
    p_c = masked_softmax(s_c, c_mask)
    o_c = jnp.einsum('bgrqn,bngd->bqgrd', p_c.astype(dt), kvc[..., 1, :])
    imp = block_importance(p_c.sum(axis=2), n_slc)
    blk = jnp.arange(n_slc)[None, :]
    cur = (t // SLC_BLOCK)[:, None]
    forced = (blk == 0) | (blk == cur) | (blk == cur - 1)
    score = jnp.where(blk <= cur, jnp.where(forced, FORCE_SCORE, imp), -jnp.inf)
    top_val, top_idx = lax.top_k(score, min(SLC_TOPK, n_slc))
    tok = (top_idx[..., None] * SLC_BLOCK + jnp.arange(SLC_BLOCK)).reshape(top_idx.shape[:3] + (-1,))
    s_mask = (tok <= t[None, None, :, None]) & jnp.repeat(jnp.isfinite(top_val), SLC_BLOCK, axis=-1)
    kv_s = slc_gather(tok)
    s_s = jnp.einsum('bqgrd,bgqnd->bgrqn', q, kv_s[..., 0, :])
    p_s = masked_softmax(s_s, s_mask[:, :, None])
    o_s = jnp.einsum('bgrqn,bgqnd->bqgrd', p_s.astype(dt), kv_s[..., 1, :])
    s_w = jnp.einsum('bqgrd,bwgd->bgrqw', q, kvw[..., 0, :])
    pw = pos_w[None, :]
    w_mask = (pw <= t[:, None]) & (pw > t[:, None] - WINDOW) & (pw >= 0)
    p_w = masked_softmax(s_w, w_mask)
    o_w = jnp.einsum('bgrqw,bwgd->bqgrd', p_w.astype(dt), kvw[..., 1, :])
    g = jax.nn.sigmoid(gate.astype(jnp.float32)).astype(dt)
    return g[..., 0:1] * o_c + g[..., 1:2] * o_s + g[..., 2:3] * o_w


def nsa_prompt(q, kv_cmp, kv_slc, kv_win, gate, cmp_params):
    B, L = q.shape[:2]
    kvc = compress(kv_cmp, *cmp_params)
    n_slc = -(-L // SLC_BLOCK)
    kvw_pad = jnp.pad(kv_win, ((0, 0), (WINDOW, 0), (0, 0), (0, 0), (0, 0)))
    b_idx = jnp.arange(B)[:, None, None, None]
    g_idx = jnp.arange(NSA_KV_GROUPS)[None, :, None, None]

    def slc_gather(tok):
        return kv_slc[b_idx, jnp.minimum(tok, L - 1), g_idx]

    def block(bi):
        start = bi * NSA_QBLK
        qb = lax.dynamic_slice_in_dim(q, start, NSA_QBLK, axis=1)
        gb = lax.dynamic_slice_in_dim(gate, start, NSA_QBLK, axis=1)
        kvw = lax.dynamic_slice_in_dim(kvw_pad, start, WINDOW + NSA_QBLK, axis=1)
        t = start + jnp.arange(NSA_QBLK)
        pos_w = start - WINDOW + jnp.arange(WINDOW + NSA_QBLK)
        return nsa_core(qb, t, kvc, slc_gather, n_slc, kvw, pos_w, gb)

    o = lax.map(block, jnp.arange(L // NSA_QBLK))
    o = jnp.moveaxis(o, 0, 1).reshape(B, L, NSA_HEADS * NSA_DH)
    return o, (kv_cmp, kv_slc, kv_win[:, L - min(WINDOW, L):])


def nsa_sample(q, kv_cmp, kv_slc, kv_win, gate, cache_cmp, cache_slc, cache_win, page_table, cmp_params):
    B, S = q.shape[:2]
    past = page_table.shape[1] * PAGE_SIZE
    dt = q.dtype
    past_cmp = cache_cmp[page_table].reshape(B, past, NSA_KV_GROUPS, 2, NSA_DH).astype(dt)
    kvc = compress(jnp.concatenate([past_cmp, kv_cmp], axis=1), *cmp_params)
    n_slc = -(-(past + S) // SLC_BLOCK)
    b_idx = jnp.arange(B)[:, None, None, None]
    g_idx = jnp.arange(NSA_KV_GROUPS)[None, :, None, None]

    def slc_gather(tok):
        tp = jnp.minimum(tok, past - 1)
        page = page_table[b_idx, tp // PAGE_SIZE]
        from_pool = cache_slc[page, tp % PAGE_SIZE, g_idx].astype(dt)
        from_new = kv_slc[b_idx, jnp.clip(tok - past, 0, S - 1), g_idx]
        return jnp.where((tok < past)[..., None, None], from_pool, from_new)

    win = cache_win.shape[1]
    kvw = jnp.concatenate([cache_win.astype(dt), kv_win], axis=1)
    pos_w = past - win + jnp.arange(win + S)
    t = past + jnp.arange(S)
    o = nsa_core(q, t, kvc, slc_gather, n_slc, kvw, pos_w, gate)
    return o.reshape(B, S, NSA_HEADS * NSA_DH), (kv_cmp, kv_slc, kv_win)


def conv_ffn(h, conv0, w_up, conv_w, conv_b, w_down):
    L = h.shape[1]
    a, b = jnp.split(h @ w_up, 2, axis=-1)
    a_ext = jnp.concatenate([conv0.astype(a.dtype), a], axis=1)
    taps = [a_ext[:, j:j + L] * conv_w[j] for j in range(CONV_W)]
    c = sum(taps[1:], taps[0]) + conv_b
    y = (jax.nn.gelu(c) * b) @ w_down
    return y, a_ext[:, L:]


def layer(x, p, nsa_fn, gla_s0, conv0, w):
    B, L, _ = x.shape
    h = rms_norm(x, w['g_mix_pre'])
    gq, gk, gv, gr, ga, nq, nkc, nks, nkw, ng, mg = jnp.split(h @ w['w_in'], _split_points(), axis=-1)
    y_gla, gla_state = gla_mixer(gq, gk, gv, gr, ga, gla_s0, w['w_gla_gate_up'], w['b_gla_gate'],
                                 w['g_gla_norm'], w['w_gla_out'])
    kv_shape = (B, L, NSA_KV_GROUPS, 2, NSA_DH)
    q = nq.reshape(B, L, NSA_KV_GROUPS, NSA_GROUP_HEADS, NSA_DH) * (NSA_DH ** -0.5)
    gate = ng.reshape(B, L, NSA_KV_GROUPS, NSA_GROUP_HEADS, 3)
    o, nsa_rows = nsa_fn(q, nkc.reshape(kv_shape), nks.reshape(kv_shape), nkw.reshape(kv_shape), gate)
    y_nsa = o @ w['w_nsa_out']
    m_gla, m_nsa = jnp.split(mg, 2, axis=-1)
    mix = jax.nn.sigmoid(m_gla) * y_gla.astype(x.dtype) + jax.nn.sigmoid(m_nsa) * y_nsa
    x = x + rms_norm(mix @ w['w_out'], w['g_mix_post'])
    f, conv_state = conv_ffn(rms_norm(x, w['g_ffn_pre']), conv0, w['w_ffn_up'], w['conv_ffn_w'],
                             w['b_conv_ffn'], w['w_ffn_down'])
    x = x + rms_norm(f, w['g_ffn_post'])
    x = x + jax.nn.sigmoid(rms_norm(x, w['g_ple']) @ w['w_ple_gate']) * (p @ w['w_ple_proj'])
    return x, (nsa_rows[0], nsa_rows[1], nsa_rows[2], gla_state, conv_state)


def setup_inputs(seed: int = 0) -> dict:
    key = jax.random.key(seed)
    ks = iter(jax.random.split(key, 48))

    def nrm(shape, scale):
        return jax.random.normal(next(ks), shape, jnp.float32) * scale

    def gain(shape):
        return 1.0 + nrm(shape, 0.05)

    n_pages = PAST_LEN // PAGE_SIZE
    n_used = DEC_BATCH * n_pages
    n_pool = n_used + n_used // 4
    win_buf = min(WINDOW, PAST_LEN)
    page_table = jax.random.permutation(next(ks), n_pool)[:n_used].reshape(DEC_BATCH, n_pages).astype(jnp.int32)
    in_cols = sum(_in_sizes())
    G, DH = NSA_KV_GROUPS, NSA_DH
    return {
        'x_prompt': nrm((BATCH, SEQ, D_MODEL), 1.0),
        'x_sample': nrm((DEC_BATCH, DEC_SEQ, D_MODEL), 1.0),
        'cache_cmp_kv': nrm((DEPTH, n_pool, PAGE_SIZE, G, 2, DH), 1.0),
        'cache_slc_kv': nrm((DEPTH, n_pool, PAGE_SIZE, G, 2, DH), 1.0),
        'cache_win_kv': nrm((DEPTH, DEC_BATCH, win_buf, G, 2, DH), 1.0),
        'state_gla': nrm((DEPTH, DEC_BATCH, GLA_HEADS, GLA_DK, GLA_DV), 0.5),
        'state_ffn_conv': nrm((DEPTH, DEC_BATCH, CONV_W - 1, D_FF), 1.0),
        'page_table': page_table,
        'p_prompt': nrm((DEPTH, BATCH, SEQ, PLE_DIM), 1.0),
        'p_sample': nrm((DEPTH, DEC_BATCH, DEC_SEQ, PLE_DIM), 1.0),
        'g_mix_pre': gain((DEPTH, D_MODEL)),
        'g_mix_post': gain((DEPTH, D_MODEL)),
        'g_ffn_pre': gain((DEPTH, D_MODEL)),
        'g_ffn_post': gain((DEPTH, D_MODEL)),
        'g_ple': gain((DEPTH, D_MODEL)),
        'w_in': nrm((DEPTH, D_MODEL, in_cols), D_MODEL ** -0.5),
        'w_gla_gate_up': nrm((DEPTH, GLA_GATE_RANK, GLA_HEADS * GLA_DK), GLA_GATE_RANK ** -0.5),
        'b_gla_gate': nrm((DEPTH, GLA_HEADS * GLA_DK), 0.1),
        'g_gla_norm': gain((DEPTH, GLA_HEADS * GLA_DV)),
        'w_gla_out': nrm((DEPTH, GLA_HEADS * GLA_DV, D_MODEL), (GLA_HEADS * GLA_DV) ** -0.5),
        'w_cmp1': nrm((DEPTH, 2, CMP_LEN * DH, CMP_HIDDEN), (CMP_LEN * DH) ** -0.5),
        'b_cmp1': nrm((DEPTH, 2, CMP_HIDDEN), 0.02),
        'w_cmp2': nrm((DEPTH, 2, CMP_HIDDEN, DH), CMP_HIDDEN ** -0.5),
        'b_cmp2': nrm((DEPTH, 2, DH), 0.02),
        'pe_cmp': nrm((DEPTH, CMP_LEN, 2, DH), 0.1),
        'w_nsa_out': nrm((DEPTH, NSA_HEADS * DH, D_MODEL), (NSA_HEADS * DH) ** -0.5),
        'w_out': nrm((DEPTH, D_MODEL, D_MODEL), D_MODEL ** -0.5),
        'w_ffn_up': nrm((DEPTH, D_MODEL, 2 * D_FF), D_MODEL ** -0.5),
        'conv_ffn_w': nrm((DEPTH, CONV_W, D_FF), CONV_W ** -0.5),
        'b_conv_ffn': nrm((DEPTH, D_FF), 0.02),
        'w_ffn_down': nrm((DEPTH, D_FF, D_MODEL), D_FF ** -0.5),
        'w_ple_proj': nrm((DEPTH, PLE_DIM, D_MODEL), PLE_DIM ** -0.5),
        'w_ple_gate': nrm((DEPTH, D_MODEL, D_MODEL), D_MODEL ** -0.5),
    }


def reference(x_prompt, x_sample, cache_cmp_kv, cache_slc_kv, cache_win_kv, state_gla, state_ffn_conv,
              page_table, p_prompt, p_sample, g_mix_pre, g_mix_post, g_ffn_pre, g_ffn_post, g_ple, w_in,
              w_gla_gate_up, b_gla_gate, g_gla_norm, w_gla_out, w_cmp1, b_cmp1, w_cmp2, b_cmp2, pe_cmp,
              w_nsa_out, w_out, w_ffn_up, conv_ffn_w, b_conv_ffn, w_ffn_down, w_ple_proj, w_ple_gate):
    yp, ys = x_prompt, x_sample
    Bp, Bs = x_prompt.shape[0], x_sample.shape[0]
    cmp_p, cmp_s, slc_p, slc_s, win_p, win_s, gla_p, gla_s, conv_p, conv_s = ([] for _ in range(10))
    for i in range(DEPTH):
        w = dict(g_mix_pre=g_mix_pre[i], g_mix_post=g_mix_post[i], g_ffn_pre=g_ffn_pre[i],
                 g_ffn_post=g_ffn_post[i], g_ple=g_ple[i], w_in=w_in[i], w_gla_gate_up=w_gla_gate_up[i],
                 b_gla_gate=b_gla_gate[i], g_gla_norm=g_gla_norm[i], w_gla_out=w_gla_out[i],
                 w_nsa_out=w_nsa_out[i], w_out=w_out[i], w_ffn_up=w_ffn_up[i], conv_ffn_w=conv_ffn_w[i],
                 b_conv_ffn=b_conv_ffn[i], w_ffn_down=w_ffn_down[i], w_ple_proj=w_ple_proj[i],
                 w_ple_gate=w_ple_gate[i])
        cmp_params = (w_cmp1[i], b_cmp1[i], w_cmp2[i], b_cmp2[i], pe_cmp[i])
        prompt_nsa = functools.partial(nsa_prompt, cmp_params=cmp_params)
        gla0 = jnp.zeros((Bp, GLA_HEADS, GLA_DK, GLA_DV), jnp.float32)
        conv0 = jnp.zeros((Bp, CONV_W - 1, D_FF), x_prompt.dtype)
        yp, ep = layer(yp, p_prompt[i], prompt_nsa, gla0, conv0, w)
        sample_nsa = functools.partial(nsa_sample, cache_cmp=cache_cmp_kv[i], cache_slc=cache_slc_kv[i],
                                       cache_win=cache_win_kv[i], page_table=page_table, cmp_params=cmp_params)
        ys, es = layer(ys, p_sample[i], sample_nsa, state_gla[i], state_ffn_conv[i], w)
        cmp_p.append(ep[0]); slc_p.append(ep[1]); win_p.append(ep[2]); gla_p.append(ep[3]); conv_p.append(ep[4])
        cmp_s.append(es[0]); slc_s.append(es[1]); win_s.append(es[2]); gla_s.append(es[3]); conv_s.append(es[4])
    return (yp, ys, jnp.stack(cmp_p), jnp.stack(cmp_s), jnp.stack(slc_p), jnp.stack(slc_s),
            jnp.stack(win_p), jnp.stack(win_s), jnp.stack(gla_p), jnp.stack(gla_s),
            jnp.stack(conv_p), jnp.stack(conv_s))
```

```cpp
#include <hip/hip_runtime.h>
#include <hip/hip_bf16.h>
#include <cstdio>
#include <cstdint>
#define MK_ONE_LAUNCH 1
namespace pg8 {
#define PG8_LAS __attribute__((address_space(3)))
typedef unsigned short bf16_t;
typedef short bf16x8 __attribute__((ext_vector_type(8)));
typedef float f32x4 __attribute__((ext_vector_type(4)));
typedef unsigned u32x4 __attribute__((ext_vector_type(4)));
constexpr int BM = 256, BK = 64, HALF = 128, HTB = HALF * BK * 2  , STAGE_BYTES = 8 * HTB, NXCD = 8, WGM = 8;

__host__ __device__ __forceinline__ int lds_byte(int r, int c) { const int st = (r >> 4) * 2 + (c >> 5), rr = r & 15, cc = c & 31, ob = rr * 64 + cc * 2; return st * 1024 + (ob ^ (((ob >> 9) & 1) << 5)); }
__host__ __device__ __forceinline__ void stage_rc(int b, int& R, int& C) { const int st = b / 1024, sb = b % 1024, swz = sb ^ (((sb >> 9) & 1) << 5); R = (st >> 1) * 16 + swz / 64; C = (st & 1) * 32 + (swz % 64) / 2; }
__host__ __device__ __forceinline__ int perm32(int rho) { const int n = rho >> 4, i = rho & 15; return 8 * (i >> 2) + 4 * n + (i & 3); }

struct Unit { int pm, pn; };
struct Gemm { const bf16_t* A; const bf16_t* Bt; int M, N, K; };

struct StaticOrder {
    int nM, nN, nwg, G, c;
    __host__ __device__ void init(int M, int N, int G_, int c_) { nM = M / BM; nN = N / BM; nwg = nM * nN; G = G_; c = c_; }
    __host__ __device__ bool next(int i, Unit& u) const {
        const long L = (long)i * G + c; if (L >= nwg) return false;
        int wgid = (int)L; { const int q = nwg / NXCD, r = nwg % NXCD, xcd = wgid % NXCD, off = wgid / NXCD; wgid = (xcd < r ? xcd * (q + 1) : r * (q + 1) + (xcd - r) * q) + off; }
        const int nig = WGM * nN, gid = wgid / nig, fm = gid * WGM, gsz = (nM - fm) < WGM ? (nM - fm) : WGM;
        u.pm = fm + ((wgid % nig) % gsz); u.pn = (wgid % nig) / gsz; return true;
    }
    __device__ __forceinline__ void a_ready(const Unit&) const {}
    __device__ __forceinline__ void done(const Unit&) const {}
};

__device__ __forceinline__ unsigned cvt_pk_bf16(float lo, float hi) { unsigned r; asm volatile("v_cvt_pk_bf16_f32 %0, %1, %2" : "=v"(r) : "v"(lo), "v"(hi)); return r; }
typedef float f32x2 __attribute__((ext_vector_type(2)));
template <class Epi, class Sched, bool ALIGN_EPI = false, bool SP2 = false>
__device__ __forceinline__ void gemm_phase(PG8_LAS unsigned char* lds, const Gemm g, const Sched& S, const Epi& E) {
    const int tid = threadIdx.x, wid = __builtin_amdgcn_readfirstlane(tid >> 6), lane = tid & 63, wr = wid >> 2, wc = wid & 3, fr = lane & 15, fq = lane >> 4;
    const int K = g.K, nt = K / BK;
    unsigned voffA[2], voffB[2];
#pragma unroll
    for (int i = 0; i < 2; ++i) { int R, C; stage_rc(tid * 16 + i * 8192, R, C); const int Rb = Epi::PERM ? ((R & ~31) + perm32(R & 31)) : R;
        voffA[i] = (unsigned)(R * K + C) * 2u; voffB[i] = (unsigned)(Rb * K + C) * 2u; }
    const size_t kstep = (size_t)(BK * 2);
    const size_t hstep = (size_t)HALF * K * 2;
    const size_t tstep = 2 * hstep;
    const unsigned ldsw = (unsigned)wid * 1024u;
    const int aoff = lds_byte(wr * 64 + fr, fq * 8), boff = lds_byte(wc * 32 + fr, fq * 8);
#define PG8_SA(b, h) (((b) * 2 + (h)) * HTB)
#define PG8_SB(b, h) ((4 + (b) * 2 + (h)) * HTB)
#define PG8_STAGE(bufoff, gbase, voff) do { _Pragma("unroll") for (int _i = 0; _i < 2; ++_i) \
        __builtin_amdgcn_global_load_lds((const unsigned*)((const char*)(gbase) + (voff)[_i]), (PG8_LAS unsigned*)(lds + (bufoff) + ldsw + _i * 8192), 16, 0, 0); } while (0)
#define PG8_LDA(dst, b, h) do { _Pragma("unroll") for (int m = 0; m < 4; ++m) _Pragma("unroll") for (int k = 0; k < 2; ++k) dst[m][k] = *(const PG8_LAS bf16x8*)(lds + PG8_SA(b, h) + aoff + m * 2048 + k * 1024); } while (0)
#define PG8_LDB(dst, b, h) do { _Pragma("unroll") for (int n = 0; n < 2; ++n) _Pragma("unroll") for (int k = 0; k < 2; ++k) dst[n][k] = *(const PG8_LAS bf16x8*)(lds + PG8_SB(b, h) + boff + n * 2048 + k * 1024); } while (0)
#define PG8_MMA(ai, bj, At, Bt) do { __builtin_amdgcn_s_setprio(1); _Pragma("unroll") for (int m = 0; m < 4; ++m) _Pragma("unroll") for (int n = 0; n < 2; ++n) _Pragma("unroll") for (int k = 0; k < 2; ++k) \
        acc[ai][bj][m][n] = __builtin_amdgcn_mfma_f32_16x16x32_bf16(Bt[n][k], At[m][k], acc[ai][bj][m][n], 0, 0, 0); __builtin_amdgcn_s_setprio(0); } while (0)
#define PG8_WAIT_V(n) asm volatile("s_waitcnt vmcnt(" #n ")" ::: "memory")
#define PG8_WAIT_L(n) asm volatile("s_waitcnt lgkmcnt(" #n ")" ::: "memory")
#define PG8_BAR __builtin_amdgcn_s_barrier()
#define PG8_SCHED __builtin_amdgcn_sched_barrier(0)
    Unit cur, nxt; int ui = 0;
    if (!S.next(0, cur)) return;
    f32x4 acc[2][2][4][2];
#pragma unroll
    for (int a = 0; a < 2; ++a)
#pragma unroll
        for (int b = 0; b < 2; ++b)
#pragma unroll
            for (int m = 0; m < 4; ++m)
#pragma unroll
                for (int n = 0; n < 2; ++n) acc[a][b][m][n] = (f32x4){0.f, 0.f, 0.f, 0.f};
    bf16x8 At[4][2], B0[2][2], B1[2][2];
    const char* cA = (const char*)g.A + (size_t)cur.pm * tstep; const char* cB = (const char*)g.Bt + (size_t)cur.pn * tstep;
    S.a_ready(cur);
    if constexpr (SP2) {
        PG8_STAGE(PG8_SB(0, 0), cB, voffB); PG8_STAGE(PG8_SB(0, 1), cB + hstep, voffB); PG8_STAGE(PG8_SA(0, 0), cA, voffA); PG8_STAGE(PG8_SA(0, 1), cA + hstep, voffA);
        if (wr == 1) PG8_BAR;
        PG8_WAIT_V(2); PG8_BAR;
        PG8_STAGE(PG8_SB(1, 0), cB + kstep, voffB); PG8_STAGE(PG8_SA(1, 0), cA + kstep, voffA); PG8_STAGE(PG8_SB(1, 1), cB + hstep + kstep, voffB);
        PG8_WAIT_V(6); PG8_BAR;
    } else {
        PG8_STAGE(PG8_SB(0, 0), cB, voffB); PG8_STAGE(PG8_SA(0, 0), cA, voffA); PG8_STAGE(PG8_SB(0, 1), cB + hstep, voffB); PG8_STAGE(PG8_SA(0, 1), cA + hstep, voffA);
        if (wr == 1) PG8_BAR;
        PG8_WAIT_V(4); PG8_BAR;
        PG8_STAGE(PG8_SB(1, 0), cB + kstep, voffB); PG8_STAGE(PG8_SA(1, 0), cA + kstep, voffA); PG8_STAGE(PG8_SB(1, 1), cB + hstep + kstep, voffB);
        PG8_WAIT_V(6); PG8_BAR;
    }
    for (;;) {
        const bool has_next = S.next(ui + 1, nxt);
        const char* nA = has_next ? (const char*)g.A + (size_t)nxt.pm * tstep : cA; const char* nB = has_next ? (const char*)g.Bt + (size_t)nxt.pn * tstep : cB;
        for (int t = 0; t < nt; t += 2) {
            const bool last = (t == nt - 2);
            const char* a1 = cA + (size_t)(t + 1) * kstep;
            const char* a2 = last ? nA : cA + (size_t)(t + 2) * kstep; const char* b2 = last ? nB : cB + (size_t)(t + 2) * kstep;
            const char* a3 = a2 + kstep; const char* b3 = b2 + kstep;
            if (last && has_next) S.a_ready(nxt);
            if constexpr (SP2) {
            PG8_LDB(B0, 0, 0); PG8_LDB(B1, 0, 1); PG8_SCHED; PG8_LDA(At, 0, 0); PG8_STAGE(PG8_SA(1, 1), a1 + hstep, voffA);
            PG8_WAIT_V(8); PG8_WAIT_L(0); PG8_BAR; PG8_MMA(0, 0, At, B0); PG8_MMA(0, 1, At, B1); PG8_BAR; PG8_SCHED;
            PG8_LDA(At, 0, 1); PG8_STAGE(PG8_SB(0, 0), b2, voffB); PG8_STAGE(PG8_SB(0, 1), b2 + hstep, voffB); PG8_STAGE(PG8_SA(0, 0), a2, voffA);
            PG8_WAIT_V(8); PG8_WAIT_L(0); PG8_BAR; PG8_MMA(1, 0, At, B0); PG8_MMA(1, 1, At, B1); PG8_BAR; PG8_SCHED;
            PG8_LDB(B0, 1, 0); PG8_LDB(B1, 1, 1); PG8_SCHED; PG8_LDA(At, 1, 0); PG8_STAGE(PG8_SA(0, 1), a2 + hstep, voffA);
            PG8_WAIT_V(8); PG8_WAIT_L(0); PG8_BAR; PG8_MMA(0, 0, At, B0); PG8_MMA(0, 1, At, B1); PG8_BAR; PG8_SCHED;
            PG8_LDA(At, 1, 1); PG8_STAGE(PG8_SB(1, 0), b3, voffB); PG8_STAGE(PG8_SB(1, 1), b3 + hstep, voffB); PG8_STAGE(PG8_SA(1, 0), a3, voffA);
            PG8_WAIT_V(8); PG8_WAIT_L(0); PG8_BAR; PG8_MMA(1, 0, At, B0); PG8_MMA(1, 1, At, B1); PG8_BAR; PG8_SCHED;
            } else {
            PG8_LDB(B0, 0, 0); PG8_SCHED; PG8_LDA(At, 0, 0); PG8_STAGE(PG8_SA(1, 1), a1 + hstep, voffA);
            PG8_WAIT_L(8); PG8_BAR; PG8_WAIT_L(0); PG8_MMA(0, 0, At, B0); PG8_BAR; PG8_SCHED;
            PG8_LDB(B1, 0, 1); PG8_STAGE(PG8_SB(0, 0), b2, voffB);
            PG8_BAR; PG8_WAIT_L(0); PG8_MMA(0, 1, At, B1); PG8_BAR;
            PG8_LDA(At, 0, 1); PG8_STAGE(PG8_SA(0, 0), a2, voffA);
            PG8_BAR; PG8_WAIT_L(0); PG8_MMA(1, 0, At, B0); PG8_BAR; PG8_SCHED;
            PG8_STAGE(PG8_SB(0, 1), b2 + hstep, voffB);
            PG8_WAIT_V(6); PG8_BAR; PG8_MMA(1, 1, At, B1); PG8_BAR;
            PG8_LDB(B0, 1, 0); PG8_SCHED; PG8_LDA(At, 1, 0); PG8_STAGE(PG8_SA(0, 1), a2 + hstep, voffA);
            PG8_WAIT_L(8); PG8_BAR; PG8_WAIT_L(0); PG8_MMA(0, 0, At, B0); PG8_BAR; PG8_SCHED;
            PG8_LDB(B1, 1, 1); PG8_STAGE(PG8_SB(1, 0), b3, voffB);
            PG8_BAR; PG8_WAIT_L(0); PG8_MMA(0, 1, At, B1); PG8_BAR;
            PG8_LDA(At, 1, 1); PG8_STAGE(PG8_SA(1, 0), a3, voffA);
            PG8_BAR; PG8_WAIT_L(0); PG8_MMA(1, 0, At, B0); PG8_BAR; PG8_SCHED;
            PG8_STAGE(PG8_SB(1, 1), b3 + hstep, voffB);
            PG8_WAIT_V(6); PG8_BAR; PG8_MMA(1, 1, At, B1); PG8_BAR;
            }
        }
        if constexpr (ALIGN_EPI) { if (wr == 0) PG8_BAR; }
        if constexpr (!Epi::AFTER_DRAIN) { E(acc, cur, wr, wc, fr, fq); S.done(cur); }
        if (!has_next) break;
#pragma unroll
        for (int a = 0; a < 2; ++a)
#pragma unroll
            for (int b = 0; b < 2; ++b)
#pragma unroll
                for (int m = 0; m < 4; ++m)
#pragma unroll
                    for (int n = 0; n < 2; ++n) acc[a][b][m][n] = (f32x4){0.f, 0.f, 0.f, 0.f};
        cur = nxt; cA = nA; cB = nB; ++ui;
        if constexpr (ALIGN_EPI) { if (wr == 1) PG8_BAR; }
    }
    PG8_WAIT_V(0);
    if constexpr (!ALIGN_EPI) { if (wr == 0) PG8_BAR; }
    PG8_BAR;
    if constexpr (Epi::AFTER_DRAIN) { E.fused(acc, cur, wr, wc, fr, fq, lds, wid, lane); S.done(cur); }
#undef PG8_SA
#undef PG8_SB
#undef PG8_STAGE
#undef PG8_LDA
#undef PG8_LDB
#undef PG8_MMA
#undef PG8_WAIT_V
#undef PG8_WAIT_L
#undef PG8_BAR
#undef PG8_SCHED
}
}
#define GAS __attribute__((address_space(1)))
#define LAS __attribute__((address_space(3)))
typedef unsigned short bf16;
typedef unsigned v4u __attribute__((ext_vector_type(4)));
typedef float f32x4 __attribute__((ext_vector_type(4)));
typedef short bf16x8 __attribute__((ext_vector_type(8)));
typedef GAS unsigned gu32;
typedef GAS unsigned long long gu64;
#define RLX_AGENT __ATOMIC_RELAXED, __HIP_MEMORY_SCOPE_AGENT
#define LDS_WAIT() asm volatile("s_waitcnt lgkmcnt(0)" ::: "memory")
#define VM_WAIT() asm volatile("s_waitcnt vmcnt(0)" ::: "memory")
__device__ __forceinline__ unsigned long long rt() { return __builtin_amdgcn_s_memrealtime(); }
__device__ __forceinline__ unsigned f2bf(float f) { unsigned u = __builtin_bit_cast(unsigned, f); return (u + 0x7fffu + ((u >> 16) & 1u)) >> 16; }
__device__ __forceinline__ unsigned pk2(float lo, float hi) { return f2bf(lo) | (f2bf(hi) << 16); }

#define XB_TMO      128
#define XB_XCNT(j)  (256  + 64 * (j))
#define XB_XSUB(j)  (1280 + 64 * (j))
#define XB_XGEN(j)  (2304 + 64 * (j))
#define XB_TOP      3328
#define XB_TOPGEN   3392
#define XCD_BAR_WORDS 3456
#define XB_SPIN_CAP (1u << 18)

__device__ __forceinline__ unsigned xb_ld(unsigned* p)              { return __hip_atomic_load(p, __ATOMIC_RELAXED, __HIP_MEMORY_SCOPE_AGENT); }
__device__ __forceinline__ unsigned xb_add(unsigned* p, unsigned v) { return __hip_atomic_fetch_add(p, v, __ATOMIC_RELAXED, __HIP_MEMORY_SCOPE_AGENT); }
__device__ __forceinline__ unsigned xb_xcc_id() { return (unsigned)__builtin_amdgcn_s_getreg((3 << 11) | 20) & 0xFu; }
#define XB_SPIN(cond, bar) do { unsigned _sp = 0; while (cond) { __builtin_amdgcn_s_sleep(1); \
    if ((++_sp & 255u) == 0u) { if (xb_ld(&(bar)[XB_TMO])) break; if (_sp > XB_SPIN_CAP) { atomicAdd(&(bar)[XB_TMO], 1u); break; } } } } while (0)

struct XcdBarrier {
    unsigned* bar; unsigned x;
    volatile LAS unsigned* st;
};

__device__ __forceinline__ XcdBarrier xcd_barrier_post(unsigned* bar, volatile LAS unsigned* st) {
    XcdBarrier b; b.bar = bar; b.x = xb_xcc_id(); b.st = st;
    if (threadIdx.x == 0) (void)xb_add(&bar[XB_XCNT(b.x)], 1u);
    return b;
}
__device__ __forceinline__ void xcd_barrier_complete(unsigned* bar, unsigned x, unsigned& nloc, unsigned& nx) {
    const unsigned G = gridDim.x * gridDim.y * gridDim.z;
    unsigned sum, cnt, mine, sp = 0u;
    for (;;) {
        sum = 0u; cnt = 0u; mine = 0u;
#pragma unroll
        for (unsigned j = 0; j < 16; ++j) { const unsigned c = xb_ld(&bar[XB_XCNT(j)]); sum += c; cnt += (c > 0u) ? 1u : 0u; mine = (j == x) ? c : mine; }
        if (sum == G) break;
        __builtin_amdgcn_s_sleep(1);
        if ((++sp & 255u) == 0u) { if (xb_ld(&bar[XB_TMO])) break; if (sp > XB_SPIN_CAP) { atomicAdd(&bar[XB_TMO], 1u); break; } }
    }
    nloc = mine > 0u ? mine : 1u; nx = cnt > 0u ? cnt : 1u;
}

__device__ __forceinline__ void xcd_barrier(const XcdBarrier& b) {
    asm volatile("s_waitcnt vmcnt(0)" ::: "memory");
    __syncthreads();
    if (threadIdx.x == 0) {
        unsigned* bar = b.bar;
        __builtin_amdgcn_s_waitcnt(0);
        unsigned nloc = b.st[0], nx = b.st[1];
        if (nloc == 0u) { xcd_barrier_complete(bar, b.x, nloc, nx); b.st[0] = nloc; b.st[1] = nx; }
        const unsigned old = xb_add(&bar[XB_XSUB(b.x)], 1u);
        const unsigned gen = old / nloc;
        if (old + 1u == (gen + 1u) * nloc) {
            __builtin_amdgcn_fence(__ATOMIC_RELEASE, "agent");
            asm volatile("s_waitcnt vmcnt(0)" ::: "memory");
            const unsigned og = xb_add(&bar[XB_TOP], 1u);
            const unsigned tg = og / nx;
            if (og + 1u == (tg + 1u) * nx) xb_add(&bar[XB_TOPGEN], 1u);
            else XB_SPIN(xb_ld(&bar[XB_TOPGEN]) == tg, bar);
            __builtin_amdgcn_fence(__ATOMIC_ACQUIRE, "agent");
            xb_add(&bar[XB_XGEN(b.x)], 1u);
            asm volatile("s_waitcnt vmcnt(0)" ::: "memory");
        } else {
            XB_SPIN(xb_ld(&bar[XB_XGEN(b.x)]) == gen, bar);
            __builtin_amdgcn_fence(__ATOMIC_ACQUIRE, "agent");
            asm volatile("s_waitcnt vmcnt(0)" ::: "memory");
        }
    }
    __syncthreads();
}
#define DI __device__ __forceinline__
typedef float f32x16 __attribute__((ext_vector_type(16)));
typedef float f32x2 __attribute__((ext_vector_type(2)));
typedef unsigned v2u __attribute__((ext_vector_type(2)));
typedef short s16x4 __attribute__((ext_vector_type(4)));
typedef __bf16 bf16x2_t __attribute__((ext_vector_type(2)));

constexpr int DM = 1024, SEQ = 8192, NBP = 2, MPR = NBP * SEQ  , NSMP = 32, MTOT = MPR + NSMP  , MP = 16640  ;
constexpr int PAST = 8192, NPAGES = 64, PAGE = 128;
constexpr int DFF = 2816, NUP = 2 * DFF  , PLE = 256;
constexpr int NPROJ = 7936;
constexpr int C_GQ = 0, C_GK = 512, C_GV = 1024, C_GR = 2048, C_NQ = 3072, C_KC = 4096, C_KS = 4608, C_KW = 5120, C_MG = 5632, C_MN = 6656, C_GA = 7680, C_NG = 7696;
constexpr int IN_COLS = 7744;
constexpr float EPS = 1e-6f;
constexpr float LOG2E = 1.4426950408889634f;
constexpr float QSCALE = 0.125f * LOG2E;
constexpr float GLA_QS = 0.08838834764831845f;
constexpr int NCHUNK = MPR / 64;
constexpr int CHK_S = 32 * 4 * 512  , CHK_P = 2 * 4 * 512  , CHK_ROWS = CHK_S + CHK_P  ;

constexpr size_t O_Y = 0, O_YS = 16777216, O_CMP_P = O_YS + 32768, O_CMP_S = O_CMP_P + 8388608, O_SLC_P = O_CMP_S + 16384, O_SLC_S = O_SLC_P + 8388608,
                 O_WIN_P = O_SLC_S + 16384, O_WIN_S = O_WIN_P + 524288, O_GLA_P = O_WIN_S + 16384, O_GLA_S = O_GLA_P + 262144, O_CONV_P = O_GLA_S + 4194304,
                 O_CONV_S = O_CONV_P + 11264, O_END = O_CONV_S + 180224;

constexpr size_t al256(size_t x) { return (x + 255) & ~(size_t)255; }
constexpr size_t WS_CTL = 0, CTL_BYTES = 1u << 20;
constexpr size_t WS_WIN_T = WS_CTL + CTL_BYTES;
constexpr size_t WS_WGO_T = WS_WIN_T + (size_t)NPROJ * DM * 2;
constexpr size_t WS_WNO_T = WS_WGO_T + (size_t)DM * DM * 2;
constexpr size_t WS_WOUT_T = WS_WNO_T + (size_t)DM * DM * 2;
constexpr size_t WS_WPG_T = WS_WOUT_T + (size_t)DM * DM * 2;
constexpr size_t WS_WUP_T = WS_WPG_T + (size_t)DM * DM * 2;
constexpr size_t WS_WDN_T = WS_WUP_T + (size_t)NUP * DM * 2;
constexpr size_t WS_WPP_T = WS_WDN_T + (size_t)DM * DFF * 2;
constexpr size_t WS_W1_T = WS_WPP_T + (size_t)DM * PLE * 2;
constexpr size_t WS_W2_T = WS_W1_T + (size_t)2 * 256 * 1024 * 2;
constexpr size_t WS_B1P = WS_W2_T + (size_t)2 * 64 * 128 * 2;
constexpr size_t WS_XN = al256(WS_B1P + 1024);
constexpr size_t WS_PB = WS_XN + (size_t)MP * DM * 2;
constexpr size_t WS_PROJ = WS_PB + (size_t)MP * PLE * 2;
constexpr size_t WS_PP = WS_PROJ + (size_t)MP * NPROJ * 2;
constexpr size_t WS_QT = WS_PP + (size_t)MP * DM * 2;
constexpr size_t WS_KT = WS_QT + (size_t)MPR * 512 * 2;
constexpr size_t WS_UT = WS_KT + (size_t)MPR * 512 * 2;
constexpr size_t WS_ST = WS_UT + (size_t)NCHUNK * 4 * 256 * 128 * 2;
constexpr size_t WS_DL = WS_ST + (size_t)NCHUNK * 4 * 256 * 128 * 2;
constexpr size_t WS_OG = WS_DL + (size_t)NCHUNK * 4 * 128 * 4;
constexpr size_t WS_CHK = WS_OG + (size_t)MP * DM * 2;
constexpr size_t WS_T = WS_CHK + (size_t)2 * CHK_ROWS * 1024 * 2;
constexpr size_t WS_KVC = WS_T + (size_t)2 * CHK_ROWS * 256 * 2 + 4096;
constexpr size_t WS_SEL = WS_KVC + (size_t)2 * CHK_ROWS * 64 * 2 + 4096;
constexpr size_t WS_OC = WS_SEL + (size_t)8 * SEQ * 4 * 4;
constexpr size_t WS_OW = WS_OC + (size_t)MP * DM * 2;
constexpr size_t WS_ONSA = WS_OW + (size_t)MP * DM * 2;
constexpr size_t WS_YG = WS_ONSA + (size_t)MP * DM * 2;
constexpr size_t WS_MIX = WS_YG + (size_t)MP * DM * 2;
constexpr size_t WS_T1 = WS_MIX + (size_t)MP * DM * 2;
constexpr size_t WS_X1 = WS_T1 + (size_t)MP * DM * 4;
constexpr size_t WS_X2 = WS_X1 + (size_t)MP * DM * 4;
constexpr size_t WS_UP = WS_X2 + (size_t)MP * DM * 4;
constexpr size_t WS_H = WS_UP + (size_t)MP * NUP * 2;
constexpr size_t WS_END = WS_H + (size_t)MP * DFF * 2;

constexpr int CW_BAR = 4096;
constexpr int LDS_BYTES = 147456;
constexpr int MISC_OFF = 131072 + 320;

DI float bf2f(unsigned short h) { return __uint_as_float((unsigned)h << 16); }
DI float bflo(unsigned u) { return __uint_as_float(u << 16); }
DI float bfhi(unsigned u) { return __uint_as_float(u & 0xffff0000u); }
DI unsigned cvtpk(float lo, float hi) { f32x2 v = {lo, hi}; bf16x2_t b = __builtin_convertvector(v, bf16x2_t); return __builtin_bit_cast(unsigned, b); }
DI float sigmoidf_(float x) { return 1.0f / (1.0f + __expf(-x)); }
DI float siluf_(float x) { return x / (1.0f + __expf(-x)); }
DI float gelu_tanh(float x) { const float u = 1.5957691216057308f * (x + 0.044715f * x * x * x); return x / (1.0f + __expf(-u)); }
DI float logsigf_(float x) { return fminf(x, 0.f) - log1pf(__expf(-fabsf(x))); }
DI float wave_sum(float v) {
#pragma unroll
    for (int o = 1; o < 64; o <<= 1) v += __shfl_xor(v, o);
    return v;
}
DI float wave_max(float v) {
#pragma unroll
    for (int o = 1; o < 64; o <<= 1) v = fmaxf(v, __shfl_xor(v, o));
    return v;
}
template <int CTRL> DI int dpp_i(int x) { return __builtin_amdgcn_update_dpp(0, x, CTRL, 0xf, 0xf, false); }
template <int CTRL> DI float dpp_f(float x) { return __int_as_float(__builtin_amdgcn_update_dpp(0, __float_as_int(x), CTRL, 0xf, 0xf, false)); }
DI float quad_sum(float x) { x += dpp_f<0xB1>(x); x += dpp_f<0x4E>(x); return x; }
DI int sum8_i(int x) { x += dpp_i<0xB1>(x); x += dpp_i<0x4E>(x); x += dpp_i<0x141>(x); return x; }
DI float sum16_f(float x) { x += dpp_f<0xB1>(x); x += dpp_f<0x4E>(x); x += dpp_f<0x141>(x); x += dpp_f<0x140>(x); return x; }

#define MFMA32(a, b, c) __builtin_amdgcn_mfma_f32_32x32x16_bf16((a), (b), (c), 0, 0, 0)
DI int crow(int r, int hi) { return (r & 3) + 8 * (r >> 2) + 4 * hi; }
typedef short v4i16_t __attribute__((ext_vector_type(4)));
DI s16x4 vtr(const LAS unsigned char* p) { return __builtin_bit_cast(s16x4, __builtin_amdgcn_ds_read_tr16_b64_v4i16((LAS v4i16_t*)p)); }
DI bf16x8 cat8(s16x4 lo, s16x4 hi) { return (bf16x8){lo[0], lo[1], lo[2], lo[3], hi[0], hi[1], hi[2], hi[3]}; }
DI bf16x8 tr_frag(const LAS unsigned char* T, int stride, int k0, int n0, int lane) {
    const int q = (lane & 15) >> 2, p = lane & 3, blk = (lane >> 4) & 1, hh = lane >> 5;
    const LAS unsigned char* a = T + (k0 + 8 * hh + q) * stride + (n0 + 16 * blk + 4 * p) * 2;
    return cat8(vtr(a), vtr(a + 4 * stride));
}
DI bf16x8 tr_frag_acc(const LAS unsigned char* T, int stride, int k0, int n0, int lane) {
    const int q = (lane & 15) >> 2, p = lane & 3, blk = (lane >> 4) & 1, hh = lane >> 5;
    const LAS unsigned char* a = T + (k0 + 4 * hh + q) * stride + (n0 + 16 * blk + 4 * p) * 2;
    return cat8(vtr(a), vtr(a + 8 * stride));
}
DI bf16x8 pack_acc(const f32x16& x, int s) {
    v4u p; p.x = cvtpk(x[8 * s + 0], x[8 * s + 1]); p.y = cvtpk(x[8 * s + 2], x[8 * s + 3]); p.z = cvtpk(x[8 * s + 4], x[8 * s + 5]); p.w = cvtpk(x[8 * s + 6], x[8 * s + 7]);
    return __builtin_bit_cast(bf16x8, p);
}

struct Ctx {
    LAS unsigned char* lds;
    int tid, lane, wave, G, bid;
    const float* in[33];
    float* out;
    unsigned char* ws;
};
#define WSP(T, off) ((T*)(C.ws + (off)))
namespace pg8 {
DI unsigned epk(float lo, float hi) { return ::cvtpk(lo, hi); }
DI u32x4 pack8(const f32x4& a, const f32x4& b) { u32x4 w; w.x = epk(a[0], a[1]); w.y = epk(a[2], a[3]); w.z = epk(b[0], b[1]); w.w = epk(b[2], b[3]); return w; }

struct EpiProj {
    static constexpr bool PERM = true, AFTER_DRAIN = false;
    bf16_t* P; float* out;
    DI void operator()(const f32x4 (&acc)[2][2][4][2], const Unit& u, int wr, int wc, int fr, int fq) const {
        const float sc = (u.pn >= 12 && u.pn < 16) ? QSCALE : 1.f;
        const bool kv = (u.pn >= 16 && u.pn < 22); const int which = (u.pn - 16) >> 1;
#pragma unroll
        for (int ai = 0; ai < 2; ++ai)
#pragma unroll
            for (int m = 0; m < 4; ++m) {
                const int row = u.pm * BM + ai * HALF + wr * 64 + m * 16 + fr;
#pragma unroll
                for (int bj = 0; bj < 2; ++bj) {
                    const int col = u.pn * BM + bj * HALF + wc * 32 + 8 * fq;
                    const f32x4 v0 = acc[ai][bj][m][0], v1 = acc[ai][bj][m][1];
                    *(u32x4*)(P + (size_t)row * NPROJ + col) = pack8(v0 * sc, v1 * sc);
                    if (kv) {
                        const int c512 = col - (C_KC + which * 512); float* dst = nullptr;
                        if (row < MPR) {
                            if (which == 0) dst = out + O_CMP_P + (size_t)row * 512 + c512;
                            else if (which == 1) dst = out + O_SLC_P + (size_t)row * 512 + c512;
                            else { const int t = row & (SEQ - 1); if (t >= SEQ - 512) dst = out + O_WIN_P + ((size_t)((row >> 13) * 512 + (t - (SEQ - 512)))) * 512 + c512; }
                        } else if (row < MTOT) {
                            dst = out + (which == 0 ? O_CMP_S : which == 1 ? O_SLC_S : O_WIN_S) + (size_t)(row - MPR) * 512 + c512;
                        }
                        if (dst) { *(f32x4*)dst = v0; *(f32x4*)(dst + 4) = v1; }
                    }
                }
            }
    }
};
template <bool UPCONV> struct EpiStore {
    static constexpr bool PERM = true, AFTER_DRAIN = false;
    bf16_t* O; int ldc; float* out;
    DI void operator()(const f32x4 (&acc)[2][2][4][2], const Unit& u, int wr, int wc, int fr, int fq) const {
#pragma unroll
        for (int ai = 0; ai < 2; ++ai)
#pragma unroll
            for (int m = 0; m < 4; ++m) {
                const int row = u.pm * BM + ai * HALF + wr * 64 + m * 16 + fr;
#pragma unroll
                for (int bj = 0; bj < 2; ++bj) {
                    const int col = u.pn * BM + bj * HALF + wc * 32 + 8 * fq;
                    const f32x4 v0 = acc[ai][bj][m][0], v1 = acc[ai][bj][m][1];
                    *(u32x4*)(O + (size_t)row * ldc + col) = pack8(v0, v1);
                    if (UPCONV) {
                        if (col < DFF) {
                            float* dst = nullptr; const int t = row & (SEQ - 1);
                            if (row < MPR) { if (t >= SEQ - 2) dst = out + O_CONV_P + ((size_t)((row >> 13) * 2 + (t - (SEQ - 2)))) * DFF + col; }
                            else if (row < MTOT) dst = out + O_CONV_S + ((size_t)((row - MPR) * 2 + 1)) * DFF + col;
                            if (dst) { *(f32x4*)dst = v0; *(f32x4*)(dst + 4) = v1; }
                        }
                    }
                }
            }
    }
};
struct EpiMix {
    static constexpr bool PERM = true, AFTER_DRAIN = false;
    const bf16_t* P; const bf16_t* YG; bf16_t* MIX;
    DI void operator()(const f32x4 (&acc)[2][2][4][2], const Unit& u, int wr, int wc, int fr, int fq) const {
#pragma unroll
        for (int ai = 0; ai < 2; ++ai)
#pragma unroll
            for (int m = 0; m < 4; ++m) {
                const int row = u.pm * BM + ai * HALF + wr * 64 + m * 16 + fr;
#pragma unroll
                for (int bj = 0; bj < 2; ++bj) {
                    const int col = u.pn * BM + bj * HALF + wc * 32 + 8 * fq;
                    const f32x4 v0 = acc[ai][bj][m][0], v1 = acc[ai][bj][m][1];
                    const u32x4 yg = *(const u32x4*)(YG + (size_t)row * DM + col);
                    const u32x4 mg = *(const u32x4*)(P + (size_t)row * NPROJ + C_MG + col);
                    const u32x4 mn = *(const u32x4*)(P + (size_t)row * NPROJ + C_MN + col);
                    float r[8];
#pragma unroll
                    for (int e = 0; e < 4; ++e) {
                        const float a0 = e < 2 ? v0[2 * e] : v1[2 * e - 4], a1 = e < 2 ? v0[2 * e + 1] : v1[2 * e - 3];
                        r[2 * e] = sigmoidf_(bflo(mg[e])) * bflo(yg[e]) + sigmoidf_(bflo(mn[e])) * a0;
                        r[2 * e + 1] = sigmoidf_(bfhi(mg[e])) * bfhi(yg[e]) + sigmoidf_(bfhi(mn[e])) * a1;
                    }
                    u32x4 w; w.x = epk(r[0], r[1]); w.y = epk(r[2], r[3]); w.z = epk(r[4], r[5]); w.w = epk(r[6], r[7]);
                    *(u32x4*)(MIX + (size_t)row * DM + col) = w;
                }
            }
    }
};
struct EpiF32 {
    static constexpr bool PERM = false, AFTER_DRAIN = false;
    float* O; int ldc;
    DI void operator()(const f32x4 (&acc)[2][2][4][2], const Unit& u, int wr, int wc, int fr, int fq) const {
#pragma unroll
        for (int ai = 0; ai < 2; ++ai)
#pragma unroll
            for (int m = 0; m < 4; ++m) {
                const int row = u.pm * BM + ai * HALF + wr * 64 + m * 16 + fr;
#pragma unroll
                for (int bj = 0; bj < 2; ++bj)
#pragma unroll
                    for (int n = 0; n < 2; ++n) { const int col = u.pn * BM + bj * HALF + wc * 32 + 16 * n + 4 * fq; *(f32x4*)(O + (size_t)row * ldc + col) = acc[ai][bj][m][n]; }
            }
    }
};
struct EpiFinal {
    static constexpr bool PERM = false, AFTER_DRAIN = false;
    const float* X2; const bf16_t* PP; float* out;
    DI void operator()(const f32x4 (&acc)[2][2][4][2], const Unit& u, int wr, int wc, int fr, int fq) const {
#pragma unroll
        for (int ai = 0; ai < 2; ++ai)
#pragma unroll
            for (int m = 0; m < 4; ++m) {
                const int row = u.pm * BM + ai * HALF + wr * 64 + m * 16 + fr;
                if (row < MTOT) {
                    float* orow = row < MPR ? out + O_Y + (size_t)row * DM : out + O_YS + (size_t)(row - MPR) * DM;
#pragma unroll
                    for (int bj = 0; bj < 2; ++bj)
#pragma unroll
                        for (int n = 0; n < 2; ++n) {
                            const int col = u.pn * BM + bj * HALF + wc * 32 + 16 * n + 4 * fq; const f32x4 a = acc[ai][bj][m][n];
                            const f32x4 x = *(const f32x4*)(X2 + (size_t)row * DM + col); const v2u pp = *(const v2u*)(PP + (size_t)row * DM + col);
                            f32x4 y; y[0] = x[0] + sigmoidf_(a[0]) * bflo(pp[0]); y[1] = x[1] + sigmoidf_(a[1]) * bfhi(pp[0]); y[2] = x[2] + sigmoidf_(a[2]) * bflo(pp[1]); y[3] = x[3] + sigmoidf_(a[3]) * bfhi(pp[1]);
                            *(f32x4*)(orow + col) = y;
                        }
                }
            }
    }
};
}
struct ColIdent { DI int operator()(int n) const { return n; } };
struct ColWin {
    DI int operator()(int n) const {
        if (n < 3072) return n;
        if (n < 4096) return 3088 + (n - 3072);
        if (n < 5632) return 4112 + (n - 4096);
        if (n < 7680) return 5696 + (n - 5632);
        if (n < 7696) return 3072 + (n - 7680);
        if (n < 7744) return 5648 + (n - 7696);
        return -1;
    }
};
template <class F> DI void tr_item(const float* W, int Nsrc, bf16* WT, int Kpitch, int k0, int n0, LAS float* scr, int lane, F srccol) {
    const int ns = srccol(n0 + (lane & 31));
#pragma unroll 8
    for (int i = 0; i < 32; ++i) { const int kk = 2 * i + (lane >> 5); scr[kk * 33 + (lane & 31)] = ns >= 0 ? W[(size_t)(k0 + kk) * Nsrc + ns] : 0.f; }
    LDS_WAIT(); asm volatile("" ::: "memory");
    const int c = lane & 7;
#pragma unroll
    for (int j = 0; j < 4; ++j) { const int n = (lane >> 3) + 8 * j; const LAS float* s = scr + (8 * c) * 33 + n;
        v4u o; o.x = cvtpk(s[0 * 33], s[1 * 33]); o.y = cvtpk(s[2 * 33], s[3 * 33]); o.z = cvtpk(s[4 * 33], s[5 * 33]); o.w = cvtpk(s[6 * 33], s[7 * 33]);
        *(v4u*)(WT + (size_t)(n0 + n) * Kpitch + k0 + 8 * c) = o; }
    LDS_WAIT(); asm volatile("" ::: "memory");
}
template <class F> DI void tr_matrix(const Ctx& C, const float* W, int K, int Nsrc, int Ndst, bf16* WT, int Kpitch, F f, int& base) {
    LAS float* scr = (LAS float*)(C.lds + C.wave * 16384);
    const int gw = C.bid * 8 + C.wave, NGW = C.G * 8, nb = Ndst / 32, items = (K / 64) * nb;
    int first = gw - (base % NGW); if (first < 0) first += NGW;
    for (int it = first; it < items; it += NGW) tr_item(W, Nsrc, WT, Kpitch, 64 * (it / nb), 32 * (it % nb), scr, C.lane, f);
    base += items;
}
DI void rms_row_bf16(const float* xrow, const float* g, bf16* orow, int lane) {
    const f32x4* xr = (const f32x4*)xrow + lane; const f32x4* gr = (const f32x4*)g + lane;
    f32x4 v[4]; float s = 0.f;
#pragma unroll
    for (int j = 0; j < 4; ++j) { v[j] = xr[64 * j]; s += (v[j][0] * v[j][0] + v[j][1] * v[j][1]) + (v[j][2] * v[j][2] + v[j][3] * v[j][3]); }
    const float rstd = rsqrtf(wave_sum(s) * (1.f / DM) + EPS);
#pragma unroll
    for (int j = 0; j < 4; ++j) { const f32x4 gg = gr[64 * j]; v2u o; o.x = cvtpk(v[j][0] * rstd * gg[0], v[j][1] * rstd * gg[1]); o.y = cvtpk(v[j][2] * rstd * gg[2], v[j][3] * rstd * gg[3]);
        *((v2u*)orow + lane + 64 * j) = o; }
}
DI void phase_prologue(const Ctx& C) {
    const int gw = C.bid * 8 + C.wave, NGW = C.G * 8, lane = C.lane;
    int base = 0;
    tr_matrix(C, C.in[15], DM, IN_COLS, NPROJ, WSP(bf16, WS_WIN_T), DM, ColWin(), base);
    tr_matrix(C, C.in[19], DM, DM, DM, WSP(bf16, WS_WGO_T), DM, ColIdent(), base);
    tr_matrix(C, C.in[25], DM, DM, DM, WSP(bf16, WS_WNO_T), DM, ColIdent(), base);
    tr_matrix(C, C.in[26], DM, DM, DM, WSP(bf16, WS_WOUT_T), DM, ColIdent(), base);
    tr_matrix(C, C.in[32], DM, DM, DM, WSP(bf16, WS_WPG_T), DM, ColIdent(), base);
    tr_matrix(C, C.in[27], DM, NUP, NUP, WSP(bf16, WS_WUP_T), DM, ColIdent(), base);
    tr_matrix(C, C.in[30], DFF, DM, DM, WSP(bf16, WS_WDN_T), DFF, ColIdent(), base);
    tr_matrix(C, C.in[31], PLE, DM, DM, WSP(bf16, WS_WPP_T), PLE, ColIdent(), base);
#pragma unroll
    for (int c = 0; c < 2; ++c)
#pragma unroll
        for (int hh = 0; hh < 2; ++hh)
            tr_matrix(C, C.in[20] + (size_t)(c * 2048 + hh * 1024) * 128, 1024, 128, 128, WSP(bf16, WS_W1_T) + (size_t)(c * 256 + hh * 128) * 1024, 1024, ColIdent(), base);
#pragma unroll
    for (int c = 0; c < 2; ++c) tr_matrix(C, C.in[22] + (size_t)c * 128 * 64, 128, 64, 64, WSP(bf16, WS_W2_T) + (size_t)c * 64 * 128, 128, ColIdent(), base);
    if (gw < 256) {
        const int c = gw >> 7, h = gw & 127; const float* w1 = C.in[20] + (size_t)c * 2048 * 128; const float* pe = C.in[24];
        float s = 0.f;
        for (int k = lane; k < 2048; k += 64) { const int pos = k >> 6, d = k & 63; s += pe[(pos * 2 + c) * 64 + d] * w1[(size_t)k * 128 + h]; }
        s = wave_sum(s);
        if (lane == 0) WSP(float, WS_B1P)[gw] = s + C.in[21][gw];
    }
    bf16* XN = WSP(bf16, WS_XN); bf16* PB = WSP(bf16, WS_PB);
    for (int m = gw; m < MP; m += NGW) {
        if (m < MTOT) {
            const float* xr = m < MPR ? C.in[0] + (size_t)m * DM : C.in[1] + (size_t)(m - MPR) * DM;
            rms_row_bf16(xr, C.in[10], XN + (size_t)m * DM, lane);
            const float* pr = m < MPR ? C.in[8] + (size_t)m * PLE : C.in[9] + (size_t)(m - MPR) * PLE;
            const f32x4 pv = *((const f32x4*)pr + lane); v2u o; o.x = cvtpk(pv[0], pv[1]); o.y = cvtpk(pv[2], pv[3]); *((v2u*)(PB + (size_t)m * PLE) + lane) = o;
        } else {
#pragma unroll
            for (int j = 0; j < 4; ++j) *((v2u*)(XN + (size_t)m * DM) + lane + 64 * j) = (v2u){0u, 0u};
            *((v2u*)(PB + (size_t)m * PLE) + lane) = (v2u){0u, 0u};
        }
    }
    {
        const float* cache = C.in[2]; const int* pt = (const int*)C.in[7]; bf16* CHK = WSP(bf16, WS_CHK);
        const int tk2 = lane >> 5, f4 = lane & 31, c = f4 >> 4, d4 = (f4 & 15) * 4;
        for (int r = gw; r < CHK_S; r += NGW) {
            const int b = r >> 11, g = (r >> 9) & 3, j = r & 511;
            const int page = pt[b * NPAGES + (j >> 3)];
            const float* src = cache + ((size_t)page * PAGE + (size_t)((16 * j) & 127)) * 512 + g * 128 + f4 * 4;
            bf16* dst = CHK + ((size_t)c * CHK_ROWS + r) * 1024 + d4;
#pragma unroll
            for (int i = 0; i < 8; ++i) { const int pos = 2 * i + tk2; const f32x4 v = *(const f32x4*)(src + (size_t)pos * 512);
                v2u o; o.x = cvtpk(v[0], v[1]); o.y = cvtpk(v[2], v[3]); *(v2u*)(dst + pos * 64) = o; }
        }
    }
    for (int i = C.bid * 512 + C.tid; i < NSMP * DFF; i += C.G * 512) { const int b = i / DFF, c = i - b * DFF; C.out[O_CONV_S + (size_t)(b * 2) * DFF + c] = C.in[6][(size_t)(b * 2 + 1) * DFF + c]; }
}

DI void phase_chk_prompt(const Ctx& C) {
    const int gw = C.bid * 8 + C.wave, NGW = C.G * 8, lane = C.lane;
    const bf16* P = WSP(bf16, WS_PROJ); bf16* CHK = WSP(bf16, WS_CHK);
    const int tk = lane >> 4, ch = lane & 15, c = ch >> 3, d8 = (ch & 7) * 8;
    for (int r = gw; r < CHK_P; r += NGW) {
        const int b = r >> 11, g = (r >> 9) & 3, j = r & 511;
        const bf16* src = P + (size_t)(b * SEQ + 16 * j) * NPROJ + C_KC + g * 128 + ch * 8;
        bf16* dst = CHK + ((size_t)c * CHK_ROWS + CHK_S + r) * 1024 + d8;
#pragma unroll
        for (int i = 0; i < 4; ++i) { const int pos = 4 * i + tk; *(v4u*)(dst + pos * 64) = *(const v4u*)(src + (size_t)pos * NPROJ); }
    }
}

DI void phase_rownorm(const Ctx& C, const float* T, const float* xin_p, const float* xin_s, const float* g_post, const float* g_pre, float* xout, bf16* XN) {
    const int gw = C.bid * 8 + C.wave, NGW = C.G * 8, lane = C.lane;
    for (int m = gw; m < MTOT; m += NGW) {
        const f32x4* tr = (const f32x4*)(T + (size_t)m * DM) + lane;
        const f32x4* xr = (const f32x4*)(m < MPR ? xin_p + (size_t)m * DM : xin_s + (size_t)(m - MPR) * DM) + lane;
        f32x4 t[4], x[4]; float s = 0.f;
#pragma unroll
        for (int j = 0; j < 4; ++j) { t[j] = tr[64 * j]; x[j] = xr[64 * j]; s += (t[j][0] * t[j][0] + t[j][1] * t[j][1]) + (t[j][2] * t[j][2] + t[j][3] * t[j][3]); }
        const float r1 = rsqrtf(wave_sum(s) * (1.f / DM) + EPS); float s2 = 0.f;
#pragma unroll
        for (int j = 0; j < 4; ++j) { const f32x4 gp = *((const f32x4*)g_post + lane + 64 * j); x[j] = x[j] + t[j] * r1 * gp;
            s2 += (x[j][0] * x[j][0] + x[j][1] * x[j][1]) + (x[j][2] * x[j][2] + x[j][3] * x[j][3]); *((f32x4*)(xout + (size_t)m * DM) + lane + 64 * j) = x[j]; }
        const float r2 = rsqrtf(wave_sum(s2) * (1.f / DM) + EPS);
#pragma unroll
        for (int j = 0; j < 4; ++j) { const f32x4 gg = *((const f32x4*)g_pre + lane + 64 * j); v2u o; o.x = cvtpk(x[j][0] * r2 * gg[0], x[j][1] * r2 * gg[1]); o.y = cvtpk(x[j][2] * r2 * gg[2], x[j][3] * r2 * gg[3]);
            *((v2u*)(XN + (size_t)m * DM) + lane + 64 * j) = o; }
    }
}

DI void phase_conv(const Ctx& C) {
    const bf16* UP = WSP(bf16, WS_UP); bf16* H = WSP(bf16, WS_H);
    const float* cw = C.in[28]; const float* cb = C.in[29]; const float* st = C.in[6];
    constexpr int NV = DFF / 8;
    const int total = MTOT * NV;
    for (int i = C.bid * 512 + C.tid; i < total; i += C.G * 512) {
        const int row = i / NV, cv = (i - row * NV) * 8;
        const v4u a0 = *(const v4u*)(UP + (size_t)row * NUP + cv), gt = *(const v4u*)(UP + (size_t)row * NUP + DFF + cv);
        float am1[8], am2[8];
        if (row < MPR) {
            const int t = row & (SEQ - 1);
            v4u x1 = (v4u){0u, 0u, 0u, 0u}, x2 = x1;
            if (t >= 1) x1 = *(const v4u*)(UP + (size_t)(row - 1) * NUP + cv);
            if (t >= 2) x2 = *(const v4u*)(UP + (size_t)(row - 2) * NUP + cv);
#pragma unroll
            for (int e = 0; e < 4; ++e) { am1[2 * e] = bflo(x1[e]); am1[2 * e + 1] = bfhi(x1[e]); am2[2 * e] = bflo(x2[e]); am2[2 * e + 1] = bfhi(x2[e]); }
        } else {
            const int b = row - MPR;
#pragma unroll
            for (int e = 0; e < 8; ++e) { am2[e] = st[(size_t)(b * 2 + 0) * DFF + cv + e]; am1[e] = st[(size_t)(b * 2 + 1) * DFF + cv + e]; }
        }
        float r[8];
#pragma unroll
        for (int e = 0; e < 8; ++e) {
            const float a = (e & 1) ? bfhi(a0[e >> 1]) : bflo(a0[e >> 1]), g = (e & 1) ? bfhi(gt[e >> 1]) : bflo(gt[e >> 1]);
            const float cval = am2[e] * cw[cv + e] + am1[e] * cw[DFF + cv + e] + a * cw[2 * DFF + cv + e] + cb[cv + e];
            r[e] = gelu_tanh(cval) * g;
        }
        v4u o; o.x = cvtpk(r[0], r[1]); o.y = cvtpk(r[2], r[3]); o.z = cvtpk(r[4], r[5]); o.w = cvtpk(r[6], r[7]);
        *(v4u*)(H + (size_t)row * DFF + cv) = o;
    }
}

DI void phase_kvc(const Ctx& C) {
    const int gw = C.bid * 8 + C.wave, NGW = C.G * 8, lane = C.lane, r32 = lane & 31, hh = lane >> 5;
    const bf16* T = WSP(bf16, WS_T); bf16* KVC = WSP(bf16, WS_KVC); const bf16* W2T = WSP(bf16, WS_W2_T); const float* B1P = WSP(float, WS_B1P);
    constexpr int NT = CHK_ROWS / 32;
    for (int task = gw; task < 2 * NT; task += NGW) {
        const int c = task / NT, R0 = (task - c * NT) * 32;
        const bf16* Tc = T + (size_t)c * CHK_ROWS * 256; const bf16* w2 = W2T + (size_t)c * 64 * 128;
        f32x16 acc0 = {}, acc1 = {};
        const bf16* trow = Tc + (size_t)(R0 + r32) * 256;
#pragma unroll
        for (int s = 0; s < 8; ++s) {
            const int k0 = 16 * s + 8 * hh;
            const v4u ta = *(const v4u*)(trow + k0), tb = *(const v4u*)(trow + 256 + 128 + k0);
            const f32x4 b0 = *(const f32x4*)(B1P + c * 128 + k0), b1 = *(const f32x4*)(B1P + c * 128 + k0 + 4);
            float hv[8];
#pragma unroll
            for (int e = 0; e < 4; ++e) { hv[2 * e] = bflo(ta[e]) + bflo(tb[e]); hv[2 * e + 1] = bfhi(ta[e]) + bfhi(tb[e]); }
#pragma unroll
            for (int e = 0; e < 8; ++e) hv[e] = gelu_tanh(hv[e] + (e < 4 ? b0[e] : b1[e - 4]));
            v4u ap; ap.x = cvtpk(hv[0], hv[1]); ap.y = cvtpk(hv[2], hv[3]); ap.z = cvtpk(hv[4], hv[5]); ap.w = cvtpk(hv[6], hv[7]);
            const bf16x8 af = __builtin_bit_cast(bf16x8, ap);
            const bf16x8 bw0 = *(const bf16x8*)(w2 + (size_t)r32 * 128 + k0), bw1 = *(const bf16x8*)(w2 + (size_t)(32 + r32) * 128 + k0);
            acc0 = MFMA32(af, bw0, acc0); acc1 = MFMA32(af, bw1, acc1);
        }
        const float bb0 = C.in[23][c * 64 + r32], bb1 = C.in[23][c * 64 + 32 + r32];
        bf16* orow = KVC + ((size_t)c * CHK_ROWS + R0) * 64;
#pragma unroll
        for (int r = 0; r < 16; ++r) { const int row = crow(r, hh);
            orow[(size_t)row * 64 + r32] = (bf16)(cvtpk(acc0[r] + bb0, 0.f) & 0xffffu); orow[(size_t)row * 64 + 32 + r32] = (bf16)(cvtpk(acc1[r] + bb1, 0.f) & 0xffffu); }
    }
}
constexpr int G_KHS = 272, G_VS = 528;
DI void load_v_tile(const Ctx& C, const bf16* P, int r0, int h, LAS unsigned char* VV) {
#pragma unroll
    for (int i = 0; i < 4; ++i) { const int idx = C.tid + 512 * i, row = idx >> 5, ch = idx & 31;
        *(LAS v4u*)(VV + row * G_VS + ch * 16) = *(const v4u*)(P + (size_t)(r0 + row) * NPROJ + C_GV + h * 256 + ch * 8); }
}
DI void phase_g1(const Ctx& C) {
    const bf16* P = WSP(bf16, WS_PROJ); bf16* QT = WSP(bf16, WS_QT); bf16* KT = WSP(bf16, WS_KT); bf16* UT = WSP(bf16, WS_UT); float* DL = WSP(float, WS_DL);
    const float* wup = C.in[16]; const float* bgate = C.in[17];
    LAS float* LA = (LAS float*)C.lds;
    LAS float* GA = (LAS float*)(C.lds + 32768);
    LAS float* WU = (LAS float*)(C.lds + 36864);
    LAS unsigned char* KH = C.lds + 45056;
    LAS unsigned char* VV = C.lds + 62464;
    const int tid = C.tid, lane = C.lane, w = C.wave;
    for (int unit = C.bid; unit < NCHUNK * 4; unit += C.G) {
        const int ci = unit >> 2, h = unit & 3, r0 = 64 * ci;
        { const int t = tid >> 3, pr = tid & 7; const unsigned g2 = *(const unsigned*)(P + (size_t)(r0 + t) * NPROJ + C_GA + 2 * pr); GA[t * 16 + 2 * pr] = bflo(g2); GA[t * 16 + 2 * pr + 1] = bfhi(g2);
          const int idx = tid * 4, r = idx >> 7, dk = idx & 127; *(LAS f32x4*)(WU + idx) = *(const f32x4*)(wup + (size_t)r * 512 + h * 128 + dk); }
        load_v_tile(C, P, r0, h, VV);
        __syncthreads();
        { const int dk = tid & 127, tq = tid >> 7; float wc[16];
#pragma unroll
          for (int r = 0; r < 16; ++r) wc[r] = WU[r * 128 + dk];
          const float bias = bgate[h * 128 + dk];
          for (int i = 0; i < 16; ++i) { const int t = tq * 16 + i; float x = bias;
#pragma unroll
              for (int r = 0; r < 16; ++r) x += GA[t * 16 + r] * wc[r];
              LA[t * 128 + dk] = logsigf_(x) * (1.0f / 16.0f); } }
        __syncthreads();
        if (tid < 128) { float run = 0.f; for (int t = 0; t < 64; ++t) { run += LA[t * 128 + tid]; LA[t * 128 + tid] = run; } }
        __syncthreads();
        { const int t = tid >> 3, dk0 = (tid & 7) * 16; const size_t prow = (size_t)(r0 + t) * NPROJ;
#pragma unroll
          for (int hf = 0; hf < 2; ++hf) {
              const int dk = dk0 + 8 * hf;
              const v4u qv = *(const v4u*)(P + prow + C_GQ + h * 128 + dk), kv = *(const v4u*)(P + prow + C_GK + h * 128 + dk);
              float qo[8], ko[8], kh[8];
#pragma unroll
              for (int e = 0; e < 8; ++e) {
                  const float q = (e & 1) ? bfhi(qv[e >> 1]) : bflo(qv[e >> 1]), k = (e & 1) ? bfhi(kv[e >> 1]) : bflo(kv[e >> 1]);
                  const float b = LA[t * 128 + dk + e], bl = LA[63 * 128 + dk + e];
                  qo[e] = q * GLA_QS * __expf(b); ko[e] = k * __expf(-b); kh[e] = k * __expf(bl - b);
              }
              v4u o; o.x = cvtpk(qo[0], qo[1]); o.y = cvtpk(qo[2], qo[3]); o.z = cvtpk(qo[4], qo[5]); o.w = cvtpk(qo[6], qo[7]);
              *(v4u*)(QT + (size_t)(r0 + t) * 512 + h * 128 + dk) = o;
              o.x = cvtpk(ko[0], ko[1]); o.y = cvtpk(ko[2], ko[3]); o.z = cvtpk(ko[4], ko[5]); o.w = cvtpk(ko[6], ko[7]);
              *(v4u*)(KT + (size_t)(r0 + t) * 512 + h * 128 + dk) = o;
              o.x = cvtpk(kh[0], kh[1]); o.y = cvtpk(kh[2], kh[3]); o.z = cvtpk(kh[4], kh[5]); o.w = cvtpk(kh[6], kh[7]);
              *(LAS v4u*)(KH + t * G_KHS + dk * 2) = o;
          }
          if (tid < 128) DL[(size_t)unit * 128 + tid] = __expf(LA[63 * 128 + tid]); }
        __syncthreads();
        {
            f32x16 acc[4] = {};
#pragma unroll
            for (int s = 0; s < 4; ++s) {
                const bf16x8 af = tr_frag(VV, G_VS, 16 * s, 32 * w, lane);
#pragma unroll
                for (int nt = 0; nt < 4; ++nt) { const bf16x8 bf_ = tr_frag(KH, G_KHS, 16 * s, 32 * nt, lane); acc[nt] = MFMA32(af, bf_, acc[nt]); }
            }
            bf16* ub = UT + ((size_t)unit * 256 + 32 * w) * 128;
            const int r32 = lane & 31, hh = lane >> 5;
#pragma unroll
            for (int nt = 0; nt < 4; ++nt)
#pragma unroll
                for (int r = 0; r < 16; ++r) ub[(size_t)crow(r, hh) * 128 + 32 * nt + r32] = (bf16)(cvtpk(acc[nt][r], 0.f) & 0xffffu);
        }
        __syncthreads();
    }
}
DI void phase_g2(const Ctx& C) {
    const bf16* __restrict__ UT = WSP(bf16, WS_UT); bf16* __restrict__ ST = WSP(bf16, WS_ST); const float* __restrict__ DL = WSP(float, WS_DL);
    for (int gid = C.bid * 512 + C.tid; gid < 8 * 256 * 64; gid += C.G * 512) {
        const int bh = gid >> 14, rem = gid & 16383, dv = rem >> 6, dk = (rem & 63) * 2, b = bh >> 2, h = bh & 3;
        float s0 = 0.f, s1 = 0.f;
#pragma unroll 8
        for (int c = 0; c < 128; ++c) {
            const size_t un = (size_t)((b * 128 + c) * 4 + h); const size_t idx = (un * 256 + dv) * 128 + dk;
            const unsigned u = *(const unsigned*)(UT + idx); const f32x2 d = *(const f32x2*)(DL + un * 128 + dk);
            *(unsigned*)(ST + idx) = cvtpk(s0, s1);
            s0 = d[0] * s0 + bflo(u); s1 = d[1] * s1 + bfhi(u);
        }
        float* o = C.out + O_GLA_P + ((size_t)(bh * 128 + dk)) * 256 + dv; o[0] = s0; o[256] = s1;
    }
}
DI void phase_g3(const Ctx& C) {
    const bf16* P = WSP(bf16, WS_PROJ); const bf16* QT = WSP(bf16, WS_QT); const bf16* KT = WSP(bf16, WS_KT); const bf16* ST = WSP(bf16, WS_ST); bf16* OG = WSP(bf16, WS_OG);
    const float* gnorm = C.in[18];
    LAS unsigned char* VV = C.lds; LAS float* RED = (LAS float*)(C.lds + 34816);
    const int lane = C.lane, w = C.wave, r32 = lane & 31, hh = lane >> 5;
    for (int unit = C.bid; unit < NCHUNK * 4; unit += C.G) {
        const int ci = unit >> 2, h = unit & 3, r0 = 64 * ci, dv0 = 32 * w;
        load_v_tile(C, P, r0, h, VV);
        __syncthreads();
        f32x16 o[2];
#pragma unroll
        for (int ti = 0; ti < 2; ++ti) {
            const int tt = 32 * ti + r32;
            bf16x8 qf[8];
#pragma unroll
            for (int s = 0; s < 8; ++s) qf[s] = *(const bf16x8*)(QT + (size_t)(r0 + tt) * 512 + h * 128 + 16 * s + 8 * hh);
            f32x16 acc = {};
            const bf16* srow = ST + ((size_t)unit * 256 + dv0 + r32) * 128 + 8 * hh;
#pragma unroll
            for (int s = 0; s < 8; ++s) { const bf16x8 af = *(const bf16x8*)(srow + 16 * s); acc = MFMA32(af, qf[s], acc); }
#pragma unroll
            for (int si = 0; si <= ti; ++si) {
                f32x16 X = {};
                const bf16* krow = KT + (size_t)(r0 + 32 * si + r32) * 512 + h * 128 + 8 * hh;
#pragma unroll
                for (int s = 0; s < 8; ++s) { const bf16x8 kf = *(const bf16x8*)(krow + 16 * s); X = MFMA32(kf, qf[s], X); }
                if (si == ti) {
#pragma unroll
                    for (int r = 0; r < 16; ++r) if (crow(r, hh) > r32) X[r] = 0.f;
                }
#pragma unroll
                for (int s2 = 0; s2 < 2; ++s2) { const bf16x8 pb = pack_acc(X, s2); const bf16x8 af = tr_frag_acc(VV, G_VS, 32 * si + 16 * s2, dv0, lane); acc = MFMA32(af, pb, acc); }
            }
            o[ti] = acc;
        }
#pragma unroll
        for (int ti = 0; ti < 2; ++ti) { float ss = 0.f;
#pragma unroll
            for (int r = 0; r < 16; ++r) ss += o[ti][r] * o[ti][r];
            ss += __shfl_xor(ss, 32); if (hh == 0) RED[w * 64 + 32 * ti + r32] = ss; }
        __syncthreads();
#pragma unroll
        for (int ti = 0; ti < 2; ++ti) {
            const int tt = 32 * ti + r32; float tot = 0.f;
#pragma unroll
            for (int ww = 0; ww < 8; ++ww) tot += RED[ww * 64 + tt];
            const float rstd = rsqrtf(tot * (1.f / 256.f) + EPS);
            const size_t prow = (size_t)(r0 + tt) * NPROJ + C_GR + h * 256; bf16* orow = OG + (size_t)(r0 + tt) * DM + h * 256;
#pragma unroll
            for (int m = 0; m < 4; ++m) { const int dv = dv0 + 8 * m + 4 * hh;
                const v2u gr = *(const v2u*)(P + prow + dv); const f32x4 gn = *(const f32x4*)(gnorm + h * 256 + dv);
                const float a0 = o[ti][4 * m] * rstd * gn[0] * siluf_(bflo(gr[0])), a1 = o[ti][4 * m + 1] * rstd * gn[1] * siluf_(bfhi(gr[0]));
                const float a2 = o[ti][4 * m + 2] * rstd * gn[2] * siluf_(bflo(gr[1])), a3 = o[ti][4 * m + 3] * rstd * gn[3] * siluf_(bfhi(gr[1]));
                v2u ov; ov.x = cvtpk(a0, a1); ov.y = cvtpk(a2, a3); *(v2u*)(orow + dv) = ov; }
        }
        __syncthreads();
    }
}
DI void phase_gla_sample(const Ctx& C) {
    const bf16* P = WSP(bf16, WS_PROJ); bf16* OG = WSP(bf16, WS_OG);
    const float* wup = C.in[16]; const float* bgate = C.in[17]; const float* gnorm = C.in[18]; const float* S0 = C.in[5];
    LAS float* QS = (LAS float*)C.lds; LAS float* KS = QS + 128; LAS float* AS = KS + 128; LAS float* GAs = AS + 128; LAS float* PART = GAs + 16; LAS float* RED = PART + 512;
    const int tid = C.tid;
    for (int unit = C.bid; unit < NSMP * 4; unit += C.G) {
        const int b = unit >> 2, h = unit & 3; const size_t prow = (size_t)(MPR + b) * NPROJ;
        if (tid < 16) GAs[tid] = bf2f(P[prow + C_GA + tid]);
        __syncthreads();
        if (tid < 128) { float x = bgate[h * 128 + tid];
#pragma unroll
            for (int r = 0; r < 16; ++r) x += GAs[r] * wup[(size_t)r * 512 + h * 128 + tid];
            AS[tid] = __expf(logsigf_(x) * (1.f / 16.f)); QS[tid] = bf2f(P[prow + C_GQ + h * 128 + tid]) * GLA_QS; KS[tid] = bf2f(P[prow + C_GK + h * 128 + tid]); }
        __syncthreads();
        const int dv = tid & 255, half = tid >> 8; const float v = bf2f(P[prow + C_GV + h * 256 + dv]);
        const float* s0 = S0 + ((size_t)unit * 128 + 64 * half) * 256 + dv; float* so = C.out + O_GLA_S + ((size_t)unit * 128 + 64 * half) * 256 + dv;
        float o = 0.f;
#pragma unroll 8
        for (int i = 0; i < 64; ++i) { const int dk = 64 * half + i; const float s = AS[dk] * s0[(size_t)i * 256] + KS[dk] * v; so[(size_t)i * 256] = s; o += QS[dk] * s; }
        PART[tid] = o;
        __syncthreads();
        float ov = 0.f, ss = 0.f;
        if (tid < 256) { ov = PART[tid] + PART[256 + tid]; ss = ov * ov; }
        ss = wave_sum(ss); if (C.lane == 0) RED[C.wave] = ss;
        __syncthreads();
        if (tid < 256) { const float tot = RED[0] + RED[1] + RED[2] + RED[3]; const float rstd = rsqrtf(tot * (1.f / 256.f) + EPS);
            const float val = ov * rstd * gnorm[h * 256 + tid] * siluf_(bf2f(P[prow + C_GR + h * 256 + tid]));
            OG[(size_t)(MPR + b) * DM + h * 256 + tid] = (bf16)(cvtpk(val, 0.f) & 0xffffu); }
        __syncthreads();
    }
}
constexpr int KSTR = 144;
constexpr int KV_TILE = 64 * KSTR;
DI void qk_tile(const LAS unsigned char* Kt, const bf16x8 (&qf)[4], int r32, int hh, f32x16& p0, f32x16& p1) {
    p0 = (f32x16){}; p1 = (f32x16){};
#pragma unroll
    for (int s = 0; s < 4; ++s) {
        const bf16x8 a0 = *(const LAS bf16x8*)(Kt + r32 * KSTR + 32 * s + 16 * hh), a1 = *(const LAS bf16x8*)(Kt + (32 + r32) * KSTR + 32 * s + 16 * hh);
        p0 = MFMA32(a0, qf[s], p0); p1 = MFMA32(a1, qf[s], p1);
    }
}
DI void pv_tile(const LAS unsigned char* Vt, const f32x16& p0, const f32x16& p1, f32x16& o0, f32x16& o1, int lane) {
#pragma unroll
    for (int kh = 0; kh < 2; ++kh)
#pragma unroll
        for (int s2 = 0; s2 < 2; ++s2) {
            const bf16x8 pb = pack_acc(kh ? p1 : p0, s2);
            const bf16x8 a0 = tr_frag_acc(Vt, KSTR, 32 * kh + 16 * s2, 0, lane), a1 = tr_frag_acc(Vt, KSTR, 32 * kh + 16 * s2, 32, lane);
            o0 = MFMA32(a0, pb, o0); o1 = MFMA32(a1, pb, o1);
        }
}
DI float max32(const f32x16& p0, const f32x16& p1) {
    float m = fmaxf(p0[0], p1[0]);
#pragma unroll
    for (int r = 1; r < 16; ++r) m = fmaxf(m, fmaxf(p0[r], p1[r]));
    return fmaxf(m, __shfl_xor(m, 32));
}
DI v4u ld_tile_row(const bf16* base, size_t pitch, int row0, int tid) { return *(const v4u*)(base + (size_t)(row0 + (tid >> 3)) * pitch + (tid & 7) * 8); }
DI void st_tile_row(LAS unsigned char* T, int tid, v4u v) { *(LAS v4u*)(T + (tid >> 3) * KSTR + (tid & 7) * 16) = v; }

DI bool attn_order(const Ctx& C, int i, int& bg, int& qt) {
    if (C.G == 256) { if (i >= 4) return false; const int s = C.bid & 31; bg = C.bid >> 5; qt = (i == 0) ? s : (i == 1) ? 63 - s : (i == 2) ? 64 + s : 127 - s; return true; }
    const int u = C.bid + i * C.G; if (u >= 1024) return false; bg = u >> 7; qt = u & 127; return true;
}

template <int MODE> DI void phase_attn_sw(const Ctx& C) {
    const bf16* P = WSP(bf16, WS_PROJ); const unsigned* SEL = WSP(unsigned, WS_SEL);
    const bf16* OC = WSP(bf16, WS_OC); const bf16* OWr = WSP(bf16, WS_OW); bf16* OUT = MODE == 1 ? WSP(bf16, WS_ONSA) : WSP(bf16, WS_OW);
    const int tid = C.tid, lane = C.lane, w = C.wave, r32 = lane & 31, hh = lane >> 5;
    LAS unsigned char* Kb = C.lds; LAS unsigned char* Vb = C.lds + 2 * KV_TILE;
    int bg, qt;
    for (int it = 0; attn_order(C, it, bg, qt); ++it) {
        const int b = bg >> 2, g = bg & 3, t0 = 64 * qt, tl = 8 * w + (r32 >> 2), t = t0 + tl, head = 4 * g + (r32 & 3);
        const size_t rowb = (size_t)b * SEQ; const size_t qrow = (rowb + t) * NPROJ;
        const bf16* Kp = P + rowb * NPROJ + (MODE == 1 ? C_KS : C_KW) + g * 128; const bf16* Vp = Kp + 64;
        bf16x8 qf[4];
#pragma unroll
        for (int s = 0; s < 4; ++s) qf[s] = *(const bf16x8*)(P + qrow + C_NQ + head * 64 + 16 * s + 8 * hh);
        v4u selw = (v4u){0u, 0u, 0u, 0u};
        if (MODE == 1) selw = *(const v4u*)(SEL + ((size_t)bg * SEQ + t) * 4);
        const int kt0 = MODE == 1 ? 0 : (qt >= 8 ? qt - 8 : 0);
        float m = -INFINITY, l = 0.f; f32x16 o0 = {}, o1 = {};
        v4u kreg = ld_tile_row(Kp, NPROJ, 64 * kt0, tid), vreg = ld_tile_row(Vp, NPROJ, 64 * kt0, tid);
        st_tile_row(Kb, tid, kreg); st_tile_row(Vb, tid, vreg);
        __syncthreads();
        for (int kt = kt0; kt <= qt; ++kt) {
            const int cur = (kt - kt0) & 1;
            if (kt < qt) { kreg = ld_tile_row(Kp, NPROJ, 64 * (kt + 1), tid); vreg = ld_tile_row(Vp, NPROJ, 64 * (kt + 1), tid); }
            f32x16 p0, p1;
            qk_tile(Kb + cur * KV_TILE, qf, r32, hh, p0, p1);
            if (MODE == 1) {
                const unsigned wsel = (kt < 32) ? selw[0] : (kt < 64) ? selw[1] : (kt < 96) ? selw[2] : selw[3];
                if (!((wsel >> (kt & 31)) & 1u)) {
#pragma unroll
                    for (int r = 0; r < 16; ++r) { p0[r] = -INFINITY; p1[r] = -INFINITY; }
                }
            }
            if (kt == qt) {
#pragma unroll
                for (int r = 0; r < 16; ++r) { const int kl = crow(r, hh); if (kl > tl) p0[r] = -INFINITY; if (kl + 32 > tl) p1[r] = -INFINITY; }
            }
            if (MODE == 2 && kt == qt - 8) {
#pragma unroll
                for (int r = 0; r < 16; ++r) { const int kl = crow(r, hh); if (kl <= tl) p0[r] = -INFINITY; if (kl + 32 <= tl) p1[r] = -INFINITY; }
            }
            const float mt = max32(p0, p1), mn = fmaxf(m, mt), mu = (mn == -INFINITY) ? 0.f : mn;
            const float alpha = __builtin_amdgcn_exp2f(m - mu); float rs = 0.f;
#pragma unroll
            for (int r = 0; r < 16; ++r) { p0[r] = __builtin_amdgcn_exp2f(p0[r] - mu); p1[r] = __builtin_amdgcn_exp2f(p1[r] - mu); rs += p0[r] + p1[r]; }
            l = l * alpha + rs; m = mn;
#pragma unroll
            for (int r = 0; r < 16; ++r) { o0[r] *= alpha; o1[r] *= alpha; }
            pv_tile(Vb + cur * KV_TILE, p0, p1, o0, o1, lane);
            if (kt < qt) { st_tile_row(Kb + (cur ^ 1) * KV_TILE, tid, kreg); st_tile_row(Vb + (cur ^ 1) * KV_TILE, tid, vreg); }
            __syncthreads();
        }
        const float lt = l + __shfl_xor(l, 32), inv = lt > 0.f ? 1.f / lt : 0.f;
        const float gate = sigmoidf_(bf2f(P[qrow + C_NG + head * 3 + (MODE == 1 ? 1 : 2)])) * inv;
        const size_t ooff = (rowb + t) * DM + head * 64;
#pragma unroll
        for (int dt = 0; dt < 2; ++dt)
#pragma unroll
            for (int mq = 0; mq < 4; ++mq) {
                const int d = 32 * dt + 8 * mq + 4 * hh; const f32x16& o = dt ? o1 : o0;
                float a0 = o[4 * mq] * gate, a1 = o[4 * mq + 1] * gate, a2 = o[4 * mq + 2] * gate, a3 = o[4 * mq + 3] * gate;
                if (MODE == 1) { const v2u c = *(const v2u*)(OC + ooff + d), ww = *(const v2u*)(OWr + ooff + d);
                    a0 += bflo(c[0]) + bflo(ww[0]); a1 += bfhi(c[0]) + bfhi(ww[0]); a2 += bflo(c[1]) + bflo(ww[1]); a3 += bfhi(c[1]) + bfhi(ww[1]); }
                v2u ov; ov.x = cvtpk(a0, a1); ov.y = cvtpk(a2, a3); *(v2u*)(OUT + ooff + d) = ov;
            }
    }
}

DI unsigned topk_select(const LAS float* IMP, int lane, int cur) {
    const int tlw = lane >> 3, sub = lane & 7;
    unsigned key[16]; unsigned fb = 0u;
#pragma unroll
    for (int i = 0; i < 16; ++i) { const int j = 16 * sub + i; const bool forced = (j == 0) || (j == cur) || (j == cur - 1); const bool cand = (j <= cur) && !forced;
        key[i] = cand ? (__float_as_uint(fmaxf(IMP[tlw * 128 + j], 0.f)) + 1u) : 0u; if (forced && j <= cur) fb |= 1u << i; }
    const int nforced = cur == 0 ? 1 : (cur == 1 ? 2 : 3), krem = 16 - nforced;
    unsigned T = 0u;
    for (int bit = 30; bit >= 0; --bit) { const unsigned Tn = T | (1u << bit); int cnt = 0;
#pragma unroll
        for (int i = 0; i < 16; ++i) cnt += (key[i] >= Tn) ? 1 : 0;
        cnt = sum8_i(cnt); if (cnt >= krem) T = Tn; }
    unsigned bits = 0u;
    if (T == 0u) {
#pragma unroll
        for (int i = 0; i < 16; ++i) bits |= (key[i] >= 1u ? 1u : 0u) << i;
    } else {
        int ngt = 0, neq = 0;
#pragma unroll
        for (int i = 0; i < 16; ++i) { ngt += (key[i] > T) ? 1 : 0; neq += (key[i] == T) ? 1 : 0; }
        const int need = krem - sum8_i(ngt);
        int run = 0;
#pragma unroll
        for (int s = 0; s < 8; ++s) { const int c = __shfl(neq, (lane & ~7) + s); if (s < sub) run += c; }
#pragma unroll
        for (int i = 0; i < 16; ++i) { if (key[i] > T) bits |= 1u << i; else if (key[i] == T) { if (run < need) bits |= 1u << i; ++run; } }
    }
    return bits | fb;
}

DI void phase_attn_cmp(const Ctx& C) {
    const bf16* P = WSP(bf16, WS_PROJ); unsigned* SEL = WSP(unsigned, WS_SEL); bf16* OC = WSP(bf16, WS_OC);
    const bf16* KVC = WSP(bf16, WS_KVC);
    const int tid = C.tid, lane = C.lane, w = C.wave, r32 = lane & 31, hh = lane >> 5;
    LAS unsigned char* Kb = C.lds; LAS unsigned char* Vb = C.lds + 2 * KV_TILE;
    LAS float* PS = (LAS float*)(C.lds + 4 * KV_TILE + w * 6400);
    LAS float* IMP = PS + 8 * 66 + 8;
    int bg, qt;
    for (int it = 0; attn_order(C, it, bg, qt); ++it) {
        const int b = bg >> 2, g = bg & 3, t0 = 64 * qt, tl = 8 * w + (r32 >> 2), t = t0 + tl, head = 4 * g + (r32 & 3);
        const size_t rowb = (size_t)b * SEQ; const size_t qrow = (rowb + t) * NPROJ;
        const bf16* Kp = KVC + ((size_t)CHK_S + (size_t)bg * 512) * 64; const bf16* Vp = Kp + (size_t)CHK_ROWS * 64;
        bf16x8 qf[4];
#pragma unroll
        for (int s = 0; s < 4; ++s) qf[s] = *(const bf16x8*)(P + qrow + C_NQ + head * 64 + 16 * s + 8 * hh);
        const int ntiles = (((t0 + 32) >> 4) >> 6) + 1;
        const int nmax = t >= 31 ? ((t - 31) >> 4) : -1;
        for (int i = lane; i < 8 * 128; i += 64) IMP[i] = 0.f;
        if (lane < 8) PS[lane * 66] = 0.f;
        float m = -INFINITY, l = 0.f;
        v4u kreg = ld_tile_row(Kp, 64, 0, tid), vreg;
        st_tile_row(Kb, tid, kreg);
        __syncthreads();
        for (int kt = 0; kt < ntiles; ++kt) {
            const int cur = kt & 1;
            if (kt + 1 < ntiles) kreg = ld_tile_row(Kp, 64, 64 * (kt + 1), tid);
            f32x16 p0, p1;
            qk_tile(Kb + cur * KV_TILE, qf, r32, hh, p0, p1);
#pragma unroll
            for (int r = 0; r < 16; ++r) { const int n = 64 * kt + crow(r, hh); if (n > nmax) p0[r] = -INFINITY; if (n + 32 > nmax) p1[r] = -INFINITY; }
            const float mt = max32(p0, p1), mn = fmaxf(m, mt), mu = (mn == -INFINITY) ? 0.f : mn;
            const float alpha = __builtin_amdgcn_exp2f(m - mu); float rs = 0.f;
#pragma unroll
            for (int r = 0; r < 16; ++r) rs += __builtin_amdgcn_exp2f(p0[r] - mu) + __builtin_amdgcn_exp2f(p1[r] - mu);
            l = l * alpha + rs; m = mn;
            if (kt + 1 < ntiles) st_tile_row(Kb + (cur ^ 1) * KV_TILE, tid, kreg);
            __syncthreads();
        }
        const float lt = l + __shfl_xor(l, 32), inv = lt > 0.f ? 1.f / lt : 0.f, mu = (m == -INFINITY) ? 0.f : m;
        f32x16 o0 = {}, o1 = {};
        kreg = ld_tile_row(Kp, 64, 0, tid); vreg = ld_tile_row(Vp, 64, 0, tid);
        st_tile_row(Kb, tid, kreg); st_tile_row(Vb, tid, vreg);
        __syncthreads();
        for (int kt = 0; kt < ntiles; ++kt) {
            const int cur = kt & 1;
            if (kt + 1 < ntiles) { kreg = ld_tile_row(Kp, 64, 64 * (kt + 1), tid); vreg = ld_tile_row(Vp, 64, 64 * (kt + 1), tid); }
            f32x16 p0, p1;
            qk_tile(Kb + cur * KV_TILE, qf, r32, hh, p0, p1);
#pragma unroll
            for (int r = 0; r < 16; ++r) { const int n = 64 * kt + crow(r, hh);
                p0[r] = (n > nmax) ? 0.f : __builtin_amdgcn_exp2f(p0[r] - mu) * inv; p1[r] = (n + 32 > nmax) ? 0.f : __builtin_amdgcn_exp2f(p1[r] - mu) * inv; }
            pv_tile(Vb + cur * KV_TILE, p0, p1, o0, o1, lane);
#pragma unroll
            for (int r = 0; r < 16; ++r) { const float s0 = quad_sum(p0[r]), s1 = quad_sum(p1[r]);
                if ((r32 & 3) == 0) { PS[(r32 >> 2) * 66 + 1 + crow(r, hh)] = s0; PS[(r32 >> 2) * 66 + 33 + crow(r, hh)] = s1; } }
            LDS_WAIT();
            { const int tk = lane >> 3, j0 = (lane & 7) * 2;
#pragma unroll
              for (int e = 0; e < 2; ++e) { const LAS float* ps = PS + tk * 66 + 1 + 4 * (j0 + e);
                  IMP[tk * 128 + 16 * kt + j0 + e] = ps[-1] + 2.f * (ps[0] + ps[1] + ps[2]) + ps[3]; } }
            LDS_WAIT();
            if (lane < 8) PS[lane * 66] = PS[lane * 66 + 64];
            LDS_WAIT();
            if (kt + 1 < ntiles) { st_tile_row(Kb + (cur ^ 1) * KV_TILE, tid, kreg); st_tile_row(Vb + (cur ^ 1) * KV_TILE, tid, vreg); }
            __syncthreads();
        }
        {
            const float gate = sigmoidf_(bf2f(P[qrow + C_NG + head * 3 + 0]));
            const size_t ooff = (rowb + t) * DM + head * 64;
#pragma unroll
            for (int dt = 0; dt < 2; ++dt)
#pragma unroll
                for (int mq = 0; mq < 4; ++mq) { const int d = 32 * dt + 8 * mq + 4 * hh; const f32x16& o = dt ? o1 : o0;
                    v2u ov; ov.x = cvtpk(o[4 * mq] * gate, o[4 * mq + 1] * gate); ov.y = cvtpk(o[4 * mq + 2] * gate, o[4 * mq + 3] * gate); *(v2u*)(OC + ooff + d) = ov; }
        }
        {
            const int sub = lane & 7, tk = lane >> 3;
            const unsigned bits = topk_select(IMP, lane, qt);
            unsigned wv = bits << (16 * (sub & 1)); wv |= (unsigned)dpp_i<0xB1>((int)wv);
            if ((sub & 1) == 0) SEL[((size_t)bg * SEQ + t0 + 8 * w + tk) * 4 + (sub >> 1)] = wv;
        }
        __syncthreads();
    }
}

template <int MODE> DI f32x4 smp_load(const Ctx& C, int b, int g, int n, int c, int i, const LAS int* blk) {
    if (MODE == 0) { const bf16* src = WSP(bf16, WS_KVC) + ((size_t)c * CHK_ROWS + (size_t)(b * 4 + g) * 512 + n) * 64 + 4 * i; const v2u v = *(const v2u*)src; return (f32x4){bflo(v[0]), bfhi(v[0]), bflo(v[1]), bfhi(v[1])}; }
    if (MODE == 1) {
        const int tok = blk[n >> 6] * 64 + (n & 63);
        if (tok >= PAST) { const bf16* src = WSP(bf16, WS_PROJ) + (size_t)(MPR + b) * NPROJ + C_KS + g * 128 + c * 64 + 4 * i; const v2u v = *(const v2u*)src; return (f32x4){bflo(v[0]), bfhi(v[0]), bflo(v[1]), bfhi(v[1])}; }
        const int page = ((const int*)C.in[7])[b * NPAGES + (tok >> 7)];
        return *(const f32x4*)(C.in[3] + ((size_t)page * PAGE + (tok & 127)) * 512 + g * 128 + c * 64 + 4 * i);
    }
    if (n >= 512) { const bf16* src = WSP(bf16, WS_PROJ) + (size_t)(MPR + b) * NPROJ + C_KW + g * 128 + c * 64 + 4 * i; const v2u v = *(const v2u*)src; return (f32x4){bflo(v[0]), bfhi(v[0]), bflo(v[1]), bfhi(v[1])}; }
    return *(const f32x4*)(C.in[4] + ((size_t)(b * 512 + n)) * 512 + g * 128 + c * 64 + 4 * i);
}
template <int MODE> DI bool smp_valid(int n, const LAS int* blk) {
    if (MODE == 0) return n < 511;
    if (MODE == 1) return blk[n >> 6] * 64 + (n & 63) <= PAST;
    return n >= 1;
}
template <int MODE> DI void smp_branch(const Ctx& C, int b, int g, int N, const f32x4 (&qv)[4], LAS float* SC, LAS float* RED, const LAS int* blkl, float& fin) {
    const int tid = C.tid, i = tid & 15, grp = tid >> 4, lane = C.lane, w = C.wave;
    const LAS int* blk = blkl;
    for (int n = grp; n < N; n += 32) {
        const f32x4 kv = smp_load<MODE>(C, b, g, n, 0, i, blk);
        float part[4];
#pragma unroll
        for (int h = 0; h < 4; ++h) part[h] = sum16_f(qv[h][0] * kv[0] + qv[h][1] * kv[1] + qv[h][2] * kv[2] + qv[h][3] * kv[3]);
        if (i == 0) { const bool ok = smp_valid<MODE>(n, blk);
#pragma unroll
            for (int h = 0; h < 4; ++h) SC[h * 1056 + n] = ok ? part[h] : -INFINITY; }
    }
    __syncthreads();
    if (w < 4) {
        float m = -INFINITY;
        for (int n = lane; n < N; n += 64) m = fmaxf(m, SC[w * 1056 + n]);
        m = wave_max(m); const float mu = (m == -INFINITY) ? 0.f : m;
        float s = 0.f;
        for (int n = lane; n < N; n += 64) { const float e = __builtin_amdgcn_exp2f(SC[w * 1056 + n] - mu); SC[w * 1056 + n] = e; s += e; }
        s = wave_sum(s); const float inv = s > 0.f ? 1.f / s : 0.f;
        for (int n = lane; n < N; n += 64) SC[w * 1056 + n] *= inv;
    }
    __syncthreads();
    f32x4 acc[4] = {};
    for (int n = grp; n < N; n += 32) {
        const f32x4 v = smp_load<MODE>(C, b, g, n, 1, i, blk);
#pragma unroll
        for (int h = 0; h < 4; ++h) acc[h] += v * SC[h * 1056 + n];
    }
#pragma unroll
    for (int h = 0; h < 4; ++h) *(LAS f32x4*)(RED + (grp * 4 + h) * 64 + 4 * i) = acc[h];
    __syncthreads();
    if (tid < 256) { const int h = tid >> 6, d = tid & 63; float s = 0.f;
#pragma unroll 8
        for (int gq = 0; gq < 32; ++gq) s += RED[(gq * 4 + h) * 64 + d];
        const float gate = sigmoidf_(bf2f(WSP(bf16, WS_PROJ)[(size_t)(MPR + b) * NPROJ + C_NG + (4 * g + h) * 3 + MODE]));
        fin += gate * s; }
    __syncthreads();
}
DI void phase_nsa_sample(const Ctx& C) {
    const bf16* P = WSP(bf16, WS_PROJ); bf16* ONSA = WSP(bf16, WS_ONSA);
    LAS float* SC = (LAS float*)C.lds;
    LAS float* RED = SC + 4 * 1056;
    LAS float* IMPS = RED + 32 * 4 * 64;
    LAS float* PSM = IMPS + 8 * 128;
    LAS int* BLK = (LAS int*)(PSM + 528);
    LAS unsigned* SELW = (LAS unsigned*)(BLK + 16);
    const int tid = C.tid, i = tid & 15, lane = C.lane, w = C.wave;
    for (int unit = C.bid; unit < NSMP * 4; unit += C.G) {
        const int b = unit >> 2, g = unit & 3; const size_t prow = (size_t)(MPR + b) * NPROJ;
        f32x4 qv[4];
#pragma unroll
        for (int h = 0; h < 4; ++h) { const v2u v = *(const v2u*)(P + prow + C_NQ + (4 * g + h) * 64 + 4 * i); qv[h] = (f32x4){bflo(v[0]), bfhi(v[0]), bflo(v[1]), bfhi(v[1])}; }
        float fin = 0.f;
        smp_branch<0>(C, b, g, 511, qv, SC, RED, BLK, fin);
        for (int n = tid; n < 520; n += 512) { const int nn = n - 4; PSM[n] = (nn >= 0 && nn < 511) ? (SC[nn] + SC[1056 + nn] + SC[2 * 1056 + nn] + SC[3 * 1056 + nn]) : 0.f; }
        __syncthreads();
        for (int j = tid; j < 8 * 128; j += 512) { const int jj = j & 127; const LAS float* ps = PSM + 4 + 4 * jj; IMPS[j] = ps[-1] + 2.f * (ps[0] + ps[1] + ps[2]) + ps[3]; }
        __syncthreads();
        if (w == 0) {
            const int sub = lane & 7; const unsigned bits = topk_select(IMPS, lane, 128);
            unsigned wv = bits << (16 * (sub & 1)); wv |= (unsigned)dpp_i<0xB1>((int)wv);
            if (lane < 8 && (sub & 1) == 0) SELW[sub >> 1] = wv;
        }
        __syncthreads();
        if (tid == 0) { int c = 0; for (int j = 0; j < 128; ++j) if ((SELW[j >> 5] >> (j & 31)) & 1u) { if (c < 15) BLK[c] = j; ++c; } BLK[15] = 128; for (; c < 15; ++c) BLK[c] = 128; }
        __syncthreads();
        smp_branch<1>(C, b, g, 1024, qv, SC, RED, BLK, fin);
        smp_branch<2>(C, b, g, 513, qv, SC, RED, BLK, fin);
        if (tid < 256) ONSA[(size_t)(MPR + b) * DM + (4 * g + (tid >> 6)) * 64 + (tid & 63)] = (bf16)(cvtpk(fin, 0.f) & 0xffffu);
        __syncthreads();
    }
}
#ifndef MK_ONE_LAUNCH
#define MK_ONE_LAUNCH 1
#endif
constexpr int N_PHASES = 15;
struct Args { const float* in[33]; float* out; unsigned char* ws; int ph_lo, ph_hi; };
static_assert(sizeof(Args) == 33 * 8 + 8 + 8 + 8, "Args has no padding");

template <class Epi> DI void run_gemm(const Ctx& C, const bf16* A, const bf16* Bt, int M, int N, int K, const Epi& E) {
    pg8::Gemm g{A, Bt, M, N, K}; pg8::StaticOrder S; S.init(M, N, C.G, C.bid);
    pg8::gemm_phase<Epi, pg8::StaticOrder, true, true>(C.lds, g, S, E);
}

__global__ void __launch_bounds__(512, 2) fwd_kernel(Args args) {
    extern __shared__ __attribute__((aligned(16))) unsigned char lds_raw[];
    Ctx C;
    C.lds = (LAS unsigned char*)lds_raw;
    C.tid = threadIdx.x; C.lane = C.tid & 63; C.wave = __builtin_amdgcn_readfirstlane(C.tid >> 6);
    C.G = gridDim.x; C.bid = blockIdx.x;
#pragma unroll
    for (int i = 0; i < 33; ++i) C.in[i] = args.in[i];
    C.out = args.out; C.ws = args.ws;
    volatile LAS unsigned* MISC = (volatile LAS unsigned*)(C.lds + MISC_OFF);
    if (C.tid < 32) MISC[C.tid] = 0u;
    __syncthreads();
    XcdBarrier bar; bar.bar = (unsigned*)(args.ws + WS_CTL) + CW_BAR; bar.x = 0; bar.st = nullptr;
    if (MK_ONE_LAUNCH) bar = xcd_barrier_post((unsigned*)(args.ws + WS_CTL) + CW_BAR, MISC + 8);
    const int lo = args.ph_lo, hi = args.ph_hi;
#define IN(k) (lo <= (k) && (k) < hi)
#define SEAM(k) do { if (IN(k) && IN((k) + 1)) { if (MK_ONE_LAUNCH) xcd_barrier(bar); } } while (0)

    if (IN(0)) { phase_prologue(C); __syncthreads(); }
    SEAM(0);
    if (IN(1)) {
        { pg8::EpiProj E{WSP(bf16, WS_PROJ), C.out}; run_gemm(C, WSP(bf16, WS_XN), WSP(bf16, WS_WIN_T), MP, NPROJ, DM, E); }
        __syncthreads();
        { pg8::EpiStore<false> E{WSP(bf16, WS_PP), DM, nullptr}; run_gemm(C, WSP(bf16, WS_PB), WSP(bf16, WS_WPP_T), MP, DM, PLE, E); }
    }
    SEAM(1);
    if (IN(2)) { phase_chk_prompt(C); phase_g1(C); __syncthreads(); phase_attn_sw<2>(C); __syncthreads(); phase_gla_sample(C); __syncthreads(); }
    SEAM(2);
    if (IN(3)) {
        phase_g2(C); __syncthreads();
#pragma unroll
        for (int c = 0; c < 2; ++c) {
            pg8::EpiStore<false> E{WSP(bf16, WS_T) + (size_t)c * CHK_ROWS * 256, 256, nullptr};
            run_gemm(C, WSP(bf16, WS_CHK) + (size_t)c * CHK_ROWS * 1024, WSP(bf16, WS_W1_T) + (size_t)c * 256 * 1024, CHK_ROWS, 256, 1024, E);
            __syncthreads();
        }
    }
    SEAM(3);
    if (IN(4)) { phase_kvc(C); __syncthreads(); phase_g3(C); __syncthreads(); }
    SEAM(4);
    if (IN(5)) {
        phase_attn_cmp(C); __syncthreads(); phase_nsa_sample(C); __syncthreads();
        { pg8::EpiStore<false> E{WSP(bf16, WS_YG), DM, nullptr}; run_gemm(C, WSP(bf16, WS_OG), WSP(bf16, WS_WGO_T), MP, DM, DM, E); }
    }
    SEAM(5);
    if (IN(6)) { phase_attn_sw<1>(C); __syncthreads(); }
    SEAM(6);
    if (IN(7)) { pg8::EpiMix E{WSP(bf16, WS_PROJ), WSP(bf16, WS_YG), WSP(bf16, WS_MIX)}; run_gemm(C, WSP(bf16, WS_ONSA), WSP(bf16, WS_WNO_T), MP, DM, DM, E); }
    SEAM(7);
    if (IN(8)) { pg8::EpiF32 E{WSP(float, WS_T1), DM}; run_gemm(C, WSP(bf16, WS_MIX), WSP(bf16, WS_WOUT_T), MP, DM, DM, E); }
    SEAM(8);
    if (IN(9)) { phase_rownorm(C, WSP(float, WS_T1), C.in[0], C.in[1], C.in[11], C.in[12], WSP(float, WS_X1), WSP(bf16, WS_XN)); }
    SEAM(9);
    if (IN(10)) { pg8::EpiStore<true> E{WSP(bf16, WS_UP), NUP, C.out}; run_gemm(C, WSP(bf16, WS_XN), WSP(bf16, WS_WUP_T), MP, NUP, DM, E); }
    SEAM(10);
    if (IN(11)) { phase_conv(C); }
    SEAM(11);
    if (IN(12)) { pg8::EpiF32 E{WSP(float, WS_T1), DM}; run_gemm(C, WSP(bf16, WS_H), WSP(bf16, WS_WDN_T), MP, DM, DFF, E); }
    SEAM(12);
    if (IN(13)) { phase_rownorm(C, WSP(float, WS_T1), WSP(float, WS_X1), WSP(float, WS_X1) + (size_t)MPR * DM, C.in[13], C.in[14], WSP(float, WS_X2), WSP(bf16, WS_XN)); }
    SEAM(13);
    if (IN(14)) { pg8::EpiFinal E{WSP(float, WS_X2), WSP(bf16, WS_PP), C.out}; run_gemm(C, WSP(bf16, WS_XN), WSP(bf16, WS_WPG_T), MP, DM, DM, E); }
#undef IN
#undef SEAM
}

extern "C" void kernel_launch(void* const* d_in, const int* in_sizes, int n_in, void* d_out, int out_size, void* d_ws, size_t ws_size, hipStream_t stream) {
    static int grid = 0;
    if (grid == 0) {
        if (n_in != 33 || (size_t)out_size != O_END || ws_size < WS_END) { fprintf(stderr, "kernel_launch: unexpected shapes (n_in %d, out %d, ws %zu, need %zu)\n", n_in, out_size, ws_size, (size_t)WS_END); grid = -1; return; }
        int dev = 0, cus = 0, per_cu = 0;
        if (hipGetDevice(&dev) != hipSuccess || hipDeviceGetAttribute(&cus, hipDeviceAttributeMultiprocessorCount, dev) != hipSuccess) { grid = -1; return; }
        if (hipFuncSetAttribute((const void*)fwd_kernel, hipFuncAttributeMaxDynamicSharedMemorySize, LDS_BYTES) != hipSuccess) { fprintf(stderr, "kernel_launch: hipFuncSetAttribute failed\n"); grid = -1; return; }
        if (hipOccupancyMaxActiveBlocksPerMultiprocessor(&per_cu, (const void*)fwd_kernel, 512, LDS_BYTES) != hipSuccess || per_cu < 1) fprintf(stderr, "kernel_launch: occupancy query says %d\n", per_cu);
        (void)hipGetLastError();
        grid = cus;
    }
    if (grid < 0) return;
    (void)hipMemsetAsync((char*)d_ws + WS_CTL, 0, CTL_BYTES, stream);
    Args a{};
    for (int i = 0; i < 33; ++i) a.in[i] = (const float*)d_in[i];
    a.out = (float*)d_out; a.ws = (unsigned char*)d_ws;
#if MK_ONE_LAUNCH
    a.ph_lo = 0; a.ph_hi = N_PHASES;
    hipLaunchKernelGGL(fwd_kernel, dim3(grid), dim3(512), LDS_BYTES, stream, a);
#else
    for (int p = 0; p < N_PHASES; ++p) { a.ph_lo = p; a.ph_hi = p + 1; hipLaunchKernelGGL(fwd_kernel, dim3(grid), dim3(512), LDS_BYTES, stream, a); }
#endif
    const hipError_t le = hipPeekAtLastError();
    if (le != hipSuccess) fprintf(stderr, "kernel_launch: launch failed: %s\n", hipGetErrorName(le));
}
```

```cpp
#include <hip/hip_runtime.h>
#include <hip/hip_bf16.h>
#include <cstdio>
#include <cstdint>
#define MK_ONE_LAUNCH 1
namespace pg8 {
#define PG8_LAS __attribute__((address_space(3)))
typedef unsigned short bf16_t;
typedef short bf16x8 __attribute__((ext_vector_type(8)));
typedef float f32x4 __attribute__((ext_vector_type(4)));
typedef unsigned u32x4 __attribute__((ext_vector_type(4)));
constexpr int BM = 256, BK = 64, HALF = 128, HTB = HALF * BK * 2  , STAGE_BYTES = 8 * HTB, NXCD = 8, WGM = 8;

__host__ __device__ __forceinline__ int lds_byte(int r, int c) { const int st = (r >> 4) * 2 + (c >> 5), rr = r & 15, cc = c & 31, ob = rr * 64 + cc * 2; return st * 1024 + (ob ^ (((ob >> 9) & 1) << 5)); }
__host__ __device__ __forceinline__ void stage_rc(int b, int& R, int& C) { const int st = b / 1024, sb = b % 1024, swz = sb ^ (((sb >> 9) & 1) << 5); R = (st >> 1) * 16 + swz / 64; C = (st & 1) * 32 + (swz % 64) / 2; }
__host__ __device__ __forceinline__ int perm32(int rho) { const int n = rho >> 4, i = rho & 15; return 8 * (i >> 2) + 4 * n + (i & 3); }

struct Unit { int pm, pn; };
struct Gemm { const bf16_t* A; const bf16_t* Bt; int M, N, K; };

struct StaticOrder {
    int nM, nN, nwg, G, c;
    __host__ __device__ void init(int M, int N, int G_, int c_) { nM = M / BM; nN = N / BM; nwg = nM * nN; G = G_; c = c_; }
    __host__ __device__ bool next(int i, Unit& u) const {
        const long L = (long)i * G + c; if (L >= nwg) return false;
        int wgid = (int)L; { const int q = nwg / NXCD, r = nwg % NXCD, xcd = wgid % NXCD, off = wgid / NXCD; wgid = (xcd < r ? xcd * (q + 1) : r * (q + 1) + (xcd - r) * q) + off; }
        const int nig = WGM * nN, gid = wgid / nig, fm = gid * WGM, gsz = (nM - fm) < WGM ? (nM - fm) : WGM;
        u.pm = fm + ((wgid % nig) % gsz); u.pn = (wgid % nig) / gsz; return true;
    }
    __device__ __forceinline__ void a_ready(const Unit&) const {}
    __device__ __forceinline__ void done(const Unit&) const {}
};

__device__ __forceinline__ unsigned cvt_pk_bf16(float lo, float hi) { unsigned r; asm volatile("v_cvt_pk_bf16_f32 %0, %1, %2" : "=v"(r) : "v"(lo), "v"(hi)); return r; }
typedef float f32x2 __attribute__((ext_vector_type(2)));
template <class Epi, class Sched, bool ALIGN_EPI = false, bool SP2 = false>
__device__ __forceinline__ void gemm_phase(PG8_LAS unsigned char* lds, const Gemm g, const Sched& S, const Epi& E) {
    const int tid = threadIdx.x, wid = __builtin_amdgcn_readfirstlane(tid >> 6), lane = tid & 63, wr = wid >> 2, wc = wid & 3, fr = lane & 15, fq = lane >> 4;
    const int K = g.K, nt = K / BK;
    unsigned voffA[2], voffB[2];
#pragma unroll
    for (int i = 0; i < 2; ++i) { int R, C; stage_rc(tid * 16 + i * 8192, R, C); const int Rb = Epi::PERM ? ((R & ~31) + perm32(R & 31)) : R;
        voffA[i] = (unsigned)(R * K + C) * 2u; voffB[i] = (unsigned)(Rb * K + C) * 2u; }
    const size_t kstep = (size_t)(BK * 2);
    const size_t hstep = (size_t)HALF * K * 2;
    const size_t tstep = 2 * hstep;
    const unsigned ldsw = (unsigned)wid * 1024u;
    const int aoff = lds_byte(wr * 64 + fr, fq * 8), boff = lds_byte(wc * 32 + fr, fq * 8);
#define PG8_SA(b, h) (((b) * 2 + (h)) * HTB)
#define PG8_SB(b, h) ((4 + (b) * 2 + (h)) * HTB)
#define PG8_STAGE(bufoff, gbase, voff) do { _Pragma("unroll") for (int _i = 0; _i < 2; ++_i) \
        __builtin_amdgcn_global_load_lds((const unsigned*)((const char*)(gbase) + (voff)[_i]), (PG8_LAS unsigned*)(lds + (bufoff) + ldsw + _i * 8192), 16, 0, 0); } while (0)
#define PG8_LDA(dst, b, h) do { _Pragma("unroll") for (int m = 0; m < 4; ++m) _Pragma("unroll") for (int k = 0; k < 2; ++k) dst[m][k] = *(const PG8_LAS bf16x8*)(lds + PG8_SA(b, h) + aoff + m * 2048 + k * 1024); } while (0)
#define PG8_LDB(dst, b, h) do { _Pragma("unroll") for (int n = 0; n < 2; ++n) _Pragma("unroll") for (int k = 0; k < 2; ++k) dst[n][k] = *(const PG8_LAS bf16x8*)(lds + PG8_SB(b, h) + boff + n * 2048 + k * 1024); } while (0)
#define PG8_MMA(ai, bj, At, Bt) do { __builtin_amdgcn_s_setprio(1); _Pragma("unroll") for (int m = 0; m < 4; ++m) _Pragma("unroll") for (int n = 0; n < 2; ++n) _Pragma("unroll") for (int k = 0; k < 2; ++k) \
        acc[ai][bj][m][n] = __builtin_amdgcn_mfma_f32_16x16x32_bf16(Bt[n][k], At[m][k], acc[ai][bj][m][n], 0, 0, 0); __builtin_amdgcn_s_setprio(0); } while (0)
#define PG8_WAIT_V(n) asm volatile("s_waitcnt vmcnt(" #n ")" ::: "memory")
#define PG8_WAIT_L(n) asm volatile("s_waitcnt lgkmcnt(" #n ")" ::: "memory")
#define PG8_BAR __builtin_amdgcn_s_barrier()
#define PG8_SCHED __builtin_amdgcn_sched_barrier(0)
    Unit cur, nxt; int ui = 0;
    if (!S.next(0, cur)) return;
    f32x4 acc[2][2][4][2];
#pragma unroll
    for (int a = 0; a < 2; ++a)
#pragma unroll
        for (int b = 0; b < 2; ++b)
#pragma unroll
            for (int m = 0; m < 4; ++m)
#pragma unroll
                for (int n = 0; n < 2; ++n) acc[a][b][m][n] = (f32x4){0.f, 0.f, 0.f, 0.f};
    bf16x8 At[4][2], B0[2][2], B1[2][2];
    const char* cA = (const char*)g.A + (size_t)cur.pm * tstep; const char* cB = (const char*)g.Bt + (size_t)cur.pn * tstep;
    S.a_ready(cur);
    if constexpr (SP2) {
        PG8_STAGE(PG8_SB(0, 0), cB, voffB); PG8_STAGE(PG8_SB(0, 1), cB + hstep, voffB); PG8_STAGE(PG8_SA(0, 0), cA, voffA); PG8_STAGE(PG8_SA(0, 1), cA + hstep, voffA);
        if (wr == 1) PG8_BAR;
        PG8_WAIT_V(2); PG8_BAR;
        PG8_STAGE(PG8_SB(1, 0), cB + kstep, voffB); PG8_STAGE(PG8_SA(1, 0), cA + kstep, voffA); PG8_STAGE(PG8_SB(1, 1), cB + hstep + kstep, voffB);
        PG8_WAIT_V(6); PG8_BAR;
    } else {
        PG8_STAGE(PG8_SB(0, 0), cB, voffB); PG8_STAGE(PG8_SA(0, 0), cA, voffA); PG8_STAGE(PG8_SB(0, 1), cB + hstep, voffB); PG8_STAGE(PG8_SA(0, 1), cA + hstep, voffA);
        if (wr == 1) PG8_BAR;
        PG8_WAIT_V(4); PG8_BAR;
        PG8_STAGE(PG8_SB(1, 0), cB + kstep, voffB); PG8_STAGE(PG8_SA(1, 0), cA + kstep, voffA); PG8_STAGE(PG8_SB(1, 1), cB + hstep + kstep, voffB);
        PG8_WAIT_V(6); PG8_BAR;
    }
    for (;;) {
        const bool has_next = S.next(ui + 1, nxt);
        const char* nA = has_next ? (const char*)g.A + (size_t)nxt.pm * tstep : cA; const char* nB = has_next ? (const char*)g.Bt + (size_t)nxt.pn * tstep : cB;
        for (int t = 0; t < nt; t += 2) {
            const bool last = (t == nt - 2);
            const char* a1 = cA + (size_t)(t + 1) * kstep;
            const char* a2 = last ? nA : cA + (size_t)(t + 2) * kstep; const char* b2 = last ? nB : cB + (size_t)(t + 2) * kstep;
            const char* a3 = a2 + kstep; const char* b3 = b2 + kstep;
            if (last && has_next) S.a_ready(nxt);
            if constexpr (SP2) {
            PG8_LDB(B0, 0, 0); PG8_LDB(B1, 0, 1); PG8_SCHED; PG8_LDA(At, 0, 0); PG8_STAGE(PG8_SA(1, 1), a1 + hstep, voffA);
            PG8_WAIT_V(8); PG8_WAIT_L(0); PG8_BAR; PG8_MMA(0, 0, At, B0); PG8_MMA(0, 1, At, B1); PG8_BAR; PG8_SCHED;
            PG8_LDA(At, 0, 1); PG8_STAGE(PG8_SB(0, 0), b2, voffB); PG8_STAGE(PG8_SB(0, 1), b2 + hstep, voffB); PG8_STAGE(PG8_SA(0, 0), a2, voffA);
            PG8_WAIT_V(8); PG8_WAIT_L(0); PG8_BAR; PG8_MMA(1, 0, At, B0); PG8_MMA(1, 1, At, B1); PG8_BAR; PG8_SCHED;
            PG8_LDB(B0, 1, 0); PG8_LDB(B1, 1, 1); PG8_SCHED; PG8_LDA(At, 1, 0); PG8_STAGE(PG8_SA(0, 1), a2 + hstep, voffA);
            PG8_WAIT_V(8); PG8_WAIT_L(0); PG8_BAR; PG8_MMA(0, 0, At, B0); PG8_MMA(0, 1, At, B1); PG8_BAR; PG8_SCHED;
            PG8_LDA(At, 1, 1); PG8_STAGE(PG8_SB(1, 0), b3, voffB); PG8_STAGE(PG8_SB(1, 1), b3 + hstep, voffB); PG8_STAGE(PG8_SA(1, 0), a3, voffA);
            PG8_WAIT_V(8); PG8_WAIT_L(0); PG8_BAR; PG8_MMA(1, 0, At, B0); PG8_MMA(1, 1, At, B1); PG8_BAR; PG8_SCHED;
            } else {
            PG8_LDB(B0, 0, 0); PG8_SCHED; PG8_LDA(At, 0, 0); PG8_STAGE(PG8_SA(1, 1), a1 + hstep, voffA);
            PG8_WAIT_L(8); PG8_BAR; PG8_WAIT_L(0); PG8_MMA(0, 0, At, B0); PG8_BAR; PG8_SCHED;
            PG8_LDB(B1, 0, 1); PG8_STAGE(PG8_SB(0, 0), b2, voffB);
            PG8_BAR; PG8_WAIT_L(0); PG8_MMA(0, 1, At, B1); PG8_BAR;
            PG8_LDA(At, 0, 1); PG8_STAGE(PG8_SA(0, 0), a2, voffA);
            PG8_BAR; PG8_WAIT_L(0); PG8_MMA(1, 0, At, B0); PG8_BAR; PG8_SCHED;
            PG8_STAGE(PG8_SB(0, 1), b2 + hstep, voffB);
            PG8_WAIT_V(6); PG8_BAR; PG8_MMA(1, 1, At, B1); PG8_BAR;
            PG8_LDB(B0, 1, 0); PG8_SCHED; PG8_LDA(At, 1, 0); PG8_STAGE(PG8_SA(0, 1), a2 + hstep, voffA);
            PG8_WAIT_L(8); PG8_BAR; PG8_WAIT_L(0); PG8_MMA(0, 0, At, B0); PG8_BAR; PG8_SCHED;
            PG8_LDB(B1, 1, 1); PG8_STAGE(PG8_SB(1, 0), b3, voffB);
            PG8_BAR; PG8_WAIT_L(0); PG8_MMA(0, 1, At, B1); PG8_BAR;
            PG8_LDA(At, 1, 1); PG8_STAGE(PG8_SA(1, 0), a3, voffA);
            PG8_BAR; PG8_WAIT_L(0); PG8_MMA(1, 0, At, B0); PG8_BAR; PG8_SCHED;
            PG8_STAGE(PG8_SB(1, 1), b3 + hstep, voffB);
            PG8_WAIT_V(6); PG8_BAR; PG8_MMA(1, 1, At, B1); PG8_BAR;
            }
        }
        if constexpr (ALIGN_EPI) { if (wr == 0) PG8_BAR; }
        if constexpr (!Epi::AFTER_DRAIN) { E(acc, cur, wr, wc, fr, fq); S.done(cur); }
        if (!has_next) break;
#pragma unroll
        for (int a = 0; a < 2; ++a)
#pragma unroll
            for (int b = 0; b < 2; ++b)
#pragma unroll
                for (int m = 0; m < 4; ++m)
#pragma unroll
                    for (int n = 0; n < 2; ++n) acc[a][b][m][n] = (f32x4){0.f, 0.f, 0.f, 0.f};
        cur = nxt; cA = nA; cB = nB; ++ui;
        if constexpr (ALIGN_EPI) { if (wr == 1) PG8_BAR; }
    }
    PG8_WAIT_V(0);
    if constexpr (!ALIGN_EPI) { if (wr == 0) PG8_BAR; }
    PG8_BAR;
    if constexpr (Epi::AFTER_DRAIN) { E.fused(acc, cur, wr, wc, fr, fq, lds, wid, lane); S.done(cur); }
#undef PG8_SA
#undef PG8_SB
#undef PG8_STAGE
#undef PG8_LDA
#undef PG8_LDB
#undef PG8_MMA
#undef PG8_WAIT_V
#undef PG8_WAIT_L
#undef PG8_BAR
#undef PG8_SCHED
}
}
#define GAS __attribute__((address_space(1)))
#define LAS __attribute__((address_space(3)))
typedef unsigned short bf16;
typedef unsigned v4u __attribute__((ext_vector_type(4)));
typedef float f32x4 __attribute__((ext_vector_type(4)));
typedef short bf16x8 __attribute__((ext_vector_type(8)));
typedef GAS unsigned gu32;
typedef GAS unsigned long long gu64;
#define RLX_AGENT __ATOMIC_RELAXED, __HIP_MEMORY_SCOPE_AGENT
#define LDS_WAIT() asm volatile("s_waitcnt lgkmcnt(0)" ::: "memory")
#define VM_WAIT() asm volatile("s_waitcnt vmcnt(0)" ::: "memory")
__device__ __forceinline__ unsigned long long rt() { return __builtin_amdgcn_s_memrealtime(); }
__device__ __forceinline__ unsigned f2bf(float f) { unsigned u = __builtin_bit_cast(unsigned, f); return (u + 0x7fffu + ((u >> 16) & 1u)) >> 16; }
__device__ __forceinline__ unsigned pk2(float lo, float hi) { return f2bf(lo) | (f2bf(hi) << 16); }

#define XB_TMO      128
#define XB_XCNT(j)  (256  + 64 * (j))
#define XB_XSUB(j)  (1280 + 64 * (j))
#define XB_XGEN(j)  (2304 + 64 * (j))
#define XB_TOP      3328
#define XB_TOPGEN   3392
#define XCD_BAR_WORDS 3456
#define XB_SPIN_CAP (1u << 18)

__device__ __forceinline__ unsigned xb_ld(unsigned* p)              { return __hip_atomic_load(p, __ATOMIC_RELAXED, __HIP_MEMORY_SCOPE_AGENT); }
__device__ __forceinline__ unsigned xb_add(unsigned* p, unsigned v) { return __hip_atomic_fetch_add(p, v, __ATOMIC_RELAXED, __HIP_MEMORY_SCOPE_AGENT); }
__device__ __forceinline__ unsigned xb_xcc_id() { return (unsigned)__builtin_amdgcn_s_getreg((3 << 11) | 20) & 0xFu; }
#define XB_SPIN(cond, bar) do { unsigned _sp = 0; while (cond) { __builtin_amdgcn_s_sleep(1); \
    if ((++_sp & 255u) == 0u) { if (xb_ld(&(bar)[XB_TMO])) break; if (_sp > XB_SPIN_CAP) { atomicAdd(&(bar)[XB_TMO], 1u); break; } } } } while (0)

struct XcdBarrier {
    unsigned* bar; unsigned x;
    volatile LAS unsigned* st;
};

__device__ __forceinline__ XcdBarrier xcd_barrier_post(unsigned* bar, volatile LAS unsigned* st) {
    XcdBarrier b; b.bar = bar; b.x = xb_xcc_id(); b.st = st;
    if (threadIdx.x == 0) (void)xb_add(&bar[XB_XCNT(b.x)], 1u);
    return b;
}
__device__ __forceinline__ void xcd_barrier_complete(unsigned* bar, unsigned x, unsigned& nloc, unsigned& nx) {
    const unsigned G = gridDim.x * gridDim.y * gridDim.z;
    unsigned sum, cnt, mine, sp = 0u;
    for (;;) {
        sum = 0u; cnt = 0u; mine = 0u;
#pragma unroll
        for (unsigned j = 0; j < 16; ++j) { const unsigned c = xb_ld(&bar[XB_XCNT(j)]); sum += c; cnt += (c > 0u) ? 1u : 0u; mine = (j == x) ? c : mine; }
        if (sum == G) break;
        __builtin_amdgcn_s_sleep(1);
        if ((++sp & 255u) == 0u) { if (xb_ld(&bar[XB_TMO])) break; if (sp > XB_SPIN_CAP) { atomicAdd(&bar[XB_TMO], 1u); break; } }
    }
    nloc = mine > 0u ? mine : 1u; nx = cnt > 0u ? cnt : 1u;
}

__device__ __forceinline__ void xcd_barrier(const XcdBarrier& b) {
    asm volatile("s_waitcnt vmcnt(0)" ::: "memory");
    __syncthreads();
    if (threadIdx.x == 0) {
        unsigned* bar = b.bar;
        __builtin_amdgcn_s_waitcnt(0);
        unsigned nloc = b.st[0], nx = b.st[1];
        if (nloc == 0u) { xcd_barrier_complete(bar, b.x, nloc, nx); b.st[0] = nloc; b.st[1] = nx; }
        const unsigned old = xb_add(&bar[XB_XSUB(b.x)], 1u);
        const unsigned gen = old / nloc;
        if (old + 1u == (gen + 1u) * nloc) {
            __builtin_amdgcn_fence(__ATOMIC_RELEASE, "agent");
            asm volatile("s_waitcnt vmcnt(0)" ::: "memory");
            const unsigned og = xb_add(&bar[XB_TOP], 1u);
            const unsigned tg = og / nx;
            if (og + 1u == (tg + 1u) * nx) xb_add(&bar[XB_TOPGEN], 1u);
            else XB_SPIN(xb_ld(&bar[XB_TOPGEN]) == tg, bar);
            __builtin_amdgcn_fence(__ATOMIC_ACQUIRE, "agent");
            xb_add(&bar[XB_XGEN(b.x)], 1u);
            asm volatile("s_waitcnt vmcnt(0)" ::: "memory");
        } else {
            XB_SPIN(xb_ld(&bar[XB_XGEN(b.x)]) == gen, bar);
            __builtin_amdgcn_fence(__ATOMIC_ACQUIRE, "agent");
            asm volatile("s_waitcnt vmcnt(0)" ::: "memory");
        }
    }
    __syncthreads();
}
#define DI __device__ __forceinline__
typedef float f32x16 __attribute__((ext_vector_type(16)));
typedef float f32x2 __attribute__((ext_vector_type(2)));
typedef unsigned v2u __attribute__((ext_vector_type(2)));
typedef short s16x4 __attribute__((ext_vector_type(4)));
typedef __bf16 bf16x2_t __attribute__((ext_vector_type(2)));

constexpr int DM = 1024, SEQ = 8192, NBP = 2, MPR = NBP * SEQ  , NSMP = 32, MTOT = MPR + NSMP  , MP = 16640  ;
constexpr int PAST = 8192, NPAGES = 64, PAGE = 128;
constexpr int DFF = 2816, NUP = 2 * DFF  , PLE = 256;
constexpr int NPROJ = 7936;
constexpr int C_GQ = 0, C_GK = 512, C_GV = 1024, C_GR = 2048, C_NQ = 3072, C_KC = 4096, C_KS = 4608, C_KW = 5120, C_MG = 5632, C_MN = 6656, C_GA = 7680, C_NG = 7696;
constexpr int IN_COLS = 7744;
constexpr float EPS = 1e-6f;
constexpr float LOG2E = 1.4426950408889634f;
constexpr float QSCALE = 0.125f * LOG2E;
constexpr float GLA_QS = 0.08838834764831845f;
constexpr int NCHUNK = MPR / 64;
constexpr int CHK_S = 32 * 4 * 512  , CHK_P = 2 * 4 * 512  , CHK_ROWS = CHK_S + CHK_P  ;

constexpr size_t O_Y = 0, O_YS = 16777216, O_CMP_P = O_YS + 32768, O_CMP_S = O_CMP_P + 8388608, O_SLC_P = O_CMP_S + 16384, O_SLC_S = O_SLC_P + 8388608,
                 O_WIN_P = O_SLC_S + 16384, O_WIN_S = O_WIN_P + 524288, O_GLA_P = O_WIN_S + 16384, O_GLA_S = O_GLA_P + 262144, O_CONV_P = O_GLA_S + 4194304,
                 O_CONV_S = O_CONV_P + 11264, O_END = O_CONV_S + 180224;

constexpr size_t al256(size_t x) { return (x + 255) & ~(size_t)255; }
constexpr size_t WS_CTL = 0, CTL_BYTES = 1u << 20;
constexpr size_t WS_WIN_T = WS_CTL + CTL_BYTES;
constexpr size_t WS_WGO_T = WS_WIN_T + (size_t)NPROJ * DM * 2;
constexpr size_t WS_WNO_T = WS_WGO_T + (size_t)DM * DM * 2;
constexpr size_t WS_WOUT_T = WS_WNO_T + (size_t)DM * DM * 2;
constexpr size_t WS_WPG_T = WS_WOUT_T + (size_t)DM * DM * 2;
constexpr size_t WS_WUP_T = WS_WPG_T + (size_t)DM * DM * 2;
constexpr size_t WS_WDN_T = WS_WUP_T + (size_t)NUP * DM * 2;
constexpr size_t WS_WPP_T = WS_WDN_T + (size_t)DM * DFF * 2;
constexpr size_t WS_W1_T = WS_WPP_T + (size_t)DM * PLE * 2;
constexpr size_t WS_W2_T = WS_W1_T + (size_t)2 * 256 * 1024 * 2;
constexpr size_t WS_B1P = WS_W2_T + (size_t)2 * 64 * 128 * 2;
constexpr size_t WS_XN = al256(WS_B1P + 1024);
constexpr size_t WS_PB = WS_XN + (size_t)MP * DM * 2;
constexpr size_t WS_PROJ = WS_PB + (size_t)MP * PLE * 2;
constexpr size_t WS_PP = WS_PROJ + (size_t)MP * NPROJ * 2;
constexpr size_t WS_QT = WS_PP + (size_t)MP * DM * 2;
constexpr size_t WS_KT = WS_QT + (size_t)MPR * 512 * 2;
constexpr size_t WS_UT = WS_KT + (size_t)MPR * 512 * 2;
constexpr size_t WS_ST = WS_UT + (size_t)NCHUNK * 4 * 256 * 128 * 2;
constexpr size_t WS_DL = WS_ST + (size_t)NCHUNK * 4 * 256 * 128 * 2;
constexpr size_t WS_OG = WS_DL + (size_t)NCHUNK * 4 * 128 * 4;
constexpr size_t WS_CHK = WS_OG + (size_t)MP * DM * 2;
constexpr size_t WS_T = WS_CHK + (size_t)2 * CHK_ROWS * 1024 * 2;
constexpr size_t WS_KVC = WS_T + (size_t)2 * CHK_ROWS * 256 * 2 + 4096;
constexpr size_t WS_SEL = WS_KVC + (size_t)2 * CHK_ROWS * 64 * 2 + 4096;
constexpr size_t WS_OC = WS_SEL + (size_t)8 * SEQ * 4 * 4;
constexpr size_t WS_OW = WS_OC + (size_t)MP * DM * 2;
constexpr size_t WS_ONSA = WS_OW + (size_t)MP * DM * 2;
constexpr size_t WS_YG = WS_ONSA + (size_t)MP * DM * 2;
constexpr size_t WS_MIX = WS_YG + (size_t)MP * DM * 2;
constexpr size_t WS_T1 = WS_MIX + (size_t)MP * DM * 2;
constexpr size_t WS_X1 = WS_T1 + (size_t)MP * DM * 4;
constexpr size_t WS_X2 = WS_X1 + (size_t)MP * DM * 4;
constexpr size_t WS_UP = WS_X2 + (size_t)MP * DM * 4;
constexpr size_t WS_H = WS_UP + (size_t)MP * NUP * 2;
constexpr size_t WS_END = WS_H + (size_t)MP * DFF * 2;

constexpr int CW_BAR = 4096;
constexpr int LDS_BYTES = 147456;
constexpr int MISC_OFF = 131072 + 320;

DI float bf2f(unsigned short h) { return __uint_as_float((unsigned)h << 16); }
DI float bflo(unsigned u) { return __uint_as_float(u << 16); }
DI float bfhi(unsigned u) { return __uint_as_float(u & 0xffff0000u); }
DI unsigned cvtpk(float lo, float hi) { f32x2 v = {lo, hi}; bf16x2_t b = __builtin_convertvector(v, bf16x2_t); return __builtin_bit_cast(unsigned, b); }
DI float sigmoidf_(float x) { return 1.0f / (1.0f + __expf(-x)); }
DI float siluf_(float x) { return x / (1.0f + __expf(-x)); }
DI float gelu_tanh(float x) { const float u = 1.5957691216057308f * (x + 0.044715f * x * x * x); return x / (1.0f + __expf(-u)); }
DI float logsigf_(float x) { return fminf(x, 0.f) - log1pf(__expf(-fabsf(x))); }
DI float wave_sum(float v) {
#pragma unroll
    for (int o = 1; o < 64; o <<= 1) v += __shfl_xor(v, o);
    return v;
}
DI float wave_max(float v) {
#pragma unroll
    for (int o = 1; o < 64; o <<= 1) v = fmaxf(v, __shfl_xor(v, o));
    return v;
}
template <int CTRL> DI int dpp_i(int x) { return __builtin_amdgcn_update_dpp(0, x, CTRL, 0xf, 0xf, false); }
template <int CTRL> DI float dpp_f(float x) { return __int_as_float(__builtin_amdgcn_update_dpp(0, __float_as_int(x), CTRL, 0xf, 0xf, false)); }
DI float quad_sum(float x) { x += dpp_f<0xB1>(x); x += dpp_f<0x4E>(x); return x; }
DI int sum8_i(int x) { x += dpp_i<0xB1>(x); x += dpp_i<0x4E>(x); x += dpp_i<0x141>(x); return x; }
DI float sum16_f(float x) { x += dpp_f<0xB1>(x); x += dpp_f<0x4E>(x); x += dpp_f<0x141>(x); x += dpp_f<0x140>(x); return x; }

#define MFMA32(a, b, c) __builtin_amdgcn_mfma_f32_32x32x16_bf16((a), (b), (c), 0, 0, 0)
DI int crow(int r, int hi) { return (r & 3) + 8 * (r >> 2) + 4 * hi; }
typedef short v4i16_t __attribute__((ext_vector_type(4)));
DI s16x4 vtr(const LAS unsigned char* p) { return __builtin_bit_cast(s16x4, __builtin_amdgcn_ds_read_tr16_b64_v4i16((LAS v4i16_t*)p)); }
DI bf16x8 cat8(s16x4 lo, s16x4 hi) { return (bf16x8){lo[0], lo[1], lo[2], lo[3], hi[0], hi[1], hi[2], hi[3]}; }
DI bf16x8 tr_frag(const LAS unsigned char* T, int stride, int k0, int n0, int lane) {
    const int q = (lane & 15) >> 2, p = lane & 3, blk = (lane >> 4) & 1, hh = lane >> 5;
    const LAS unsigned char* a = T + (k0 + 8 * hh + q) * stride + (n0 + 16 * blk + 4 * p) * 2;
    return cat8(vtr(a), vtr(a + 4 * stride));
}
DI bf16x8 tr_frag_acc(const LAS unsigned char* T, int stride, int k0, int n0, int lane) {
    const int q = (lane & 15) >> 2, p = lane & 3, blk = (lane >> 4) & 1, hh = lane >> 5;
    const LAS unsigned char* a = T + (k0 + 4 * hh + q) * stride + (n0 + 16 * blk + 4 * p) * 2;
    return cat8(vtr(a), vtr(a + 8 * stride));
}
DI bf16x8 pack_acc(const f32x16& x, int s) {
    v4u p; p.x = cvtpk(x[8 * s + 0], x[8 * s + 1]); p.y = cvtpk(x[8 * s + 2], x[8 * s + 3]); p.z = cvtpk(x[8 * s + 4], x[8 * s + 5]); p.w = cvtpk(x[8 * s + 6], x[8 * s + 7]);
    return __builtin_bit_cast(bf16x8, p);
}

struct Ctx {
    LAS unsigned char* lds;
    int tid, lane, wave, G, bid;
    const float* in[33];
    float* out;
    unsigned char* ws;
};
#define WSP(T, off) ((T*)(C.ws + (off)))
namespace pg8 {
DI unsigned epk(float lo, float hi) { return ::cvtpk(lo, hi); }
DI u32x4 pack8(const f32x4& a, const f32x4& b) { u32x4 w; w.x = epk(a[0], a[1]); w.y = epk(a[2], a[3]); w.z = epk(b[0], b[1]); w.w = epk(b[2], b[3]); return w; }

struct EpiProj {
    static constexpr bool PERM = true, AFTER_DRAIN = false;
    bf16_t* P; float* out;
    DI void operator()(const f32x4 (&acc)[2][2][4][2], const Unit& u, int wr, int wc, int fr, int fq) const {
        const float sc = (u.pn >= 12 && u.pn < 16) ? QSCALE : 1.f;
        const bool kv = (u.pn >= 16 && u.pn < 22); const int which = (u.pn - 16) >> 1;
#pragma unroll
        for (int ai = 0; ai < 2; ++ai)
#pragma unroll
            for (int m = 0; m < 4; ++m) {
                const int row = u.pm * BM + ai * HALF + wr * 64 + m * 16 + fr;
#pragma unroll
                for (int bj = 0; bj < 2; ++bj) {
                    const int col = u.pn * BM + bj * HALF + wc * 32 + 8 * fq;
                    const f32x4 v0 = acc[ai][bj][m][0], v1 = acc[ai][bj][m][1];
                    *(u32x4*)(P + (size_t)row * NPROJ + col) = pack8(v0 * sc, v1 * sc);
                    if (kv) {
                        const int c512 = col - (C_KC + which * 512); float* dst = nullptr;
                        if (row < MPR) {
                            if (which == 0) dst = out + O_CMP_P + (size_t)row * 512 + c512;
                            else if (which == 1) dst = out + O_SLC_P + (size_t)row * 512 + c512;
                            else { const int t = row & (SEQ - 1); if (t >= SEQ - 512) dst = out + O_WIN_P + ((size_t)((row >> 13) * 512 + (t - (SEQ - 512)))) * 512 + c512; }
                        } else if (row < MTOT) {
                            dst = out + (which == 0 ? O_CMP_S : which == 1 ? O_SLC_S : O_WIN_S) + (size_t)(row - MPR) * 512 + c512;
                        }
                        if (dst) { *(f32x4*)dst = v0; *(f32x4*)(dst + 4) = v1; }
                    }
                }
            }
    }
};
template <bool UPCONV> struct EpiStore {
    static constexpr bool PERM = true, AFTER_DRAIN = false;
    bf16_t* O; int ldc; float* out;
    DI void e4(int row, int col, const f32x4& v) const { v2u w; w.x = epk(v[0], v[1]); w.y = epk(v[2], v[3]); *(v2u*)(O + (size_t)row * ldc + col) = w; }
    DI void operator()(const f32x4 (&acc)[2][2][4][2], const Unit& u, int wr, int wc, int fr, int fq) const {
#pragma unroll
        for (int ai = 0; ai < 2; ++ai)
#pragma unroll
            for (int m = 0; m < 4; ++m) {
                const int row = u.pm * BM + ai * HALF + wr * 64 + m * 16 + fr;
#pragma unroll
                for (int bj = 0; bj < 2; ++bj) {
                    const int col = u.pn * BM + bj * HALF + wc * 32 + 8 * fq;
                    const f32x4 v0 = acc[ai][bj][m][0], v1 = acc[ai][bj][m][1];
                    *(u32x4*)(O + (size_t)row * ldc + col) = pack8(v0, v1);
                    if (UPCONV) {
                        if (col < DFF) {
                            float* dst = nullptr; const int t = row & (SEQ - 1);
                            if (row < MPR) { if (t >= SEQ - 2) dst = out + O_CONV_P + ((size_t)((row >> 13) * 2 + (t - (SEQ - 2)))) * DFF + col; }
                            else if (row < MTOT) dst = out + O_CONV_S + ((size_t)((row - MPR) * 2 + 1)) * DFF + col;
                            if (dst) { *(f32x4*)dst = v0; *(f32x4*)(dst + 4) = v1; }
                        }
                    }
                }
            }
    }
};
struct EpiMix {
    static constexpr bool PERM = true, AFTER_DRAIN = false;
    const bf16_t* P; const bf16_t* YG; bf16_t* MIX;
    DI void e4(int row, int col, const f32x4& v) const {
        const v2u yg = *(const v2u*)(YG + (size_t)row * DM + col), mg = *(const v2u*)(P + (size_t)row * NPROJ + C_MG + col), mn = *(const v2u*)(P + (size_t)row * NPROJ + C_MN + col);
        const float r0 = sigmoidf_(bflo(mg[0])) * bflo(yg[0]) + sigmoidf_(bflo(mn[0])) * v[0], r1 = sigmoidf_(bfhi(mg[0])) * bfhi(yg[0]) + sigmoidf_(bfhi(mn[0])) * v[1];
        const float r2 = sigmoidf_(bflo(mg[1])) * bflo(yg[1]) + sigmoidf_(bflo(mn[1])) * v[2], r3 = sigmoidf_(bfhi(mg[1])) * bfhi(yg[1]) + sigmoidf_(bfhi(mn[1])) * v[3];
        v2u w; w.x = epk(r0, r1); w.y = epk(r2, r3); *(v2u*)(MIX + (size_t)row * DM + col) = w;
    }
    DI void operator()(const f32x4 (&acc)[2][2][4][2], const Unit& u, int wr, int wc, int fr, int fq) const {
#pragma unroll
        for (int ai = 0; ai < 2; ++ai)
#pragma unroll
            for (int m = 0; m < 4; ++m) {
                const int row = u.pm * BM + ai * HALF + wr * 64 + m * 16 + fr;
#pragma unroll
                for (int bj = 0; bj < 2; ++bj) {
                    const int col = u.pn * BM + bj * HALF + wc * 32 + 8 * fq;
                    const f32x4 v0 = acc[ai][bj][m][0], v1 = acc[ai][bj][m][1];
                    const u32x4 yg = *(const u32x4*)(YG + (size_t)row * DM + col);
                    const u32x4 mg = *(const u32x4*)(P + (size_t)row * NPROJ + C_MG + col);
                    const u32x4 mn = *(const u32x4*)(P + (size_t)row * NPROJ + C_MN + col);
                    float r[8];
#pragma unroll
                    for (int e = 0; e < 4; ++e) {
                        const float a0 = e < 2 ? v0[2 * e] : v1[2 * e - 4], a1 = e < 2 ? v0[2 * e + 1] : v1[2 * e - 3];
                        r[2 * e] = sigmoidf_(bflo(mg[e])) * bflo(yg[e]) + sigmoidf_(bflo(mn[e])) * a0;
                        r[2 * e + 1] = sigmoidf_(bfhi(mg[e])) * bfhi(yg[e]) + sigmoidf_(bfhi(mn[e])) * a1;
                    }
                    u32x4 w; w.x = epk(r[0], r[1]); w.y = epk(r[2], r[3]); w.z = epk(r[4], r[5]); w.w = epk(r[6], r[7]);
                    *(u32x4*)(MIX + (size_t)row * DM + col) = w;
                }
            }
    }
};
struct EpiF32 {
    static constexpr bool PERM = false, AFTER_DRAIN = false;
    float* O; int ldc;
    DI void e4(int row, int col, const f32x4& v) const { *(f32x4*)(O + (size_t)row * ldc + col) = v; }
    DI void operator()(const f32x4 (&acc)[2][2][4][2], const Unit& u, int wr, int wc, int fr, int fq) const {
#pragma unroll
        for (int ai = 0; ai < 2; ++ai)
#pragma unroll
            for (int m = 0; m < 4; ++m) {
                const int row = u.pm * BM + ai * HALF + wr * 64 + m * 16 + fr;
#pragma unroll
                for (int bj = 0; bj < 2; ++bj)
#pragma unroll
                    for (int n = 0; n < 2; ++n) { const int col = u.pn * BM + bj * HALF + wc * 32 + 16 * n + 4 * fq; *(f32x4*)(O + (size_t)row * ldc + col) = acc[ai][bj][m][n]; }
            }
    }
};
struct EpiFinal {
    static constexpr bool PERM = false, AFTER_DRAIN = false;
    const float* X2; const bf16_t* PP; float* out;
    DI void e4(int row, int col, const f32x4& a) const {
        float* orow = row < MPR ? out + O_Y + (size_t)row * DM : out + O_YS + (size_t)(row - MPR) * DM;
        const f32x4 x = *(const f32x4*)(X2 + (size_t)row * DM + col); const v2u pp = *(const v2u*)(PP + (size_t)row * DM + col);
        f32x4 y; y[0] = x[0] + sigmoidf_(a[0]) * bflo(pp[0]); y[1] = x[1] + sigmoidf_(a[1]) * bfhi(pp[0]); y[2] = x[2] + sigmoidf_(a[2]) * bflo(pp[1]); y[3] = x[3] + sigmoidf_(a[3]) * bfhi(pp[1]);
        *(f32x4*)(orow + col) = y;
    }
    DI void operator()(const f32x4 (&acc)[2][2][4][2], const Unit& u, int wr, int wc, int fr, int fq) const {
#pragma unroll
        for (int ai = 0; ai < 2; ++ai)
#pragma unroll
            for (int m = 0; m < 4; ++m) {
                const int row = u.pm * BM + ai * HALF + wr * 64 + m * 16 + fr;
                if (row < MTOT) {
                    float* orow = row < MPR ? out + O_Y + (size_t)row * DM : out + O_YS + (size_t)(row - MPR) * DM;
#pragma unroll
                    for (int bj = 0; bj < 2; ++bj)
#pragma unroll
                        for (int n = 0; n < 2; ++n) {
                            const int col = u.pn * BM + bj * HALF + wc * 32 + 16 * n + 4 * fq; const f32x4 a = acc[ai][bj][m][n];
                            const f32x4 x = *(const f32x4*)(X2 + (size_t)row * DM + col); const v2u pp = *(const v2u*)(PP + (size_t)row * DM + col);
                            f32x4 y; y[0] = x[0] + sigmoidf_(a[0]) * bflo(pp[0]); y[1] = x[1] + sigmoidf_(a[1]) * bfhi(pp[0]); y[2] = x[2] + sigmoidf_(a[2]) * bflo(pp[1]); y[3] = x[3] + sigmoidf_(a[3]) * bfhi(pp[1]);
                            *(f32x4*)(orow + col) = y;
                        }
                }
            }
    }
};
}
struct ColIdent { DI int operator()(int n) const { return n; } };
struct ColWin {
    DI int operator()(int n) const {
        if (n < 3072) return n;
        if (n < 4096) return 3088 + (n - 3072);
        if (n < 5632) return 4112 + (n - 4096);
        if (n < 7680) return 5696 + (n - 5632);
        if (n < 7696) return 3072 + (n - 7680);
        if (n < 7744) return 5648 + (n - 7696);
        return -1;
    }
};
template <class F> DI void tr_item(const float* W, int Nsrc, bf16* WT, int Kpitch, int k0, int n0, LAS float* scr, int lane, F srccol) {
    const int ns = srccol(n0 + (lane & 31));
#pragma unroll 8
    for (int i = 0; i < 32; ++i) { const int kk = 2 * i + (lane >> 5); scr[kk * 33 + (lane & 31)] = ns >= 0 ? W[(size_t)(k0 + kk) * Nsrc + ns] : 0.f; }
    LDS_WAIT(); asm volatile("" ::: "memory");
    const int c = lane & 7;
#pragma unroll
    for (int j = 0; j < 4; ++j) { const int n = (lane >> 3) + 8 * j; const LAS float* s = scr + (8 * c) * 33 + n;
        v4u o; o.x = cvtpk(s[0 * 33], s[1 * 33]); o.y = cvtpk(s[2 * 33], s[3 * 33]); o.z = cvtpk(s[4 * 33], s[5 * 33]); o.w = cvtpk(s[6 * 33], s[7 * 33]);
        *(v4u*)(WT + (size_t)(n0 + n) * Kpitch + k0 + 8 * c) = o; }
    LDS_WAIT(); asm volatile("" ::: "memory");
}
template <class F> DI void tr_matrix(const Ctx& C, const float* W, int K, int Nsrc, int Ndst, bf16* WT, int Kpitch, F f, int& base) {
    LAS float* scr = (LAS float*)(C.lds + C.wave * 16384);
    const int gw = C.bid * 8 + C.wave, NGW = C.G * 8, nb = Ndst / 32, items = (K / 64) * nb;
    int first = gw - (base % NGW); if (first < 0) first += NGW;
    for (int it = first; it < items; it += NGW) tr_item(W, Nsrc, WT, Kpitch, 64 * (it / nb), 32 * (it % nb), scr, C.lane, f);
    base += items;
}
DI void rms_row_bf16(const float* xrow, const float* g, bf16* orow, int lane) {
    const f32x4* xr = (const f32x4*)xrow + lane; const f32x4* gr = (const f32x4*)g + lane;
    f32x4 v[4]; float s = 0.f;
#pragma unroll
    for (int j = 0; j < 4; ++j) { v[j] = xr[64 * j]; s += (v[j][0] * v[j][0] + v[j][1] * v[j][1]) + (v[j][2] * v[j][2] + v[j][3] * v[j][3]); }
    const float rstd = rsqrtf(wave_sum(s) * (1.f / DM) + EPS);
#pragma unroll
    for (int j = 0; j < 4; ++j) { const f32x4 gg = gr[64 * j]; v2u o; o.x = cvtpk(v[j][0] * rstd * gg[0], v[j][1] * rstd * gg[1]); o.y = cvtpk(v[j][2] * rstd * gg[2], v[j][3] * rstd * gg[3]);
        *((v2u*)orow + lane + 64 * j) = o; }
}
DI void phase_prologue(const Ctx& C) {
    const int gw = C.bid * 8 + C.wave, NGW = C.G * 8, lane = C.lane;
    int base = 0;
    tr_matrix(C, C.in[15], DM, IN_COLS, NPROJ, WSP(bf16, WS_WIN_T), DM, ColWin(), base);
    tr_matrix(C, C.in[19], DM, DM, DM, WSP(bf16, WS_WGO_T), DM, ColIdent(), base);
    tr_matrix(C, C.in[25], DM, DM, DM, WSP(bf16, WS_WNO_T), DM, ColIdent(), base);
    tr_matrix(C, C.in[26], DM, DM, DM, WSP(bf16, WS_WOUT_T), DM, ColIdent(), base);
    tr_matrix(C, C.in[32], DM, DM, DM, WSP(bf16, WS_WPG_T), DM, ColIdent(), base);
    tr_matrix(C, C.in[27], DM, NUP, NUP, WSP(bf16, WS_WUP_T), DM, ColIdent(), base);
    tr_matrix(C, C.in[30], DFF, DM, DM, WSP(bf16, WS_WDN_T), DFF, ColIdent(), base);
    tr_matrix(C, C.in[31], PLE, DM, DM, WSP(bf16, WS_WPP_T), PLE, ColIdent(), base);
#pragma unroll
    for (int c = 0; c < 2; ++c)
#pragma unroll
        for (int hh = 0; hh < 2; ++hh)
            tr_matrix(C, C.in[20] + (size_t)(c * 2048 + hh * 1024) * 128, 1024, 128, 128, WSP(bf16, WS_W1_T) + (size_t)(c * 256 + hh * 128) * 1024, 1024, ColIdent(), base);
#pragma unroll
    for (int c = 0; c < 2; ++c) tr_matrix(C, C.in[22] + (size_t)c * 128 * 64, 128, 64, 64, WSP(bf16, WS_W2_T) + (size_t)c * 64 * 128, 128, ColIdent(), base);
    if (gw < 256) {
        const int c = gw >> 7, h = gw & 127; const float* w1 = C.in[20] + (size_t)c * 2048 * 128; const float* pe = C.in[24];
        float s = 0.f;
        for (int k = lane; k < 2048; k += 64) { const int pos = k >> 6, d = k & 63; s += pe[(pos * 2 + c) * 64 + d] * w1[(size_t)k * 128 + h]; }
        s = wave_sum(s);
        if (lane == 0) WSP(float, WS_B1P)[gw] = s + C.in[21][gw];
    }
    bf16* XN = WSP(bf16, WS_XN); bf16* PB = WSP(bf16, WS_PB);
    for (int m = gw; m < MP; m += NGW) {
        if (m < MTOT) {
            const float* xr = m < MPR ? C.in[0] + (size_t)m * DM : C.in[1] + (size_t)(m - MPR) * DM;
            rms_row_bf16(xr, C.in[10], XN + (size_t)m * DM, lane);
            const float* pr = m < MPR ? C.in[8] + (size_t)m * PLE : C.in[9] + (size_t)(m - MPR) * PLE;
            const f32x4 pv = *((const f32x4*)pr + lane); v2u o; o.x = cvtpk(pv[0], pv[1]); o.y = cvtpk(pv[2], pv[3]); *((v2u*)(PB + (size_t)m * PLE) + lane) = o;
        } else {
#pragma unroll
            for (int j = 0; j < 4; ++j) *((v2u*)(XN + (size_t)m * DM) + lane + 64 * j) = (v2u){0u, 0u};
            *((v2u*)(PB + (size_t)m * PLE) + lane) = (v2u){0u, 0u};
        }
    }
    for (int i = C.bid * 512 + C.tid; i < NSMP * DFF; i += C.G * 512) { const int b = i / DFF, c = i - b * DFF; C.out[O_CONV_S + (size_t)(b * 2) * DFF + c] = C.in[6][(size_t)(b * 2 + 1) * DFF + c]; }
}

DI void phase_chk_prompt(const Ctx& C) {
    const int gw = C.bid * 8 + C.wave, NGW = C.G * 8, lane = C.lane;
    const bf16* P = WSP(bf16, WS_PROJ); bf16* CHK = WSP(bf16, WS_CHK);
    const int tk = lane >> 4, ch = lane & 15, c = ch >> 3, d8 = (ch & 7) * 8;
    for (int r = gw; r < CHK_P; r += NGW) {
        const int b = r >> 11, g = (r >> 9) & 3, j = r & 511;
        const bf16* src = P + (size_t)(b * SEQ + 16 * j) * NPROJ + C_KC + g * 128 + ch * 8;
        bf16* dst = CHK + ((size_t)c * CHK_ROWS + CHK_S + r) * 1024 + d8;
#pragma unroll
        for (int i = 0; i < 4; ++i) { const int pos = 4 * i + tk; *(v4u*)(dst + pos * 64) = *(const v4u*)(src + (size_t)pos * NPROJ); }
    }
}

DI void phase_rownorm(const Ctx& C, const float* T, const float* xin_p, const float* xin_s, const float* g_post, const float* g_pre, float* xout, bf16* XN) {
    const int gw = C.bid * 8 + C.wave, NGW = C.G * 8, lane = C.lane;
    for (int m = gw; m < MTOT; m += NGW) {
        const f32x4* tr = (const f32x4*)(T + (size_t)m * DM) + lane;
        const f32x4* xr = (const f32x4*)(m < MPR ? xin_p + (size_t)m * DM : xin_s + (size_t)(m - MPR) * DM) + lane;
        f32x4 t[4], x[4]; float s = 0.f;
#pragma unroll
        for (int j = 0; j < 4; ++j) { t[j] = tr[64 * j]; x[j] = xr[64 * j]; s += (t[j][0] * t[j][0] + t[j][1] * t[j][1]) + (t[j][2] * t[j][2] + t[j][3] * t[j][3]); }
        const float r1 = rsqrtf(wave_sum(s) * (1.f / DM) + EPS); float s2 = 0.f;
#pragma unroll
        for (int j = 0; j < 4; ++j) { const f32x4 gp = *((const f32x4*)g_post + lane + 64 * j); x[j] = x[j] + t[j] * r1 * gp;
            s2 += (x[j][0] * x[j][0] + x[j][1] * x[j][1]) + (x[j][2] * x[j][2] + x[j][3] * x[j][3]); *((f32x4*)(xout + (size_t)m * DM) + lane + 64 * j) = x[j]; }
        const float r2 = rsqrtf(wave_sum(s2) * (1.f / DM) + EPS);
#pragma unroll
        for (int j = 0; j < 4; ++j) { const f32x4 gg = *((const f32x4*)g_pre + lane + 64 * j); v2u o; o.x = cvtpk(x[j][0] * r2 * gg[0], x[j][1] * r2 * gg[1]); o.y = cvtpk(x[j][2] * r2 * gg[2], x[j][3] * r2 * gg[3]);
            *((v2u*)(XN + (size_t)m * DM) + lane + 64 * j) = o; }
    }
}

DI void phase_conv(const Ctx& C) {
    const bf16* UP = WSP(bf16, WS_UP); bf16* H = WSP(bf16, WS_H);
    const float* cw = C.in[28]; const float* cb = C.in[29]; const float* st = C.in[6];
    constexpr int NV = DFF / 8;
    const int total = MTOT * NV;
    for (int i = C.bid * 512 + C.tid; i < total; i += C.G * 512) {
        const int row = i / NV, cv = (i - row * NV) * 8;
        const v4u a0 = *(const v4u*)(UP + (size_t)row * NUP + cv), gt = *(const v4u*)(UP + (size_t)row * NUP + DFF + cv);
        float am1[8], am2[8];
        if (row < MPR) {
            const int t = row & (SEQ - 1);
            v4u x1 = (v4u){0u, 0u, 0u, 0u}, x2 = x1;
            if (t >= 1) x1 = *(const v4u*)(UP + (size_t)(row - 1) * NUP + cv);
            if (t >= 2) x2 = *(const v4u*)(UP + (size_t)(row - 2) * NUP + cv);
#pragma unroll
            for (int e = 0; e < 4; ++e) { am1[2 * e] = bflo(x1[e]); am1[2 * e + 1] = bfhi(x1[e]); am2[2 * e] = bflo(x2[e]); am2[2 * e + 1] = bfhi(x2[e]); }
        } else {
            const int b = row - MPR;
#pragma unroll
            for (int e = 0; e < 8; ++e) { am2[e] = st[(size_t)(b * 2 + 0) * DFF + cv + e]; am1[e] = st[(size_t)(b * 2 + 1) * DFF + cv + e]; }
        }
        float r[8];
#pragma unroll
        for (int e = 0; e < 8; ++e) {
            const float a = (e & 1) ? bfhi(a0[e >> 1]) : bflo(a0[e >> 1]), g = (e & 1) ? bfhi(gt[e >> 1]) : bflo(gt[e >> 1]);
            const float cval = am2[e] * cw[cv + e] + am1[e] * cw[DFF + cv + e] + a * cw[2 * DFF + cv + e] + cb[cv + e];
            r[e] = gelu_tanh(cval) * g;
        }
        v4u o; o.x = cvtpk(r[0], r[1]); o.y = cvtpk(r[2], r[3]); o.z = cvtpk(r[4], r[5]); o.w = cvtpk(r[6], r[7]);
        *(v4u*)(H + (size_t)row * DFF + cv) = o;
    }
}

DI void phase_kvc(const Ctx& C) {
    const int gw = C.bid * 8 + C.wave, NGW = C.G * 8, lane = C.lane, r32 = lane & 31, hh = lane >> 5;
    const bf16* T = WSP(bf16, WS_T); bf16* KVC = WSP(bf16, WS_KVC); const bf16* W2T = WSP(bf16, WS_W2_T); const float* B1P = WSP(float, WS_B1P);
    constexpr int NT = CHK_ROWS / 32;
    for (int task = gw; task < 2 * NT; task += NGW) {
        const int c = task / NT, R0 = (task - c * NT) * 32;
        const bf16* Tc = T + (size_t)c * CHK_ROWS * 256; const bf16* w2 = W2T + (size_t)c * 64 * 128;
        f32x16 acc0 = {}, acc1 = {};
        const bf16* trow = Tc + (size_t)(R0 + r32) * 256;
#pragma unroll
        for (int s = 0; s < 8; ++s) {
            const int k0 = 16 * s + 8 * hh;
            const v4u ta = *(const v4u*)(trow + k0), tb = *(const v4u*)(trow + 256 + 128 + k0);
            const f32x4 b0 = *(const f32x4*)(B1P + c * 128 + k0), b1 = *(const f32x4*)(B1P + c * 128 + k0 + 4);
            float hv[8];
#pragma unroll
            for (int e = 0; e < 4; ++e) { hv[2 * e] = bflo(ta[e]) + bflo(tb[e]); hv[2 * e + 1] = bfhi(ta[e]) + bfhi(tb[e]); }
#pragma unroll
            for (int e = 0; e < 8; ++e) hv[e] = gelu_tanh(hv[e] + (e < 4 ? b0[e] : b1[e - 4]));
            v4u ap; ap.x = cvtpk(hv[0], hv[1]); ap.y = cvtpk(hv[2], hv[3]); ap.z = cvtpk(hv[4], hv[5]); ap.w = cvtpk(hv[6], hv[7]);
            const bf16x8 af = __builtin_bit_cast(bf16x8, ap);
            const bf16x8 bw0 = *(const bf16x8*)(w2 + (size_t)r32 * 128 + k0), bw1 = *(const bf16x8*)(w2 + (size_t)(32 + r32) * 128 + k0);
            acc0 = MFMA32(af, bw0, acc0); acc1 = MFMA32(af, bw1, acc1);
        }
        const float bb0 = C.in[23][c * 64 + r32], bb1 = C.in[23][c * 64 + 32 + r32];
        bf16* orow = KVC + ((size_t)c * CHK_ROWS + R0) * 64;
#pragma unroll
        for (int r = 0; r < 16; ++r) { const int row = crow(r, hh);
            orow[(size_t)row * 64 + r32] = (bf16)(cvtpk(acc0[r] + bb0, 0.f) & 0xffffu); orow[(size_t)row * 64 + 32 + r32] = (bf16)(cvtpk(acc1[r] + bb1, 0.f) & 0xffffu); }
    }
}
constexpr int G_KHS = 272, G_VS = 528;
DI void load_v_tile(const Ctx& C, const bf16* P, int r0, int h, LAS unsigned char* VV) {
#pragma unroll
    for (int i = 0; i < 4; ++i) { const int idx = C.tid + 512 * i, row = idx >> 5, ch = idx & 31;
        *(LAS v4u*)(VV + row * G_VS + ch * 16) = *(const v4u*)(P + (size_t)(r0 + row) * NPROJ + C_GV + h * 256 + ch * 8); }
}
DI void phase_g1(const Ctx& C) {
    const bf16* P = WSP(bf16, WS_PROJ); bf16* QT = WSP(bf16, WS_QT); bf16* KT = WSP(bf16, WS_KT); bf16* UT = WSP(bf16, WS_UT); float* DL = WSP(float, WS_DL);
    const float* wup = C.in[16]; const float* bgate = C.in[17];
    LAS float* LA = (LAS float*)C.lds;
    LAS float* GA = (LAS float*)(C.lds + 32768);
    LAS float* WU = (LAS float*)(C.lds + 36864);
    LAS unsigned char* KH = C.lds + 45056;
    LAS unsigned char* VV = C.lds + 62464;
    const int tid = C.tid, lane = C.lane, w = C.wave;
    for (int unit = C.bid; unit < NCHUNK * 4; unit += C.G) {
        const int ci = unit >> 2, h = unit & 3, r0 = 64 * ci;
        { const int t = tid >> 3, pr = tid & 7; const unsigned g2 = *(const unsigned*)(P + (size_t)(r0 + t) * NPROJ + C_GA + 2 * pr); GA[t * 16 + 2 * pr] = bflo(g2); GA[t * 16 + 2 * pr + 1] = bfhi(g2);
          const int idx = tid * 4, r = idx >> 7, dk = idx & 127; *(LAS f32x4*)(WU + idx) = *(const f32x4*)(wup + (size_t)r * 512 + h * 128 + dk); }
        load_v_tile(C, P, r0, h, VV);
        __syncthreads();
        { const int dk = tid & 127, tq = tid >> 7; float wc[16];
#pragma unroll
          for (int r = 0; r < 16; ++r) wc[r] = WU[r * 128 + dk];
          const float bias = bgate[h * 128 + dk];
          for (int i = 0; i < 16; ++i) { const int t = tq * 16 + i; float x = bias;
#pragma unroll
              for (int r = 0; r < 16; ++r) x += GA[t * 16 + r] * wc[r];
              LA[t * 128 + dk] = logsigf_(x) * (1.0f / 16.0f); } }
        __syncthreads();
        if (tid < 128) { float run = 0.f; for (int t = 0; t < 64; ++t) { run += LA[t * 128 + tid]; LA[t * 128 + tid] = run; } }
        __syncthreads();
        { const int t = tid >> 3, dk0 = (tid & 7) * 16; const size_t prow = (size_t)(r0 + t) * NPROJ;
#pragma unroll
          for (int hf = 0; hf < 2; ++hf) {
              const int dk = dk0 + 8 * hf;
              const v4u qv = *(const v4u*)(P + prow + C_GQ + h * 128 + dk), kv = *(const v4u*)(P + prow + C_GK + h * 128 + dk);
              float qo[8], ko[8], kh[8];
#pragma unroll
              for (int e = 0; e < 8; ++e) {
                  const float q = (e & 1) ? bfhi(qv[e >> 1]) : bflo(qv[e >> 1]), k = (e & 1) ? bfhi(kv[e >> 1]) : bflo(kv[e >> 1]);
                  const float b = LA[t * 128 + dk + e], bl = LA[63 * 128 + dk + e];
                  qo[e] = q * GLA_QS * __expf(b); ko[e] = k * __expf(-b); kh[e] = k * __expf(bl - b);
              }
              v4u o; o.x = cvtpk(qo[0], qo[1]); o.y = cvtpk(qo[2], qo[3]); o.z = cvtpk(qo[4], qo[5]); o.w = cvtpk(qo[6], qo[7]);
              *(v4u*)(QT + (size_t)(r0 + t) * 512 + h * 128 + dk) = o;
              o.x = cvtpk(ko[0], ko[1]); o.y = cvtpk(ko[2], ko[3]); o.z = cvtpk(ko[4], ko[5]); o.w = cvtpk(ko[6], ko[7]);
              *(v4u*)(KT + (size_t)(r0 + t) * 512 + h * 128 + dk) = o;
              o.x = cvtpk(kh[0], kh[1]); o.y = cvtpk(kh[2], kh[3]); o.z = cvtpk(kh[4], kh[5]); o.w = cvtpk(kh[6], kh[7]);
              *(LAS v4u*)(KH + t * G_KHS + dk * 2) = o;
          }
          if (tid < 128) DL[(size_t)unit * 128 + tid] = __expf(LA[63 * 128 + tid]); }
        __syncthreads();
        {
            f32x16 acc[4] = {};
#pragma unroll
            for (int s = 0; s < 4; ++s) {
                const bf16x8 af = tr_frag(VV, G_VS, 16 * s, 32 * w, lane);
#pragma unroll
                for (int nt = 0; nt < 4; ++nt) { const bf16x8 bf_ = tr_frag(KH, G_KHS, 16 * s, 32 * nt, lane); acc[nt] = MFMA32(af, bf_, acc[nt]); }
            }
            bf16* ub = UT + ((size_t)unit * 256 + 32 * w) * 128;
            const int r32 = lane & 31, hh = lane >> 5;
#pragma unroll
            for (int nt = 0; nt < 4; ++nt)
#pragma unroll
                for (int r = 0; r < 16; ++r) ub[(size_t)crow(r, hh) * 128 + 32 * nt + r32] = (bf16)(cvtpk(acc[nt][r], 0.f) & 0xffffu);
        }
        __syncthreads();
    }
}
DI void phase_g2(const Ctx& C) {
    const bf16* __restrict__ UT = WSP(bf16, WS_UT); bf16* __restrict__ ST = WSP(bf16, WS_ST); const float* __restrict__ DL = WSP(float, WS_DL);
    for (int gid = C.bid * 512 + C.tid; gid < 8 * 256 * 64; gid += C.G * 512) {
        const int bh = gid >> 14, rem = gid & 16383, dv = rem >> 6, dk = (rem & 63) * 2, b = bh >> 2, h = bh & 3;
        float s0 = 0.f, s1 = 0.f;
#pragma unroll 8
        for (int c = 0; c < 128; ++c) {
            const size_t un = (size_t)((b * 128 + c) * 4 + h); const size_t idx = (un * 256 + dv) * 128 + dk;
            const unsigned u = *(const unsigned*)(UT + idx); const f32x2 d = *(const f32x2*)(DL + un * 128 + dk);
            *(unsigned*)(ST + idx) = cvtpk(s0, s1);
            s0 = d[0] * s0 + bflo(u); s1 = d[1] * s1 + bfhi(u);
        }
        float* o = C.out + O_GLA_P + ((size_t)(bh * 128 + dk)) * 256 + dv; o[0] = s0; o[256] = s1;
    }
}
DI void phase_g3(const Ctx& C) {
    const bf16* P = WSP(bf16, WS_PROJ); const bf16* QT = WSP(bf16, WS_QT); const bf16* KT = WSP(bf16, WS_KT); const bf16* ST = WSP(bf16, WS_ST); bf16* OG = WSP(bf16, WS_OG);
    const float* gnorm = C.in[18];
    LAS unsigned char* VV = C.lds; LAS float* RED = (LAS float*)(C.lds + 34816);
    const int lane = C.lane, w = C.wave, r32 = lane & 31, hh = lane >> 5;
    for (int unit = C.bid; unit < NCHUNK * 4; unit += C.G) {
        const int ci = unit >> 2, h = unit & 3, r0 = 64 * ci, dv0 = 32 * w;
        load_v_tile(C, P, r0, h, VV);
        __syncthreads();
        f32x16 o[2];
#pragma unroll
        for (int ti = 0; ti < 2; ++ti) {
            const int tt = 32 * ti + r32;
            bf16x8 qf[8];
#pragma unroll
            for (int s = 0; s < 8; ++s) qf[s] = *(const bf16x8*)(QT + (size_t)(r0 + tt) * 512 + h * 128 + 16 * s + 8 * hh);
            f32x16 acc = {};
            const bf16* srow = ST + ((size_t)unit * 256 + dv0 + r32) * 128 + 8 * hh;
#pragma unroll
            for (int s = 0; s < 8; ++s) { const bf16x8 af = *(const bf16x8*)(srow + 16 * s); acc = MFMA32(af, qf[s], acc); }
#pragma unroll
            for (int si = 0; si <= ti; ++si) {
                f32x16 X = {};
                const bf16* krow = KT + (size_t)(r0 + 32 * si + r32) * 512 + h * 128 + 8 * hh;
#pragma unroll
                for (int s = 0; s < 8; ++s) { const bf16x8 kf = *(const bf16x8*)(krow + 16 * s); X = MFMA32(kf, qf[s], X); }
                if (si == ti) {
#pragma unroll
                    for (int r = 0; r < 16; ++r) if (crow(r, hh) > r32) X[r] = 0.f;
                }
#pragma unroll
                for (int s2 = 0; s2 < 2; ++s2) { const bf16x8 pb = pack_acc(X, s2); const bf16x8 af = tr_frag_acc(VV, G_VS, 32 * si + 16 * s2, dv0, lane); acc = MFMA32(af, pb, acc); }
            }
            o[ti] = acc;
        }
#pragma unroll
        for (int ti = 0; ti < 2; ++ti) { float ss = 0.f;
#pragma unroll
            for (int r = 0; r < 16; ++r) ss += o[ti][r] * o[ti][r];
            ss += __shfl_xor(ss, 32); if (hh == 0) RED[w * 64 + 32 * ti + r32] = ss; }
        __syncthreads();
#pragma unroll
        for (int ti = 0; ti < 2; ++ti) {
            const int tt = 32 * ti + r32; float tot = 0.f;
#pragma unroll
            for (int ww = 0; ww < 8; ++ww) tot += RED[ww * 64 + tt];
            const float rstd = rsqrtf(tot * (1.f / 256.f) + EPS);
            const size_t prow = (size_t)(r0 + tt) * NPROJ + C_GR + h * 256; bf16* orow = OG + (size_t)(r0 + tt) * DM + h * 256;
#pragma unroll
            for (int m = 0; m < 4; ++m) { const int dv = dv0 + 8 * m + 4 * hh;
                const v2u gr = *(const v2u*)(P + prow + dv); const f32x4 gn = *(const f32x4*)(gnorm + h * 256 + dv);
                const float a0 = o[ti][4 * m] * rstd * gn[0] * siluf_(bflo(gr[0])), a1 = o[ti][4 * m + 1] * rstd * gn[1] * siluf_(bfhi(gr[0]));
                const float a2 = o[ti][4 * m + 2] * rstd * gn[2] * siluf_(bflo(gr[1])), a3 = o[ti][4 * m + 3] * rstd * gn[3] * siluf_(bfhi(gr[1]));
                v2u ov; ov.x = cvtpk(a0, a1); ov.y = cvtpk(a2, a3); *(v2u*)(orow + dv) = ov; }
        }
        __syncthreads();
    }
}
DI void phase_gla_sample(const Ctx& C) {
    const bf16* P = WSP(bf16, WS_PROJ); bf16* OG = WSP(bf16, WS_OG);
    const float* wup = C.in[16]; const float* bgate = C.in[17]; const float* gnorm = C.in[18]; const float* S0 = C.in[5];
    LAS float* QS = (LAS float*)C.lds; LAS float* KS = QS + 128; LAS float* AS = KS + 128; LAS float* GAs = AS + 128; LAS float* PART = GAs + 16; LAS float* RED = PART + 512;
    const int tid = C.tid;
    for (int unit = C.bid; unit < NSMP * 4; unit += C.G) {
        const int b = unit >> 2, h = unit & 3; const size_t prow = (size_t)(MPR + b) * NPROJ;
        if (tid < 16) GAs[tid] = bf2f(P[prow + C_GA + tid]);
        __syncthreads();
        if (tid < 128) { float x = bgate[h * 128 + tid];
#pragma unroll
            for (int r = 0; r < 16; ++r) x += GAs[r] * wup[(size_t)r * 512 + h * 128 + tid];
            AS[tid] = __expf(logsigf_(x) * (1.f / 16.f)); QS[tid] = bf2f(P[prow + C_GQ + h * 128 + tid]) * GLA_QS; KS[tid] = bf2f(P[prow + C_GK + h * 128 + tid]); }
        __syncthreads();
        const int dv = tid & 255, half = tid >> 8; const float v = bf2f(P[prow + C_GV + h * 256 + dv]);
        const float* s0 = S0 + ((size_t)unit * 128 + 64 * half) * 256 + dv; float* so = C.out + O_GLA_S + ((size_t)unit * 128 + 64 * half) * 256 + dv;
        float o = 0.f;
#pragma unroll 8
        for (int i = 0; i < 64; ++i) { const int dk = 64 * half + i; const float s = AS[dk] * s0[(size_t)i * 256] + KS[dk] * v; so[(size_t)i * 256] = s; o += QS[dk] * s; }
        PART[tid] = o;
        __syncthreads();
        float ov = 0.f, ss = 0.f;
        if (tid < 256) { ov = PART[tid] + PART[256 + tid]; ss = ov * ov; }
        ss = wave_sum(ss); if (C.lane == 0) RED[C.wave] = ss;
        __syncthreads();
        if (tid < 256) { const float tot = RED[0] + RED[1] + RED[2] + RED[3]; const float rstd = rsqrtf(tot * (1.f / 256.f) + EPS);
            const float val = ov * rstd * gnorm[h * 256 + tid] * siluf_(bf2f(P[prow + C_GR + h * 256 + tid]));
            OG[(size_t)(MPR + b) * DM + h * 256 + tid] = (bf16)(cvtpk(val, 0.f) & 0xffffu); }
        __syncthreads();
    }
}
constexpr int KSTR = 144;
constexpr int KV_TILE = 64 * KSTR;
DI void qk_tile(const LAS unsigned char* Kt, const bf16x8 (&qf)[4], int r32, int hh, f32x16& p0, f32x16& p1) {
    p0 = (f32x16){}; p1 = (f32x16){};
#pragma unroll
    for (int s = 0; s < 4; ++s) {
        const bf16x8 a0 = *(const LAS bf16x8*)(Kt + r32 * KSTR + 32 * s + 16 * hh), a1 = *(const LAS bf16x8*)(Kt + (32 + r32) * KSTR + 32 * s + 16 * hh);
        p0 = MFMA32(a0, qf[s], p0); p1 = MFMA32(a1, qf[s], p1);
    }
}
DI void pv_tile(const LAS unsigned char* Vt, const f32x16& p0, const f32x16& p1, f32x16& o0, f32x16& o1, int lane) {
#pragma unroll
    for (int kh = 0; kh < 2; ++kh)
#pragma unroll
        for (int s2 = 0; s2 < 2; ++s2) {
            const bf16x8 pb = pack_acc(kh ? p1 : p0, s2);
            const bf16x8 a0 = tr_frag_acc(Vt, KSTR, 32 * kh + 16 * s2, 0, lane), a1 = tr_frag_acc(Vt, KSTR, 32 * kh + 16 * s2, 32, lane);
            o0 = MFMA32(a0, pb, o0); o1 = MFMA32(a1, pb, o1);
        }
}
DI float max32(const f32x16& p0, const f32x16& p1) {
    float m = fmaxf(p0[0], p1[0]);
#pragma unroll
    for (int r = 1; r < 16; ++r) m = fmaxf(m, fmaxf(p0[r], p1[r]));
    return fmaxf(m, __shfl_xor(m, 32));
}
DI v4u ld_tile_row(const bf16* base, size_t pitch, int row0, int tid) { return *(const v4u*)(base + (size_t)(row0 + (tid >> 3)) * pitch + (tid & 7) * 8); }
DI void st_tile_row(LAS unsigned char* T, int tid, v4u v) { *(LAS v4u*)(T + (tid >> 3) * KSTR + (tid & 7) * 16) = v; }

DI bool attn_order(const Ctx& C, int i, int& bg, int& qt) {
    if (C.G == 256) { if (i >= 4) return false; const int s = C.bid & 31; bg = C.bid >> 5; qt = (i == 0) ? s : (i == 1) ? 63 - s : (i == 2) ? 64 + s : 127 - s; return true; }
    const int u = C.bid + i * C.G; if (u >= 1024) return false; bg = u >> 7; qt = u & 127; return true;
}

template <int MODE> DI void phase_attn_sw(const Ctx& C) {
    const bf16* P = WSP(bf16, WS_PROJ); const unsigned* SEL = WSP(unsigned, WS_SEL);
    const bf16* OC = WSP(bf16, WS_OC); const bf16* OWr = WSP(bf16, WS_OW); bf16* OUT = MODE == 1 ? WSP(bf16, WS_ONSA) : WSP(bf16, WS_OW);
    const int tid = C.tid, lane = C.lane, w = C.wave, r32 = lane & 31, hh = lane >> 5;
    LAS unsigned char* Kb = C.lds; LAS unsigned char* Vb = C.lds + 2 * KV_TILE;
    int bg, qt;
    for (int it = 0; attn_order(C, it, bg, qt); ++it) {
        const int b = bg >> 2, g = bg & 3, t0 = 64 * qt, tl = 8 * w + (r32 >> 2), t = t0 + tl, head = 4 * g + (r32 & 3);
        const size_t rowb = (size_t)b * SEQ; const size_t qrow = (rowb + t) * NPROJ;
        const bf16* Kp = P + rowb * NPROJ + (MODE == 1 ? C_KS : C_KW) + g * 128; const bf16* Vp = Kp + 64;
        bf16x8 qf[4];
#pragma unroll
        for (int s = 0; s < 4; ++s) qf[s] = *(const bf16x8*)(P + qrow + C_NQ + head * 64 + 16 * s + 8 * hh);
        v4u selw = (v4u){0u, 0u, 0u, 0u};
        if (MODE == 1) selw = *(const v4u*)(SEL + ((size_t)bg * SEQ + t) * 4);
        const int kt0 = MODE == 1 ? 0 : (qt >= 8 ? qt - 8 : 0);
        float m = -INFINITY, l = 0.f; f32x16 o0 = {}, o1 = {};
        v4u kreg = ld_tile_row(Kp, NPROJ, 64 * kt0, tid), vreg = ld_tile_row(Vp, NPROJ, 64 * kt0, tid);
        st_tile_row(Kb, tid, kreg); st_tile_row(Vb, tid, vreg);
        __syncthreads();
        for (int kt = kt0; kt <= qt; ++kt) {
            const int cur = (kt - kt0) & 1;
            if (kt < qt) { kreg = ld_tile_row(Kp, NPROJ, 64 * (kt + 1), tid); vreg = ld_tile_row(Vp, NPROJ, 64 * (kt + 1), tid); }
            f32x16 p0, p1;
            qk_tile(Kb + cur * KV_TILE, qf, r32, hh, p0, p1);
            if (MODE == 1) {
                const unsigned wsel = (kt < 32) ? selw[0] : (kt < 64) ? selw[1] : (kt < 96) ? selw[2] : selw[3];
                if (!((wsel >> (kt & 31)) & 1u)) {
#pragma unroll
                    for (int r = 0; r < 16; ++r) { p0[r] = -INFINITY; p1[r] = -INFINITY; }
                }
            }
            if (kt == qt) {
#pragma unroll
                for (int r = 0; r < 16; ++r) { const int kl = crow(r, hh); if (kl > tl) p0[r] = -INFINITY; if (kl + 32 > tl) p1[r] = -INFINITY; }
            }
            if (MODE == 2 && kt == qt - 8) {
#pragma unroll
                for (int r = 0; r < 16; ++r) { const int kl = crow(r, hh); if (kl <= tl) p0[r] = -INFINITY; if (kl + 32 <= tl) p1[r] = -INFINITY; }
            }
            const float mt = max32(p0, p1), mn = fmaxf(m, mt), mu = (mn == -INFINITY) ? 0.f : mn;
            const float alpha = __builtin_amdgcn_exp2f(m - mu); float rs = 0.f;
#pragma unroll
            for (int r = 0; r < 16; ++r) { p0[r] = __builtin_amdgcn_exp2f(p0[r] - mu); p1[r] = __builtin_amdgcn_exp2f(p1[r] - mu); rs += p0[r] + p1[r]; }
            l = l * alpha + rs; m = mn;
#pragma unroll
            for (int r = 0; r < 16; ++r) { o0[r] *= alpha; o1[r] *= alpha; }
            pv_tile(Vb + cur * KV_TILE, p0, p1, o0, o1, lane);
            if (kt < qt) { st_tile_row(Kb + (cur ^ 1) * KV_TILE, tid, kreg); st_tile_row(Vb + (cur ^ 1) * KV_TILE, tid, vreg); }
            __syncthreads();
        }
        const float lt = l + __shfl_xor(l, 32), inv = lt > 0.f ? 1.f / lt : 0.f;
        const float gate = sigmoidf_(bf2f(P[qrow + C_NG + head * 3 + (MODE == 1 ? 1 : 2)])) * inv;
        const size_t ooff = (rowb + t) * DM + head * 64;
#pragma unroll
        for (int dt = 0; dt < 2; ++dt)
#pragma unroll
            for (int mq = 0; mq < 4; ++mq) {
                const int d = 32 * dt + 8 * mq + 4 * hh; const f32x16& o = dt ? o1 : o0;
                float a0 = o[4 * mq] * gate, a1 = o[4 * mq + 1] * gate, a2 = o[4 * mq + 2] * gate, a3 = o[4 * mq + 3] * gate;
                if (MODE == 1) { const v2u c = *(const v2u*)(OC + ooff + d), ww = *(const v2u*)(OWr + ooff + d);
                    a0 += bflo(c[0]) + bflo(ww[0]); a1 += bfhi(c[0]) + bfhi(ww[0]); a2 += bflo(c[1]) + bflo(ww[1]); a3 += bfhi(c[1]) + bfhi(ww[1]); }
                v2u ov; ov.x = cvtpk(a0, a1); ov.y = cvtpk(a2, a3); *(v2u*)(OUT + ooff + d) = ov;
            }
    }
}

DI unsigned topk_select(const LAS float* IMP, int lane, int cur) {
    const int tlw = lane >> 3, sub = lane & 7;
    unsigned key[16]; unsigned fb = 0u;
#pragma unroll
    for (int i = 0; i < 16; ++i) { const int j = 16 * sub + i; const bool forced = (j == 0) || (j == cur) || (j == cur - 1); const bool cand = (j <= cur) && !forced;
        key[i] = cand ? (__float_as_uint(fmaxf(IMP[tlw * 128 + j], 0.f)) + 1u) : 0u; if (forced && j <= cur) fb |= 1u << i; }
    const int nforced = cur == 0 ? 1 : (cur == 1 ? 2 : 3), krem = 16 - nforced;
    unsigned T = 0u;
    for (int bit = 30; bit >= 0; --bit) { const unsigned Tn = T | (1u << bit); int cnt = 0;
#pragma unroll
        for (int i = 0; i < 16; ++i) cnt += (key[i] >= Tn) ? 1 : 0;
        cnt = sum8_i(cnt); if (cnt >= krem) T = Tn; }
    unsigned bits = 0u;
    if (T == 0u) {
#pragma unroll
        for (int i = 0; i < 16; ++i) bits |= (key[i] >= 1u ? 1u : 0u) << i;
    } else {
        int ngt = 0, neq = 0;
#pragma unroll
        for (int i = 0; i < 16; ++i) { ngt += (key[i] > T) ? 1 : 0; neq += (key[i] == T) ? 1 : 0; }
        const int need = krem - sum8_i(ngt);
        int run = 0;
#pragma unroll
        for (int s = 0; s < 8; ++s) { const int c = __shfl(neq, (lane & ~7) + s); if (s < sub) run += c; }
#pragma unroll
        for (int i = 0; i < 16; ++i) { if (key[i] > T) bits |= 1u << i; else if (key[i] == T) { if (run < need) bits |= 1u << i; ++run; } }
    }
    return bits | fb;
}

DI void phase_attn_cmp(const Ctx& C) {
    const bf16* P = WSP(bf16, WS_PROJ); unsigned* SEL = WSP(unsigned, WS_SEL); bf16* OC = WSP(bf16, WS_OC);
    const bf16* KVC = WSP(bf16, WS_KVC);
    const int tid = C.tid, lane = C.lane, w = C.wave, r32 = lane & 31, hh = lane >> 5;
    LAS unsigned char* Kb = C.lds; LAS unsigned char* Vb = C.lds + 2 * KV_TILE;
    LAS float* PS = (LAS float*)(C.lds + 4 * KV_TILE + w * 6400);
    LAS float* IMP = PS + 8 * 66 + 8;
    int bg, qt;
    for (int it = 0; attn_order(C, it, bg, qt); ++it) {
        const int b = bg >> 2, g = bg & 3, t0 = 64 * qt, tl = 8 * w + (r32 >> 2), t = t0 + tl, head = 4 * g + (r32 & 3);
        const size_t rowb = (size_t)b * SEQ; const size_t qrow = (rowb + t) * NPROJ;
        const bf16* Kp = KVC + ((size_t)CHK_S + (size_t)bg * 512) * 64; const bf16* Vp = Kp + (size_t)CHK_ROWS * 64;
        bf16x8 qf[4];
#pragma unroll
        for (int s = 0; s < 4; ++s) qf[s] = *(const bf16x8*)(P + qrow + C_NQ + head * 64 + 16 * s + 8 * hh);
        const int ntiles = (((t0 + 32) >> 4) >> 6) + 1;
        const int nmax = t >= 31 ? ((t - 31) >> 4) : -1;
        for (int i = lane; i < 8 * 128; i += 64) IMP[i] = 0.f;
        if (lane < 8) PS[lane * 66] = 0.f;
        float m = -INFINITY, l = 0.f;
        v4u kreg = ld_tile_row(Kp, 64, 0, tid), vreg;
        st_tile_row(Kb, tid, kreg);
        __syncthreads();
        for (int kt = 0; kt < ntiles; ++kt) {
            const int cur = kt & 1;
            if (kt + 1 < ntiles) kreg = ld_tile_row(Kp, 64, 64 * (kt + 1), tid);
            f32x16 p0, p1;
            qk_tile(Kb + cur * KV_TILE, qf, r32, hh, p0, p1);
#pragma unroll
            for (int r = 0; r < 16; ++r) { const int n = 64 * kt + crow(r, hh); if (n > nmax) p0[r] = -INFINITY; if (n + 32 > nmax) p1[r] = -INFINITY; }
            const float mt = max32(p0, p1), mn = fmaxf(m, mt), mu = (mn == -INFINITY) ? 0.f : mn;
            const float alpha = __builtin_amdgcn_exp2f(m - mu); float rs = 0.f;
#pragma unroll
            for (int r = 0; r < 16; ++r) rs += __builtin_amdgcn_exp2f(p0[r] - mu) + __builtin_amdgcn_exp2f(p1[r] - mu);
            l = l * alpha + rs; m = mn;
            if (kt + 1 < ntiles) st_tile_row(Kb + (cur ^ 1) * KV_TILE, tid, kreg);
            __syncthreads();
        }
        const float lt = l + __shfl_xor(l, 32), inv = lt > 0.f ? 1.f / lt : 0.f, mu = (m == -INFINITY) ? 0.f : m;
        f32x16 o0 = {}, o1 = {};
        kreg = ld_tile_row(Kp, 64, 0, tid); vreg = ld_tile_row(Vp, 64, 0, tid);
        st_tile_row(Kb, tid, kreg); st_tile_row(Vb, tid, vreg);
        __syncthreads();
        for (int kt = 0; kt < ntiles; ++kt) {
            const int cur = kt & 1;
            if (kt + 1 < ntiles) { kreg = ld_tile_row(Kp, 64, 64 * (kt + 1), tid); vreg = ld_tile_row(Vp, 64, 64 * (kt + 1), tid); }
            f32x16 p0, p1;
            qk_tile(Kb + cur * KV_TILE, qf, r32, hh, p0, p1);
#pragma unroll
            for (int r = 0; r < 16; ++r) { const int n = 64 * kt + crow(r, hh);
                p0[r] = (n > nmax) ? 0.f : __builtin_amdgcn_exp2f(p0[r] - mu) * inv; p1[r] = (n + 32 > nmax) ? 0.f : __builtin_amdgcn_exp2f(p1[r] - mu) * inv; }
            pv_tile(Vb + cur * KV_TILE, p0, p1, o0, o1, lane);
#pragma unroll
            for (int r = 0; r < 16; ++r) { const float s0 = quad_sum(p0[r]), s1 = quad_sum(p1[r]);
                if ((r32 & 3) == 0) { PS[(r32 >> 2) * 66 + 1 + crow(r, hh)] = s0; PS[(r32 >> 2) * 66 + 33 + crow(r, hh)] = s1; } }
            LDS_WAIT();
            { const int tk = lane >> 3, j0 = (lane & 7) * 2;
#pragma unroll
              for (int e = 0; e < 2; ++e) { const LAS float* ps = PS + tk * 66 + 1 + 4 * (j0 + e);
                  IMP[tk * 128 + 16 * kt + j0 + e] = ps[-1] + 2.f * (ps[0] + ps[1] + ps[2]) + ps[3]; } }
            LDS_WAIT();
            if (lane < 8) PS[lane * 66] = PS[lane * 66 + 64];
            LDS_WAIT();
            if (kt + 1 < ntiles) { st_tile_row(Kb + (cur ^ 1) * KV_TILE, tid, kreg); st_tile_row(Vb + (cur ^ 1) * KV_TILE, tid, vreg); }
            __syncthreads();
        }
        {
            const float gate = sigmoidf_(bf2f(P[qrow + C_NG + head * 3 + 0]));
            const size_t ooff = (rowb + t) * DM + head * 64;
#pragma unroll
            for (int dt = 0; dt < 2; ++dt)
#pragma unroll
                for (int mq = 0; mq < 4; ++mq) { const int d = 32 * dt + 8 * mq + 4 * hh; const f32x16& o = dt ? o1 : o0;
                    v2u ov; ov.x = cvtpk(o[4 * mq] * gate, o[4 * mq + 1] * gate); ov.y = cvtpk(o[4 * mq + 2] * gate, o[4 * mq + 3] * gate); *(v2u*)(OC + ooff + d) = ov; }
        }
        {
            const int sub = lane & 7, tk = lane >> 3;
            const unsigned bits = topk_select(IMP, lane, qt);
            unsigned wv = bits << (16 * (sub & 1)); wv |= (unsigned)dpp_i<0xB1>((int)wv);
            if ((sub & 1) == 0) SEL[((size_t)bg * SEQ + t0 + 8 * w + tk) * 4 + (sub >> 1)] = wv;
        }
        __syncthreads();
    }
}

DI f32x4 ld_bf4(const bf16* p) { const v2u v = *(const v2u*)p; return (f32x4){bflo(v[0]), bfhi(v[0]), bflo(v[1]), bfhi(v[1])}; }
template <int MODE> DI f32x4 smp_load(const Ctx& C, int b, int g, int n, int c, int i, const LAS long* koff) {
    if (MODE == 0) return ld_bf4(WSP(bf16, WS_KVC) + ((size_t)c * CHK_ROWS + (size_t)(b * 4 + g) * 512 + n) * 64 + 4 * i);
    if (MODE == 1) {
        const long o = koff[n >> 6];
        if (o < 0) return ld_bf4(WSP(bf16, WS_PROJ) + (size_t)(MPR + b) * NPROJ + C_KS + g * 128 + c * 64 + 4 * i);
        return *(const f32x4*)(C.in[3] + o + (size_t)(n & 63) * 512 + c * 64 + 4 * i);
    }
    if (n >= 512) return ld_bf4(WSP(bf16, WS_PROJ) + (size_t)(MPR + b) * NPROJ + C_KW + g * 128 + c * 64 + 4 * i);
    return *(const f32x4*)(C.in[4] + ((size_t)(b * 512 + n)) * 512 + g * 128 + c * 64 + 4 * i);
}
template <int MODE> DI bool smp_valid(int n, const LAS long* koff) {
    if (MODE == 0) return n < 511;
    if (MODE == 1) return koff[n >> 6] >= 0 || (n & 63) == 0;
    return n >= 1;
}
template <int MODE> DI void smp_branch(const Ctx& C, int b, int g, int N, const f32x4 (&qv)[4], LAS float* SC, LAS float* RED, const LAS long* koff, float& fin) {
    const int tid = C.tid, i = tid & 15, grp = tid >> 4, lane = C.lane, w = C.wave;
    for (int n0 = grp; n0 < N; n0 += 256) {
        f32x4 kv[8];
#pragma unroll
        for (int u = 0; u < 8; ++u) { const int n = n0 + 32 * u; kv[u] = smp_load<MODE>(C, b, g, n < N ? n : N - 1, 0, i, koff); }
#pragma unroll
        for (int u = 0; u < 8; ++u) {
            const int n = n0 + 32 * u;
            float part[4];
#pragma unroll
            for (int h = 0; h < 4; ++h) part[h] = sum16_f(qv[h][0] * kv[u][0] + qv[h][1] * kv[u][1] + qv[h][2] * kv[u][2] + qv[h][3] * kv[u][3]);
            if (i == 0 && n < N) { const bool ok = smp_valid<MODE>(n, koff);
#pragma unroll
                for (int h = 0; h < 4; ++h) SC[h * 1056 + n] = ok ? part[h] : -INFINITY; }
        }
    }
    __syncthreads();
    if (w < 4) {
        float m = -INFINITY;
        for (int n = lane; n < N; n += 64) m = fmaxf(m, SC[w * 1056 + n]);
        m = wave_max(m); const float mu = (m == -INFINITY) ? 0.f : m;
        float s = 0.f;
        for (int n = lane; n < N; n += 64) { const float e = __builtin_amdgcn_exp2f(SC[w * 1056 + n] - mu); SC[w * 1056 + n] = e; s += e; }
        s = wave_sum(s); const float inv = s > 0.f ? 1.f / s : 0.f;
        for (int n = lane; n < N; n += 64) SC[w * 1056 + n] *= inv;
    }
    __syncthreads();
    f32x4 acc[4] = {};
    for (int n0 = grp; n0 < N; n0 += 256) {
        f32x4 vv[8];
#pragma unroll
        for (int u = 0; u < 8; ++u) { const int n = n0 + 32 * u; vv[u] = smp_load<MODE>(C, b, g, n < N ? n : N - 1, 1, i, koff); }
#pragma unroll
        for (int u = 0; u < 8; ++u) {
            const int n = n0 + 32 * u;
            if (n < N) {
#pragma unroll
                for (int h = 0; h < 4; ++h) acc[h] += vv[u] * SC[h * 1056 + n];
            }
        }
    }
#pragma unroll
    for (int h = 0; h < 4; ++h) *(LAS f32x4*)(RED + (grp * 4 + h) * 64 + 4 * i) = acc[h];
    __syncthreads();
    if (tid < 256) { const int h = tid >> 6, d = tid & 63; float s = 0.f;
#pragma unroll 8
        for (int gq = 0; gq < 32; ++gq) s += RED[(gq * 4 + h) * 64 + d];
        const float gate = sigmoidf_(bf2f(WSP(bf16, WS_PROJ)[(size_t)(MPR + b) * NPROJ + C_NG + (4 * g + h) * 3 + MODE]));
        fin += gate * s; }
    __syncthreads();
}
DI void phase_nsa_sample(const Ctx& C) {
    const bf16* P = WSP(bf16, WS_PROJ); bf16* ONSA = WSP(bf16, WS_ONSA);
    LAS float* SC = (LAS float*)C.lds;
    LAS float* RED = SC + 4 * 1056;
    LAS float* IMPS = RED + 32 * 4 * 64;
    LAS float* PSM = IMPS + 8 * 128;
    LAS long* KOFF = (LAS long*)(PSM + 528);
    LAS unsigned* SELW = (LAS unsigned*)(KOFF + 16);
    const int tid = C.tid, i = tid & 15, lane = C.lane, w = C.wave;
    for (int unit = C.bid; unit < NSMP * 4; unit += C.G) {
        const int b = unit >> 2, g = unit & 3; const size_t prow = (size_t)(MPR + b) * NPROJ;
        f32x4 qv[4];
#pragma unroll
        for (int h = 0; h < 4; ++h) qv[h] = ld_bf4(P + prow + C_NQ + (4 * g + h) * 64 + 4 * i);
        float fin = 0.f;
        smp_branch<0>(C, b, g, 511, qv, SC, RED, KOFF, fin);
        for (int n = tid; n < 528; n += 512) { const int nn = n - 4; PSM[n] = (nn >= 0 && nn < 511) ? (SC[nn] + SC[1056 + nn] + SC[2 * 1056 + nn] + SC[3 * 1056 + nn]) : 0.f; }
        __syncthreads();
        for (int j = tid; j < 8 * 128; j += 512) { const int jj = j & 127; const LAS float* ps = PSM + 4 + 4 * jj; IMPS[j] = ps[-1] + 2.f * (ps[0] + ps[1] + ps[2]) + ps[3]; }
        __syncthreads();
        if (w == 0) {
            const int sub = lane & 7; const unsigned bits = topk_select(IMPS, lane, 128);
            unsigned wv = bits << (16 * (sub & 1)); wv |= (unsigned)dpp_i<0xB1>((int)wv);
            if (lane < 8 && (sub & 1) == 0) SELW[sub >> 1] = wv;
        }
        __syncthreads();
        if (tid == 0) { int c = 0; const int* pt = (const int*)C.in[7];
            for (int j = 0; j < 128; ++j) if ((SELW[j >> 5] >> (j & 31)) & 1u) { if (c < 15) KOFF[c] = ((long)pt[b * NPAGES + (j >> 1)] * PAGE + (j & 1) * 64) * 512 + g * 128; ++c; }
            for (; c < 15; ++c) KOFF[c] = KOFF[0];
            KOFF[15] = -1; }
        __syncthreads();
        smp_branch<1>(C, b, g, 1024, qv, SC, RED, KOFF, fin);
        smp_branch<2>(C, b, g, 513, qv, SC, RED, KOFF, fin);
        if (tid < 256) ONSA[(size_t)(MPR + b) * DM + (4 * g + (tid >> 6)) * 64 + (tid & 63)] = (bf16)(cvtpk(fin, 0.f) & 0xffffu);
        __syncthreads();
    }
}
constexpr int TD_A = 128 * KSTR  , TD_B = 256 * KSTR  , TD_BUF = TD_A + TD_B  , TD_PGO = 2 * TD_BUF  ;
template <int MODE> DI void phase_tdirect(const Ctx& C) {
    const bf16* W1T = WSP(bf16, WS_W1_T); bf16* T = WSP(bf16, WS_T); const bf16* P = WSP(bf16, WS_PROJ);
    const float* cache = C.in[2]; const int* pt = (const int*)C.in[7];
    LAS long* PGO = (LAS long*)(C.lds + TD_PGO);
    const int tid = C.tid, lane = C.lane, w = C.wave, r32 = lane & 31, hh = lane >> 5;
    const int nunits = MODE == 0 ? NSMP * 32 : NBP * 32;
    for (int unit = C.bid; unit < nunits; unit += C.G) {
        const int b = unit >> 5, g = (unit >> 3) & 3, q4 = (unit >> 1) & 3, c = unit & 1;
        const int R0 = (MODE == 0 ? 0 : CHK_S) + (b * 4 + g) * 512 + 128 * q4;
        if (MODE == 0) { if (tid < 128) PGO[tid] = ((long)pt[b * NPAGES + 16 * q4 + (tid >> 3)] * PAGE + 16 * (tid & 7)) * 512 + g * 128 + c * 64; }
        __syncthreads();
        f32x4 areg[4]; v4u aregb[2]; v4u breg[4];
        const bf16* pbase = P + ((size_t)b * SEQ + 2048 * q4 + 16 * (tid >> 3)) * NPROJ + C_KC + g * 128 + c * 64 + (tid & 7) * 8;
        const bf16* wbase = W1T + ((size_t)c * 256 + (tid >> 3)) * 1024 + (tid & 7) * 8;
#define TD_LOAD(pos) do { \
        if (MODE == 0) { _Pragma("unroll") for (int i = 0; i < 4; ++i) areg[i] = *(const f32x4*)(cache + PGO[i * 32 + (tid >> 4)] + (tid & 15) * 4 + (size_t)(pos) * 512); } \
        else { _Pragma("unroll") for (int i = 0; i < 2; ++i) aregb[i] = *(const v4u*)(pbase + ((size_t)(i * 1024 + (pos))) * NPROJ); } \
        _Pragma("unroll") for (int i = 0; i < 4; ++i) breg[i] = *(const v4u*)(wbase + (size_t)(i * 64) * 1024 + (pos) * 64); } while (0)
#define TD_STORE(buf) do { LAS unsigned char* Ab_ = C.lds + (buf) * TD_BUF; LAS unsigned char* Bb_ = Ab_ + TD_A; \
        if (MODE == 0) { _Pragma("unroll") for (int i = 0; i < 4; ++i) { const int jr = i * 32 + (tid >> 4); v2u o; o.x = cvtpk(areg[i][0], areg[i][1]); o.y = cvtpk(areg[i][2], areg[i][3]); \
                *(LAS v2u*)(Ab_ + jr * KSTR + (tid & 15) * 8) = o; } } \
        else { _Pragma("unroll") for (int i = 0; i < 2; ++i) { const int jr = i * 64 + (tid >> 3); *(LAS v4u*)(Ab_ + jr * KSTR + (tid & 7) * 16) = aregb[i]; } } \
        _Pragma("unroll") for (int i = 0; i < 4; ++i) *(LAS v4u*)(Bb_ + (i * 64 + (tid >> 3)) * KSTR + (tid & 7) * 16) = breg[i]; } while (0)
        f32x16 acc[2][2];
#pragma unroll
        for (int nt = 0; nt < 2; ++nt)
#pragma unroll
            for (int rt = 0; rt < 2; ++rt) acc[nt][rt] = (f32x16){};
        const int n0 = (w & 3) * 64, row0 = (w >> 2) * 64;
        TD_LOAD(0); TD_STORE(0); TD_LOAD(1);
        __syncthreads();
        for (int pos = 0; pos < 16; ++pos) {
            const int cur = pos & 1;
            if (pos < 15) { TD_STORE(cur ^ 1); }
            if (pos < 14) { TD_LOAD(pos + 2); }
            const LAS unsigned char* Ac = C.lds + cur * TD_BUF + (row0 + r32) * KSTR + 16 * hh; const LAS unsigned char* Bc = C.lds + cur * TD_BUF + TD_A + (n0 + r32) * KSTR + 16 * hh;
#pragma unroll
            for (int ks = 0; ks < 4; ++ks) {
                bf16x8 wf[2], af[2];
#pragma unroll
                for (int nt = 0; nt < 2; ++nt) wf[nt] = *(const LAS bf16x8*)(Bc + nt * 32 * KSTR + 32 * ks);
#pragma unroll
                for (int rt = 0; rt < 2; ++rt) af[rt] = *(const LAS bf16x8*)(Ac + rt * 32 * KSTR + 32 * ks);
#pragma unroll
                for (int nt = 0; nt < 2; ++nt)
#pragma unroll
                    for (int rt = 0; rt < 2; ++rt) acc[nt][rt] = MFMA32(wf[nt], af[rt], acc[nt][rt]);
            }
            __syncthreads();
        }
#undef TD_LOAD
#undef TD_STORE
        bf16* Tc = T + ((size_t)c * CHK_ROWS + R0 + row0) * 256;
#pragma unroll
        for (int nt = 0; nt < 2; ++nt)
#pragma unroll
            for (int rt = 0; rt < 2; ++rt)
#pragma unroll
                for (int m = 0; m < 4; ++m) { v2u o; o.x = cvtpk(acc[nt][rt][4 * m], acc[nt][rt][4 * m + 1]); o.y = cvtpk(acc[nt][rt][4 * m + 2], acc[nt][rt][4 * m + 3]);
                    *(v2u*)(Tc + (size_t)(32 * rt + r32) * 256 + n0 + 32 * nt + 8 * m + 4 * hh) = o; }
    }
}
#ifndef MK_ONE_LAUNCH
#define MK_ONE_LAUNCH 1
#endif
#ifndef MK_DUP_MASK
#define MK_DUP_MASK 0
#endif
#ifndef MK_DUPF
#define MK_DUPF 0
#endif
#define DUPF(bit, call) do { call; if constexpr (((MK_DUPF >> (bit)) & 1) != 0) { __syncthreads(); call; } } while (0)
constexpr int N_PHASES = 14;
struct Args { const float* in[33]; float* out; unsigned char* ws; int ph_lo, ph_hi; };
static_assert(sizeof(Args) == 33 * 8 + 8 + 8 + 8, "Args has no padding");

template <class Epi> DI void run_gemm(const Ctx& C, const bf16* A, const bf16* Bt, int M, int N, int K, const Epi& E) {
    pg8::Gemm g{A, Bt, M, N, K}; pg8::StaticOrder S; S.init(M, N, C.G, C.bid);
    pg8::gemm_phase<Epi, pg8::StaticOrder, true, true>(C.lds, g, S, E);
}

template <class Epi> DI void gemm_skinny(const Ctx& C, const bf16* A, const bf16* Bt, int N, int K, const Epi& E) {
    LAS f32x4* red = (LAS f32x4*)C.lds;
    const int lane = C.lane, w = C.wave, ntasks = N / 16, kper = K / 8;
    for (int t = C.bid; t < ntasks; t += C.G) {
        const int col0 = 16 * t;
        const bf16* bp = Bt + (size_t)(col0 + (lane & 15)) * K + w * kper + 8 * (lane >> 4);
        const bf16* ap = A + (size_t)(MPR + (lane & 15)) * K + w * kper + 8 * (lane >> 4);
        f32x4 acc0 = {0.f, 0.f, 0.f, 0.f}, acc1 = acc0;
#pragma unroll 4
        for (int kk = 0; kk < kper; kk += 32) {
            const bf16x8 bw = *(const bf16x8*)(bp + kk), a0 = *(const bf16x8*)(ap + kk), a1 = *(const bf16x8*)(ap + (size_t)16 * K + kk);
            acc0 = __builtin_amdgcn_mfma_f32_16x16x32_bf16(bw, a0, acc0, 0, 0, 0); acc1 = __builtin_amdgcn_mfma_f32_16x16x32_bf16(bw, a1, acc1, 0, 0, 0);
        }
        red[(w * 2 + 0) * 64 + lane] = acc0; red[(w * 2 + 1) * 64 + lane] = acc1;
        __syncthreads();
        if (w == 0) {
            f32x4 v0 = red[lane], v1 = red[64 + lane];
#pragma unroll
            for (int ww = 1; ww < 8; ++ww) { v0 += red[(ww * 2) * 64 + lane]; v1 += red[(ww * 2 + 1) * 64 + lane]; }
            E.e4(MPR + (lane & 15), col0 + 4 * (lane >> 4), v0); E.e4(MPR + 16 + (lane & 15), col0 + 4 * (lane >> 4), v1);
        }
        __syncthreads();
    }
}

__global__ void __launch_bounds__(512, 2) fwd_kernel(Args args) {
    extern __shared__ __attribute__((aligned(16))) unsigned char lds_raw[];
    Ctx C;
    C.lds = (LAS unsigned char*)lds_raw;
    C.tid = threadIdx.x; C.lane = C.tid & 63; C.wave = __builtin_amdgcn_readfirstlane(C.tid >> 6);
    C.G = gridDim.x; C.bid = blockIdx.x;
#pragma unroll
    for (int i = 0; i < 33; ++i) C.in[i] = args.in[i];
    C.out = args.out; C.ws = args.ws;
    volatile LAS unsigned* MISC = (volatile LAS unsigned*)(C.lds + MISC_OFF);
    if (C.tid < 32) MISC[C.tid] = 0u;
    __syncthreads();
    XcdBarrier bar; bar.bar = (unsigned*)(args.ws + WS_CTL) + CW_BAR; bar.x = 0; bar.st = nullptr;
    if (MK_ONE_LAUNCH) bar = xcd_barrier_post((unsigned*)(args.ws + WS_CTL) + CW_BAR, MISC + 8);
    const int lo = args.ph_lo, hi = args.ph_hi;
#define IN(k) (lo <= (k) && (k) < hi)
#define SEAM(k) do { if (IN(k) && IN((k) + 1)) { if (MK_ONE_LAUNCH) xcd_barrier(bar); } } while (0)

#define PH(k, ...) do { if (IN(k)) { __VA_ARGS__; if constexpr (((MK_DUP_MASK >> (k)) & 1) != 0) { __syncthreads(); __VA_ARGS__; } } SEAM(k); } while (0)
    PH(0, phase_prologue(C); __syncthreads());
    PH(1, { pg8::EpiProj E{WSP(bf16, WS_PROJ), C.out}; run_gemm(C, WSP(bf16, WS_XN), WSP(bf16, WS_WIN_T), MP, NPROJ, DM, E); } __syncthreads();
          { pg8::EpiStore<false> E{WSP(bf16, WS_PP), DM, nullptr}; run_gemm(C, WSP(bf16, WS_PB), WSP(bf16, WS_WPP_T), MPR, DM, PLE, E); __syncthreads(); gemm_skinny(C, WSP(bf16, WS_PB), WSP(bf16, WS_WPP_T), DM, PLE, E); });
    PH(2, DUPF(6, phase_tdirect<0>(C)); __syncthreads(); phase_tdirect<1>(C); __syncthreads(); DUPF(2, phase_g1(C)); __syncthreads(); DUPF(3, phase_attn_sw<2>(C)); __syncthreads(); DUPF(4, phase_gla_sample(C)); __syncthreads());
    PH(3, DUPF(5, phase_g2(C)); __syncthreads(); DUPF(7, phase_kvc(C)); __syncthreads());
    PH(4, DUPF(8, phase_g3(C)); __syncthreads(); DUPF(0, phase_attn_cmp(C)); __syncthreads(); DUPF(1, phase_nsa_sample(C)); __syncthreads());
    PH(5, { pg8::EpiStore<false> E{WSP(bf16, WS_YG), DM, nullptr}; run_gemm(C, WSP(bf16, WS_OG), WSP(bf16, WS_WGO_T), MPR, DM, DM, E); __syncthreads(); gemm_skinny(C, WSP(bf16, WS_OG), WSP(bf16, WS_WGO_T), DM, DM, E); } __syncthreads();
          DUPF(9, phase_attn_sw<1>(C)); __syncthreads());
    PH(6, { pg8::EpiMix E{WSP(bf16, WS_PROJ), WSP(bf16, WS_YG), WSP(bf16, WS_MIX)}; run_gemm(C, WSP(bf16, WS_ONSA), WSP(bf16, WS_WNO_T), MPR, DM, DM, E); __syncthreads(); gemm_skinny(C, WSP(bf16, WS_ONSA), WSP(bf16, WS_WNO_T), DM, DM, E); });
    PH(7, { pg8::EpiF32 E{WSP(float, WS_T1), DM}; run_gemm(C, WSP(bf16, WS_MIX), WSP(bf16, WS_WOUT_T), MPR, DM, DM, E); __syncthreads(); gemm_skinny(C, WSP(bf16, WS_MIX), WSP(bf16, WS_WOUT_T), DM, DM, E); });
    PH(8, phase_rownorm(C, WSP(float, WS_T1), C.in[0], C.in[1], C.in[11], C.in[12], WSP(float, WS_X1), WSP(bf16, WS_XN)));
    PH(9, { pg8::EpiStore<true> E{WSP(bf16, WS_UP), NUP, C.out}; run_gemm(C, WSP(bf16, WS_XN), WSP(bf16, WS_WUP_T), MP, NUP, DM, E); });
    PH(10, phase_conv(C));
    PH(11, { pg8::EpiF32 E{WSP(float, WS_T1), DM}; run_gemm(C, WSP(bf16, WS_H), WSP(bf16, WS_WDN_T), MPR, DM, DFF, E); __syncthreads(); gemm_skinny(C, WSP(bf16, WS_H), WSP(bf16, WS_WDN_T), DM, DFF, E); });
    PH(12, phase_rownorm(C, WSP(float, WS_T1), WSP(float, WS_X1), WSP(float, WS_X1) + (size_t)MPR * DM, C.in[13], C.in[14], WSP(float, WS_X2), WSP(bf16, WS_XN)));
    if (IN(13)) { pg8::EpiFinal E{WSP(float, WS_X2), WSP(bf16, WS_PP), C.out}; run_gemm(C, WSP(bf16, WS_XN), WSP(bf16, WS_WPG_T), MPR, DM, DM, E); __syncthreads(); gemm_skinny(C, WSP(bf16, WS_XN), WSP(bf16, WS_WPG_T), DM, DM, E); }
#undef PH
#undef IN
#undef SEAM
}

extern "C" void kernel_launch(void* const* d_in, const int* in_sizes, int n_in, void* d_out, int out_size, void* d_ws, size_t ws_size, hipStream_t stream) {
    static int grid = 0;
    if (grid == 0) {
        if (n_in != 33 || (size_t)out_size != O_END || ws_size < WS_END) { fprintf(stderr, "kernel_launch: unexpected shapes (n_in %d, out %d, ws %zu, need %zu)\n", n_in, out_size, ws_size, (size_t)WS_END); grid = -1; return; }
        int dev = 0, cus = 0, per_cu = 0;
        if (hipGetDevice(&dev) != hipSuccess || hipDeviceGetAttribute(&cus, hipDeviceAttributeMultiprocessorCount, dev) != hipSuccess) { grid = -1; return; }
        if (hipFuncSetAttribute((const void*)fwd_kernel, hipFuncAttributeMaxDynamicSharedMemorySize, LDS_BYTES) != hipSuccess) { fprintf(stderr, "kernel_launch: hipFuncSetAttribute failed\n"); grid = -1; return; }
        if (hipOccupancyMaxActiveBlocksPerMultiprocessor(&per_cu, (const void*)fwd_kernel, 512, LDS_BYTES) != hipSuccess || per_cu < 1) fprintf(stderr, "kernel_launch: occupancy query says %d\n", per_cu);
        (void)hipGetLastError();
        grid = cus;
    }
    if (grid < 0) return;
    (void)hipMemsetAsync((char*)d_ws + WS_CTL, 0, CTL_BYTES, stream);
    Args a{};
    for (int i = 0; i < 33; ++i) a.in[i] = (const float*)d_in[i];
    a.out = (float*)d_out; a.ws = (unsigned char*)d_ws;
#if MK_ONE_LAUNCH
    a.ph_lo = 0; a.ph_hi = N_PHASES;
    hipLaunchKernelGGL(fwd_kernel, dim3(grid), dim3(512), LDS_BYTES, stream, a);
#else
    for (int p = 0; p < N_PHASES; ++p) { a.ph_lo = p; a.ph_hi = p + 1; hipLaunchKernelGGL(fwd_kernel, dim3(grid), dim3(512), LDS_BYTES, stream, a); }
#endif
    const hipError_t le = hipPeekAtLastError();
    if (le != hipSuccess) fprintf(stderr, "kernel_launch: launch failed: %s\n", hipGetErrorName(le));
}
```

```cpp
#include <hip/hip_runtime.h>
#include <hip/hip_bf16.h>
#include <cstdio>
#include <cstdint>
#define MK_ONE_LAUNCH 1
namespace pg8 {
#define PG8_LAS __attribute__((address_space(3)))
typedef unsigned short bf16_t;
typedef short bf16x8 __attribute__((ext_vector_type(8)));
typedef float f32x4 __attribute__((ext_vector_type(4)));
typedef unsigned u32x4 __attribute__((ext_vector_type(4)));
constexpr int BM = 256, BK = 64, HALF = 128, HTB = HALF * BK * 2  , STAGE_BYTES = 8 * HTB, NXCD = 8, WGM = 8;

__host__ __device__ __forceinline__ int lds_byte(int r, int c) { const int st = (r >> 4) * 2 + (c >> 5), rr = r & 15, cc = c & 31, ob = rr * 64 + cc * 2; return st * 1024 + (ob ^ (((ob >> 9) & 1) << 5)); }
__host__ __device__ __forceinline__ void stage_rc(int b, int& R, int& C) { const int st = b / 1024, sb = b % 1024, swz = sb ^ (((sb >> 9) & 1) << 5); R = (st >> 1) * 16 + swz / 64; C = (st & 1) * 32 + (swz % 64) / 2; }
__host__ __device__ __forceinline__ int perm32(int rho) { const int n = rho >> 4, i = rho & 15; return 8 * (i >> 2) + 4 * n + (i & 3); }

struct Unit { int pm, pn; };
struct Gemm { const bf16_t* A; const bf16_t* Bt; int M, N, K; };

struct StaticOrder {
    int nM, nN, nwg, G, c;
    __host__ __device__ void init(int M, int N, int G_, int c_) { nM = M / BM; nN = N / BM; nwg = nM * nN; G = G_; c = c_; }
    __host__ __device__ bool next(int i, Unit& u) const {
        const long L = (long)i * G + c; if (L >= nwg) return false;
        int wgid = (int)L; { const int q = nwg / NXCD, r = nwg % NXCD, xcd = wgid % NXCD, off = wgid / NXCD; wgid = (xcd < r ? xcd * (q + 1) : r * (q + 1) + (xcd - r) * q) + off; }
        const int nig = WGM * nN, gid = wgid / nig, fm = gid * WGM, gsz = (nM - fm) < WGM ? (nM - fm) : WGM;
        u.pm = fm + ((wgid % nig) % gsz); u.pn = (wgid % nig) / gsz; return true;
    }
    __device__ __forceinline__ void a_ready(const Unit&) const {}
    __device__ __forceinline__ void done(const Unit&) const {}
};

__device__ __forceinline__ unsigned cvt_pk_bf16(float lo, float hi) { unsigned r; asm volatile("v_cvt_pk_bf16_f32 %0, %1, %2" : "=v"(r) : "v"(lo), "v"(hi)); return r; }
typedef float f32x2 __attribute__((ext_vector_type(2)));
template <class Epi, class Sched, bool ALIGN_EPI = false, bool SP2 = false>
__device__ __forceinline__ void gemm_phase(PG8_LAS unsigned char* lds, const Gemm g, const Sched& S, const Epi& E) {
    const int tid = threadIdx.x, wid = __builtin_amdgcn_readfirstlane(tid >> 6), lane = tid & 63, wr = wid >> 2, wc = wid & 3, fr = lane & 15, fq = lane >> 4;
    const int K = g.K, nt = K / BK;
    unsigned voffA[2], voffB[2];
#pragma unroll
    for (int i = 0; i < 2; ++i) { int R, C; stage_rc(tid * 16 + i * 8192, R, C); const int Rb = Epi::PERM ? ((R & ~31) + perm32(R & 31)) : R;
        voffA[i] = (unsigned)(R * K + C) * 2u; voffB[i] = (unsigned)(Rb * K + C) * 2u; }
    const size_t kstep = (size_t)(BK * 2);
    const size_t hstep = (size_t)HALF * K * 2;
    const size_t tstep = 2 * hstep;
    const unsigned ldsw = (unsigned)wid * 1024u;
    const int aoff = lds_byte(wr * 64 + fr, fq * 8), boff = lds_byte(wc * 32 + fr, fq * 8);
#define PG8_SA(b, h) (((b) * 2 + (h)) * HTB)
#define PG8_SB(b, h) ((4 + (b) * 2 + (h)) * HTB)
#define PG8_STAGE(bufoff, gbase, voff) do { _Pragma("unroll") for (int _i = 0; _i < 2; ++_i) \
        __builtin_amdgcn_global_load_lds((const unsigned*)((const char*)(gbase) + (voff)[_i]), (PG8_LAS unsigned*)(lds + (bufoff) + ldsw + _i * 8192), 16, 0, 0); } while (0)
#define PG8_LDA(dst, b, h) do { _Pragma("unroll") for (int m = 0; m < 4; ++m) _Pragma("unroll") for (int k = 0; k < 2; ++k) dst[m][k] = *(const PG8_LAS bf16x8*)(lds + PG8_SA(b, h) + aoff + m * 2048 + k * 1024); } while (0)
#define PG8_LDB(dst, b, h) do { _Pragma("unroll") for (int n = 0; n < 2; ++n) _Pragma("unroll") for (int k = 0; k < 2; ++k) dst[n][k] = *(const PG8_LAS bf16x8*)(lds + PG8_SB(b, h) + boff + n * 2048 + k * 1024); } while (0)
#define PG8_MMA(ai, bj, At, Bt) do { __builtin_amdgcn_s_setprio(1); _Pragma("unroll") for (int m = 0; m < 4; ++m) _Pragma("unroll") for (int n = 0; n < 2; ++n) _Pragma("unroll") for (int k = 0; k < 2; ++k) \
        acc[ai][bj][m][n] = __builtin_amdgcn_mfma_f32_16x16x32_bf16(Bt[n][k], At[m][k], acc[ai][bj][m][n], 0, 0, 0); __builtin_amdgcn_s_setprio(0); } while (0)
#define PG8_WAIT_V(n) asm volatile("s_waitcnt vmcnt(" #n ")" ::: "memory")
#define PG8_WAIT_L(n) asm volatile("s_waitcnt lgkmcnt(" #n ")" ::: "memory")
#define PG8_BAR __builtin_amdgcn_s_barrier()
#define PG8_SCHED __builtin_amdgcn_sched_barrier(0)
    Unit cur, nxt; int ui = 0;
    if (!S.next(0, cur)) return;
    f32x4 acc[2][2][4][2];
#pragma unroll
    for (int a = 0; a < 2; ++a)
#pragma unroll
        for (int b = 0; b < 2; ++b)
#pragma unroll
            for (int m = 0; m < 4; ++m)
#pragma unroll
                for (int n = 0; n < 2; ++n) acc[a][b][m][n] = (f32x4){0.f, 0.f, 0.f, 0.f};
    bf16x8 At[4][2], B0[2][2], B1[2][2];
    const char* cA = (const char*)g.A + (size_t)cur.pm * tstep; const char* cB = (const char*)g.Bt + (size_t)cur.pn * tstep;
    S.a_ready(cur);
    if constexpr (SP2) {
        PG8_STAGE(PG8_SB(0, 0), cB, voffB); PG8_STAGE(PG8_SB(0, 1), cB + hstep, voffB); PG8_STAGE(PG8_SA(0, 0), cA, voffA); PG8_STAGE(PG8_SA(0, 1), cA + hstep, voffA);
        if (wr == 1) PG8_BAR;
        PG8_WAIT_V(2); PG8_BAR;
        PG8_STAGE(PG8_SB(1, 0), cB + kstep, voffB); PG8_STAGE(PG8_SA(1, 0), cA + kstep, voffA); PG8_STAGE(PG8_SB(1, 1), cB + hstep + kstep, voffB);
        PG8_WAIT_V(6); PG8_BAR;
    } else {
        PG8_STAGE(PG8_SB(0, 0), cB, voffB); PG8_STAGE(PG8_SA(0, 0), cA, voffA); PG8_STAGE(PG8_SB(0, 1), cB + hstep, voffB); PG8_STAGE(PG8_SA(0, 1), cA + hstep, voffA);
        if (wr == 1) PG8_BAR;
        PG8_WAIT_V(4); PG8_BAR;
        PG8_STAGE(PG8_SB(1, 0), cB + kstep, voffB); PG8_STAGE(PG8_SA(1, 0), cA + kstep, voffA); PG8_STAGE(PG8_SB(1, 1), cB + hstep + kstep, voffB);
        PG8_WAIT_V(6); PG8_BAR;
    }
    for (;;) {
        const bool has_next = S.next(ui + 1, nxt);
        const char* nA = has_next ? (const char*)g.A + (size_t)nxt.pm * tstep : cA; const char* nB = has_next ? (const char*)g.Bt + (size_t)nxt.pn * tstep : cB;
        for (int t = 0; t < nt; t += 2) {
            const bool last = (t == nt - 2);
            const char* a1 = cA + (size_t)(t + 1) * kstep;
            const char* a2 = last ? nA : cA + (size_t)(t + 2) * kstep; const char* b2 = last ? nB : cB + (size_t)(t + 2) * kstep;
            const char* a3 = a2 + kstep; const char* b3 = b2 + kstep;
            if (last && has_next) S.a_ready(nxt);
            if constexpr (SP2) {
            PG8_LDB(B0, 0, 0); PG8_LDB(B1, 0, 1); PG8_SCHED; PG8_LDA(At, 0, 0); PG8_STAGE(PG8_SA(1, 1), a1 + hstep, voffA);
            PG8_WAIT_V(8); PG8_WAIT_L(0); PG8_BAR; PG8_MMA(0, 0, At, B0); PG8_MMA(0, 1, At, B1); PG8_BAR; PG8_SCHED;
            PG8_LDA(At, 0, 1); PG8_STAGE(PG8_SB(0, 0), b2, voffB); PG8_STAGE(PG8_SB(0, 1), b2 + hstep, voffB); PG8_STAGE(PG8_SA(0, 0), a2, voffA);
            PG8_WAIT_V(8); PG8_WAIT_L(0); PG8_BAR; PG8_MMA(1, 0, At, B0); PG8_MMA(1, 1, At, B1); PG8_BAR; PG8_SCHED;
            PG8_LDB(B0, 1, 0); PG8_LDB(B1, 1, 1); PG8_SCHED; PG8_LDA(At, 1, 0); PG8_STAGE(PG8_SA(0, 1), a2 + hstep, voffA);
            PG8_WAIT_V(8); PG8_WAIT_L(0); PG8_BAR; PG8_MMA(0, 0, At, B0); PG8_MMA(0, 1, At, B1); PG8_BAR; PG8_SCHED;
            PG8_LDA(At, 1, 1); PG8_STAGE(PG8_SB(1, 0), b3, voffB); PG8_STAGE(PG8_SB(1, 1), b3 + hstep, voffB); PG8_STAGE(PG8_SA(1, 0), a3, voffA);
            PG8_WAIT_V(8); PG8_WAIT_L(0); PG8_BAR; PG8_MMA(1, 0, At, B0); PG8_MMA(1, 1, At, B1); PG8_BAR; PG8_SCHED;
            } else {
            PG8_LDB(B0, 0, 0); PG8_SCHED; PG8_LDA(At, 0, 0); PG8_STAGE(PG8_SA(1, 1), a1 + hstep, voffA);
            PG8_WAIT_L(8); PG8_BAR; PG8_WAIT_L(0); PG8_MMA(0, 0, At, B0); PG8_BAR; PG8_SCHED;
            PG8_LDB(B1, 0, 1); PG8_STAGE(PG8_SB(0, 0), b2, voffB);
            PG8_BAR; PG8_WAIT_L(0); PG8_MMA(0, 1, At, B1); PG8_BAR;
            PG8_LDA(At, 0, 1); PG8_STAGE(PG8_SA(0, 0), a2, voffA);
            PG8_BAR; PG8_WAIT_L(0); PG8_MMA(1, 0, At, B0); PG8_BAR; PG8_SCHED;
            PG8_STAGE(PG8_SB(0, 1), b2 + hstep, voffB);
            PG8_WAIT_V(6); PG8_BAR; PG8_MMA(1, 1, At, B1); PG8_BAR;
            PG8_LDB(B0, 1, 0); PG8_SCHED; PG8_LDA(At, 1, 0); PG8_STAGE(PG8_SA(0, 1), a2 + hstep, voffA);
            PG8_WAIT_L(8); PG8_BAR; PG8_WAIT_L(0); PG8_MMA(0, 0, At, B0); PG8_BAR; PG8_SCHED;
            PG8_LDB(B1, 1, 1); PG8_STAGE(PG8_SB(1, 0), b3, voffB);
            PG8_BAR; PG8_WAIT_L(0); PG8_MMA(0, 1, At, B1); PG8_BAR;
            PG8_LDA(At, 1, 1); PG8_STAGE(PG8_SA(1, 0), a3, voffA);
            PG8_BAR; PG8_WAIT_L(0); PG8_MMA(1, 0, At, B0); PG8_BAR; PG8_SCHED;
            PG8_STAGE(PG8_SB(1, 1), b3 + hstep, voffB);
            PG8_WAIT_V(6); PG8_BAR; PG8_MMA(1, 1, At, B1); PG8_BAR;
            }
        }
        if constexpr (ALIGN_EPI) { if (wr == 0) PG8_BAR; }
        if constexpr (!Epi::AFTER_DRAIN) { E(acc, cur, wr, wc, fr, fq); S.done(cur); }
        if (!has_next) break;
#pragma unroll
        for (int a = 0; a < 2; ++a)
#pragma unroll
            for (int b = 0; b < 2; ++b)
#pragma unroll
                for (int m = 0; m < 4; ++m)
#pragma unroll
                    for (int n = 0; n < 2; ++n) acc[a][b][m][n] = (f32x4){0.f, 0.f, 0.f, 0.f};
        cur = nxt; cA = nA; cB = nB; ++ui;
        if constexpr (ALIGN_EPI) { if (wr == 1) PG8_BAR; }
    }
    PG8_WAIT_V(0);
    if constexpr (!ALIGN_EPI) { if (wr == 0) PG8_BAR; }
    PG8_BAR;
    if constexpr (Epi::AFTER_DRAIN) { E.fused(acc, cur, wr, wc, fr, fq, lds, wid, lane); S.done(cur); }
#undef PG8_SA
#undef PG8_SB
#undef PG8_STAGE
#undef PG8_LDA
#undef PG8_LDB
#undef PG8_MMA
#undef PG8_WAIT_V
#undef PG8_WAIT_L
#undef PG8_BAR
#undef PG8_SCHED
}
}
#define GAS __attribute__((address_space(1)))
#define LAS __attribute__((address_space(3)))
typedef unsigned short bf16;
typedef unsigned v4u __attribute__((ext_vector_type(4)));
typedef float f32x4 __attribute__((ext_vector_type(4)));
typedef short bf16x8 __attribute__((ext_vector_type(8)));
typedef GAS unsigned gu32;
typedef GAS unsigned long long gu64;
#define RLX_AGENT __ATOMIC_RELAXED, __HIP_MEMORY_SCOPE_AGENT
#define LDS_WAIT() asm volatile("s_waitcnt lgkmcnt(0)" ::: "memory")
#define VM_WAIT() asm volatile("s_waitcnt vmcnt(0)" ::: "memory")
__device__ __forceinline__ unsigned long long rt() { return __builtin_amdgcn_s_memrealtime(); }
__device__ __forceinline__ unsigned f2bf(float f) { unsigned u = __builtin_bit_cast(unsigned, f); return (u + 0x7fffu + ((u >> 16) & 1u)) >> 16; }
__device__ __forceinline__ unsigned pk2(float lo, float hi) { return f2bf(lo) | (f2bf(hi) << 16); }

#define XB_TMO      128
#define XB_XCNT(j)  (256  + 64 * (j))
#define XB_XSUB(j)  (1280 + 64 * (j))
#define XB_XGEN(j)  (2304 + 64 * (j))
#define XB_TOP      3328
#define XB_TOPGEN   3392
#define XCD_BAR_WORDS 3456
#define XB_SPIN_CAP (1u << 18)

__device__ __forceinline__ unsigned xb_ld(unsigned* p)              { return __hip_atomic_load(p, __ATOMIC_RELAXED, __HIP_MEMORY_SCOPE_AGENT); }
__device__ __forceinline__ unsigned xb_add(unsigned* p, unsigned v) { return __hip_atomic_fetch_add(p, v, __ATOMIC_RELAXED, __HIP_MEMORY_SCOPE_AGENT); }
__device__ __forceinline__ unsigned xb_xcc_id() { return (unsigned)__builtin_amdgcn_s_getreg((3 << 11) | 20) & 0xFu; }
#define XB_SPIN(cond, bar) do { unsigned _sp = 0; while (cond) { __builtin_amdgcn_s_sleep(1); \
    if ((++_sp & 255u) == 0u) { if (xb_ld(&(bar)[XB_TMO])) break; if (_sp > XB_SPIN_CAP) { atomicAdd(&(bar)[XB_TMO], 1u); break; } } } } while (0)

struct XcdBarrier {
    unsigned* bar; unsigned x;
    volatile LAS unsigned* st;
};

__device__ __forceinline__ XcdBarrier xcd_barrier_post(unsigned* bar, volatile LAS unsigned* st) {
    XcdBarrier b; b.bar = bar; b.x = xb_xcc_id(); b.st = st;
    if (threadIdx.x == 0) (void)xb_add(&bar[XB_XCNT(b.x)], 1u);
    return b;
}
__device__ __forceinline__ void xcd_barrier_complete(unsigned* bar, unsigned x, unsigned& nloc, unsigned& nx) {
    const unsigned G = gridDim.x * gridDim.y * gridDim.z;
    unsigned sum, cnt, mine, sp = 0u;
    for (;;) {
        sum = 0u; cnt = 0u; mine = 0u;
#pragma unroll
        for (unsigned j = 0; j < 16; ++j) { const unsigned c = xb_ld(&bar[XB_XCNT(j)]); sum += c; cnt += (c > 0u) ? 1u : 0u; mine = (j == x) ? c : mine; }
        if (sum == G) break;
        __builtin_amdgcn_s_sleep(1);
        if ((++sp & 255u) == 0u) { if (xb_ld(&bar[XB_TMO])) break; if (sp > XB_SPIN_CAP) { atomicAdd(&bar[XB_TMO], 1u); break; } }
    }
    nloc = mine > 0u ? mine : 1u; nx = cnt > 0u ? cnt : 1u;
}

__device__ __forceinline__ void xcd_barrier(const XcdBarrier& b) {
    asm volatile("s_waitcnt vmcnt(0)" ::: "memory");
    __syncthreads();
    if (threadIdx.x == 0) {
        unsigned* bar = b.bar;
        __builtin_amdgcn_s_waitcnt(0);
        unsigned nloc = b.st[0], nx = b.st[1];
        if (nloc == 0u) { xcd_barrier_complete(bar, b.x, nloc, nx); b.st[0] = nloc; b.st[1] = nx; }
        const unsigned old = xb_add(&bar[XB_XSUB(b.x)], 1u);
        const unsigned gen = old / nloc;
        if (old + 1u == (gen + 1u) * nloc) {
            __builtin_amdgcn_fence(__ATOMIC_RELEASE, "agent");
            asm volatile("s_waitcnt vmcnt(0)" ::: "memory");
            const unsigned og = xb_add(&bar[XB_TOP], 1u);
            const unsigned tg = og / nx;
            if (og + 1u == (tg + 1u) * nx) xb_add(&bar[XB_TOPGEN], 1u);
            else XB_SPIN(xb_ld(&bar[XB_TOPGEN]) == tg, bar);
            __builtin_amdgcn_fence(__ATOMIC_ACQUIRE, "agent");
            xb_add(&bar[XB_XGEN(b.x)], 1u);
            asm volatile("s_waitcnt vmcnt(0)" ::: "memory");
        } else {
            XB_SPIN(xb_ld(&bar[XB_XGEN(b.x)]) == gen, bar);
            __builtin_amdgcn_fence(__ATOMIC_ACQUIRE, "agent");
            asm volatile("s_waitcnt vmcnt(0)" ::: "memory");
        }
    }
    __syncthreads();
}
#define DI __device__ __forceinline__
typedef float f32x16 __attribute__((ext_vector_type(16)));
typedef float f32x2 __attribute__((ext_vector_type(2)));
typedef unsigned v2u __attribute__((ext_vector_type(2)));
typedef short s16x4 __attribute__((ext_vector_type(4)));
typedef __bf16 bf16x2_t __attribute__((ext_vector_type(2)));

constexpr int DM = 1024, SEQ = 8192, NBP = 2, MPR = NBP * SEQ  , NSMP = 32, MTOT = MPR + NSMP  , MP = 16640  ;
constexpr int PAST = 8192, NPAGES = 64, PAGE = 128;
constexpr int DFF = 2816, NUP = 2 * DFF  , PLE = 256;
constexpr int NPROJ = 7936;
constexpr int C_GQ = 0, C_GK = 512, C_GV = 1024, C_GR = 2048, C_NQ = 3072, C_KC = 4096, C_KS = 4608, C_KW = 5120, C_MG = 5632, C_MN = 6656, C_GA = 7680, C_NG = 7696;
constexpr int IN_COLS = 7744;
constexpr float EPS = 1e-6f;
constexpr float LOG2E = 1.4426950408889634f;
constexpr float QSCALE = 0.125f * LOG2E;
constexpr float GLA_QS = 0.08838834764831845f;
constexpr int NCHUNK = MPR / 64;
constexpr int CHK_S = 32 * 4 * 512  , CHK_P = 2 * 4 * 512  , CHK_ROWS = CHK_S + CHK_P  ;

constexpr size_t O_Y = 0, O_YS = 16777216, O_CMP_P = O_YS + 32768, O_CMP_S = O_CMP_P + 8388608, O_SLC_P = O_CMP_S + 16384, O_SLC_S = O_SLC_P + 8388608,
                 O_WIN_P = O_SLC_S + 16384, O_WIN_S = O_WIN_P + 524288, O_GLA_P = O_WIN_S + 16384, O_GLA_S = O_GLA_P + 262144, O_CONV_P = O_GLA_S + 4194304,
                 O_CONV_S = O_CONV_P + 11264, O_END = O_CONV_S + 180224;

constexpr size_t al256(size_t x) { return (x + 255) & ~(size_t)255; }
constexpr size_t WS_CTL = 0, CTL_BYTES = 1u << 20;
constexpr size_t WS_WIN_T = WS_CTL + CTL_BYTES;
constexpr size_t WS_WGO_T = WS_WIN_T + (size_t)NPROJ * DM * 2;
constexpr size_t WS_WNO_T = WS_WGO_T + (size_t)DM * DM * 2;
constexpr size_t WS_WOUT_T = WS_WNO_T + (size_t)DM * DM * 2;
constexpr size_t WS_WPG_T = WS_WOUT_T + (size_t)DM * DM * 2;
constexpr size_t WS_WUP_T = WS_WPG_T + (size_t)DM * DM * 2;
constexpr size_t WS_WDN_T = WS_WUP_T + (size_t)NUP * DM * 2;
constexpr size_t WS_WPP_T = WS_WDN_T + (size_t)DM * DFF * 2;
constexpr size_t WS_W1_T = WS_WPP_T + (size_t)DM * PLE * 2;
constexpr size_t WS_W2_T = WS_W1_T + (size_t)2 * 256 * 1024 * 2;
constexpr size_t WS_B1P = WS_W2_T + (size_t)2 * 64 * 128 * 2;
constexpr size_t WS_XN = al256(WS_B1P + 1024);
constexpr size_t WS_PB = WS_XN + (size_t)MP * DM * 2;
constexpr size_t WS_PROJ = WS_PB + (size_t)MP * PLE * 2;
constexpr size_t WS_PP = WS_PROJ + (size_t)MP * NPROJ * 2;
constexpr size_t WS_QT = WS_PP + (size_t)MP * DM * 2;
constexpr size_t WS_KT = WS_QT + (size_t)MPR * 512 * 2;
constexpr size_t WS_UT = WS_KT + (size_t)MPR * 512 * 2;
constexpr size_t WS_ST = WS_UT + (size_t)NCHUNK * 4 * 256 * 128 * 2;
constexpr size_t WS_DL = WS_ST + (size_t)NCHUNK * 4 * 256 * 128 * 2;
constexpr size_t WS_OG = WS_DL + (size_t)NCHUNK * 4 * 128 * 4;
constexpr size_t WS_CHK = WS_OG + (size_t)MP * DM * 2;
constexpr size_t WS_T = WS_CHK + (size_t)2 * CHK_ROWS * 1024 * 2;
constexpr size_t WS_KVC = WS_T + (size_t)2 * CHK_ROWS * 256 * 2 + 4096;
constexpr size_t WS_SEL = WS_KVC + (size_t)2 * CHK_ROWS * 64 * 2 + 4096;
constexpr size_t WS_OC = WS_SEL + (size_t)8 * SEQ * 4 * 4;
constexpr size_t WS_OW = WS_OC + (size_t)MP * DM * 2;
constexpr size_t WS_ONSA = WS_OW + (size_t)MP * DM * 2;
constexpr size_t WS_YG = WS_ONSA + (size_t)MP * DM * 2;
constexpr size_t WS_MIX = WS_YG + (size_t)MP * DM * 2;
constexpr size_t WS_T1 = WS_MIX + (size_t)MP * DM * 2;
constexpr size_t WS_X1 = WS_T1 + (size_t)MP * DM * 4;
constexpr size_t WS_X2 = WS_X1 + (size_t)MP * DM * 4;
constexpr size_t WS_UP = WS_X2 + (size_t)MP * DM * 4;
constexpr size_t WS_H = WS_UP + (size_t)MP * NUP * 2;
constexpr size_t WS_END = WS_H + (size_t)MP * DFF * 2;

constexpr int CW_BAR = 4096;
constexpr int LDS_BYTES = 147456;
constexpr int MISC_OFF = 131072 + 320;

DI float bf2f(unsigned short h) { return __uint_as_float((unsigned)h << 16); }
DI float bflo(unsigned u) { return __uint_as_float(u << 16); }
DI float bfhi(unsigned u) { return __uint_as_float(u & 0xffff0000u); }
DI unsigned cvtpk(float lo, float hi) { f32x2 v = {lo, hi}; bf16x2_t b = __builtin_convertvector(v, bf16x2_t); return __builtin_bit_cast(unsigned, b); }
DI float sigmoidf_(float x) { return 1.0f / (1.0f + __expf(-x)); }
DI float siluf_(float x) { return x / (1.0f + __expf(-x)); }
DI float gelu_tanh(float x) { const float u = 1.5957691216057308f * (x + 0.044715f * x * x * x); return x / (1.0f + __expf(-u)); }
DI float logsigf_(float x) { return fminf(x, 0.f) - log1pf(__expf(-fabsf(x))); }
DI float wave_sum(float v) {
#pragma unroll
    for (int o = 1; o < 64; o <<= 1) v += __shfl_xor(v, o);
    return v;
}
DI float wave_max(float v) {
#pragma unroll
    for (int o = 1; o < 64; o <<= 1) v = fmaxf(v, __shfl_xor(v, o));
    return v;
}
template <int CTRL> DI int dpp_i(int x) { return __builtin_amdgcn_update_dpp(0, x, CTRL, 0xf, 0xf, false); }
template <int CTRL> DI float dpp_f(float x) { return __int_as_float(__builtin_amdgcn_update_dpp(0, __float_as_int(x), CTRL, 0xf, 0xf, false)); }
DI float quad_sum(float x) { x += dpp_f<0xB1>(x); x += dpp_f<0x4E>(x); return x; }
DI int sum8_i(int x) { x += dpp_i<0xB1>(x); x += dpp_i<0x4E>(x); x += dpp_i<0x141>(x); return x; }
DI float sum16_f(float x) { x += dpp_f<0xB1>(x); x += dpp_f<0x4E>(x); x += dpp_f<0x141>(x); x += dpp_f<0x140>(x); return x; }

#define MFMA32(a, b, c) __builtin_amdgcn_mfma_f32_32x32x16_bf16((a), (b), (c), 0, 0, 0)
DI int crow(int r, int hi) { return (r & 3) + 8 * (r >> 2) + 4 * hi; }
typedef short v4i16_t __attribute__((ext_vector_type(4)));
DI s16x4 vtr(const LAS unsigned char* p) { return __builtin_bit_cast(s16x4, __builtin_amdgcn_ds_read_tr16_b64_v4i16((LAS v4i16_t*)p)); }
DI bf16x8 cat8(s16x4 lo, s16x4 hi) { return (bf16x8){lo[0], lo[1], lo[2], lo[3], hi[0], hi[1], hi[2], hi[3]}; }
DI bf16x8 tr_frag(const LAS unsigned char* T, int stride, int k0, int n0, int lane) {
    const int q = (lane & 15) >> 2, p = lane & 3, blk = (lane >> 4) & 1, hh = lane >> 5;
    const LAS unsigned char* a = T + (k0 + 8 * hh + q) * stride + (n0 + 16 * blk + 4 * p) * 2;
    return cat8(vtr(a), vtr(a + 4 * stride));
}
DI bf16x8 tr_frag_acc(const LAS unsigned char* T, int stride, int k0, int n0, int lane) {
    const int q = (lane & 15) >> 2, p = lane & 3, blk = (lane >> 4) & 1, hh = lane >> 5;
    const LAS unsigned char* a = T + (k0 + 4 * hh + q) * stride + (n0 + 16 * blk + 4 * p) * 2;
    return cat8(vtr(a), vtr(a + 8 * stride));
}
DI bf16x8 pack_acc(const f32x16& x, int s) {
    v4u p; p.x = cvtpk(x[8 * s + 0], x[8 * s + 1]); p.y = cvtpk(x[8 * s + 2], x[8 * s + 3]); p.z = cvtpk(x[8 * s + 4], x[8 * s + 5]); p.w = cvtpk(x[8 * s + 6], x[8 * s + 7]);
    return __builtin_bit_cast(bf16x8, p);
}

struct Ctx {
    LAS unsigned char* lds;
    int tid, lane, wave, G, bid;
    const float* in[33];
    float* out;
    unsigned char* ws;
};
#define WSP(T, off) ((T*)(C.ws + (off)))
namespace pg8 {
DI unsigned epk(float lo, float hi) { return ::cvtpk(lo, hi); }
DI u32x4 pack8(const f32x4& a, const f32x4& b) { u32x4 w; w.x = epk(a[0], a[1]); w.y = epk(a[2], a[3]); w.z = epk(b[0], b[1]); w.w = epk(b[2], b[3]); return w; }

struct EpiProj {
    static constexpr bool PERM = true, AFTER_DRAIN = false;
    bf16_t* P; float* out;
    DI void operator()(const f32x4 (&acc)[2][2][4][2], const Unit& u, int wr, int wc, int fr, int fq) const {
        const float sc = (u.pn >= 12 && u.pn < 16) ? QSCALE : 1.f;
        const bool kv = (u.pn >= 16 && u.pn < 22); const int which = (u.pn - 16) >> 1;
#pragma unroll
        for (int ai = 0; ai < 2; ++ai)
#pragma unroll
            for (int m = 0; m < 4; ++m) {
                const int row = u.pm * BM + ai * HALF + wr * 64 + m * 16 + fr;
#pragma unroll
                for (int bj = 0; bj < 2; ++bj) {
                    const int col = u.pn * BM + bj * HALF + wc * 32 + 8 * fq;
                    const f32x4 v0 = acc[ai][bj][m][0], v1 = acc[ai][bj][m][1];
                    *(u32x4*)(P + (size_t)row * NPROJ + col) = pack8(v0 * sc, v1 * sc);
                    if (kv) {
                        const int c512 = col - (C_KC + which * 512); float* dst = nullptr;
                        if (row < MPR) {
                            if (which == 0) dst = out + O_CMP_P + (size_t)row * 512 + c512;
                            else if (which == 1) dst = out + O_SLC_P + (size_t)row * 512 + c512;
                            else { const int t = row & (SEQ - 1); if (t >= SEQ - 512) dst = out + O_WIN_P + ((size_t)((row >> 13) * 512 + (t - (SEQ - 512)))) * 512 + c512; }
                        } else if (row < MTOT) {
                            dst = out + (which == 0 ? O_CMP_S : which == 1 ? O_SLC_S : O_WIN_S) + (size_t)(row - MPR) * 512 + c512;
                        }
                        if (dst) { *(f32x4*)dst = v0; *(f32x4*)(dst + 4) = v1; }
                    }
                }
            }
    }
};
template <bool UPCONV> struct EpiStore {
    static constexpr bool PERM = true, AFTER_DRAIN = false;
    bf16_t* O; int ldc; float* out;
    DI void e4(int row, int col, const f32x4& v) const { v2u w; w.x = epk(v[0], v[1]); w.y = epk(v[2], v[3]); *(v2u*)(O + (size_t)row * ldc + col) = w; }
    DI void operator()(const f32x4 (&acc)[2][2][4][2], const Unit& u, int wr, int wc, int fr, int fq) const {
#pragma unroll
        for (int ai = 0; ai < 2; ++ai)
#pragma unroll
            for (int m = 0; m < 4; ++m) {
                const int row = u.pm * BM + ai * HALF + wr * 64 + m * 16 + fr;
#pragma unroll
                for (int bj = 0; bj < 2; ++bj) {
                    const int col = u.pn * BM + bj * HALF + wc * 32 + 8 * fq;
                    const f32x4 v0 = acc[ai][bj][m][0], v1 = acc[ai][bj][m][1];
                    *(u32x4*)(O + (size_t)row * ldc + col) = pack8(v0, v1);
                    if (UPCONV) {
                        if (col < DFF) {
                            float* dst = nullptr; const int t = row & (SEQ - 1);
                            if (row < MPR) { if (t >= SEQ - 2) dst = out + O_CONV_P + ((size_t)((row >> 13) * 2 + (t - (SEQ - 2)))) * DFF + col; }
                            else if (row < MTOT) dst = out + O_CONV_S + ((size_t)((row - MPR) * 2 + 1)) * DFF + col;
                            if (dst) { *(f32x4*)dst = v0; *(f32x4*)(dst + 4) = v1; }
                        }
                    }
                }
            }
    }
};
struct EpiMix {
    static constexpr bool PERM = true, AFTER_DRAIN = false;
    const bf16_t* P; const bf16_t* YG; bf16_t* MIX;
    DI void e4(int row, int col, const f32x4& v) const {
        const v2u yg = *(const v2u*)(YG + (size_t)row * DM + col), mg = *(const v2u*)(P + (size_t)row * NPROJ + C_MG + col), mn = *(const v2u*)(P + (size_t)row * NPROJ + C_MN + col);
        const float r0 = sigmoidf_(bflo(mg[0])) * bflo(yg[0]) + sigmoidf_(bflo(mn[0])) * v[0], r1 = sigmoidf_(bfhi(mg[0])) * bfhi(yg[0]) + sigmoidf_(bfhi(mn[0])) * v[1];
        const float r2 = sigmoidf_(bflo(mg[1])) * bflo(yg[1]) + sigmoidf_(bflo(mn[1])) * v[2], r3 = sigmoidf_(bfhi(mg[1])) * bfhi(yg[1]) + sigmoidf_(bfhi(mn[1])) * v[3];
        v2u w; w.x = epk(r0, r1); w.y = epk(r2, r3); *(v2u*)(MIX + (size_t)row * DM + col) = w;
    }
    DI void operator()(const f32x4 (&acc)[2][2][4][2], const Unit& u, int wr, int wc, int fr, int fq) const {
#pragma unroll
        for (int ai = 0; ai < 2; ++ai)
#pragma unroll
            for (int m = 0; m < 4; ++m) {
                const int row = u.pm * BM + ai * HALF + wr * 64 + m * 16 + fr;
#pragma unroll
                for (int bj = 0; bj < 2; ++bj) {
                    const int col = u.pn * BM + bj * HALF + wc * 32 + 8 * fq;
                    const f32x4 v0 = acc[ai][bj][m][0], v1 = acc[ai][bj][m][1];
                    const u32x4 yg = *(const u32x4*)(YG + (size_t)row * DM + col);
                    const u32x4 mg = *(const u32x4*)(P + (size_t)row * NPROJ + C_MG + col);
                    const u32x4 mn = *(const u32x4*)(P + (size_t)row * NPROJ + C_MN + col);
                    float r[8];
#pragma unroll
                    for (int e = 0; e < 4; ++e) {
                        const float a0 = e < 2 ? v0[2 * e] : v1[2 * e - 4], a1 = e < 2 ? v0[2 * e + 1] : v1[2 * e - 3];
                        r[2 * e] = sigmoidf_(bflo(mg[e])) * bflo(yg[e]) + sigmoidf_(bflo(mn[e])) * a0;
                        r[2 * e + 1] = sigmoidf_(bfhi(mg[e])) * bfhi(yg[e]) + sigmoidf_(bfhi(mn[e])) * a1;
                    }
                    u32x4 w; w.x = epk(r[0], r[1]); w.y = epk(r[2], r[3]); w.z = epk(r[4], r[5]); w.w = epk(r[6], r[7]);
                    *(u32x4*)(MIX + (size_t)row * DM + col) = w;
                }
            }
    }
};
struct EpiF32 {
    static constexpr bool PERM = false, AFTER_DRAIN = false;
    float* O; int ldc;
    DI void e4(int row, int col, const f32x4& v) const { *(f32x4*)(O + (size_t)row * ldc + col) = v; }
    DI void operator()(const f32x4 (&acc)[2][2][4][2], const Unit& u, int wr, int wc, int fr, int fq) const {
#pragma unroll
        for (int ai = 0; ai < 2; ++ai)
#pragma unroll
            for (int m = 0; m < 4; ++m) {
                const int row = u.pm * BM + ai * HALF + wr * 64 + m * 16 + fr;
#pragma unroll
                for (int bj = 0; bj < 2; ++bj)
#pragma unroll
                    for (int n = 0; n < 2; ++n) { const int col = u.pn * BM + bj * HALF + wc * 32 + 16 * n + 4 * fq; *(f32x4*)(O + (size_t)row * ldc + col) = acc[ai][bj][m][n]; }
            }
    }
};
struct EpiFinal {
    static constexpr bool PERM = false, AFTER_DRAIN = false;
    const float* X2; const bf16_t* PP; float* out;
    DI void e4(int row, int col, const f32x4& a) const {
        float* orow = row < MPR ? out + O_Y + (size_t)row * DM : out + O_YS + (size_t)(row - MPR) * DM;
        const f32x4 x = *(const f32x4*)(X2 + (size_t)row * DM + col); const v2u pp = *(const v2u*)(PP + (size_t)row * DM + col);
        f32x4 y; y[0] = x[0] + sigmoidf_(a[0]) * bflo(pp[0]); y[1] = x[1] + sigmoidf_(a[1]) * bfhi(pp[0]); y[2] = x[2] + sigmoidf_(a[2]) * bflo(pp[1]); y[3] = x[3] + sigmoidf_(a[3]) * bfhi(pp[1]);
        *(f32x4*)(orow + col) = y;
    }
    DI void operator()(const f32x4 (&acc)[2][2][4][2], const Unit& u, int wr, int wc, int fr, int fq) const {
#pragma unroll
        for (int ai = 0; ai < 2; ++ai)
#pragma unroll
            for (int m = 0; m < 4; ++m) {
                const int row = u.pm * BM + ai * HALF + wr * 64 + m * 16 + fr;
                if (row < MTOT) {
                    float* orow = row < MPR ? out + O_Y + (size_t)row * DM : out + O_YS + (size_t)(row - MPR) * DM;
#pragma unroll
                    for (int bj = 0; bj < 2; ++bj)
#pragma unroll
                        for (int n = 0; n < 2; ++n) {
                            const int col = u.pn * BM + bj * HALF + wc * 32 + 16 * n + 4 * fq; const f32x4 a = acc[ai][bj][m][n];
                            const f32x4 x = *(const f32x4*)(X2 + (size_t)row * DM + col); const v2u pp = *(const v2u*)(PP + (size_t)row * DM + col);
                            f32x4 y; y[0] = x[0] + sigmoidf_(a[0]) * bflo(pp[0]); y[1] = x[1] + sigmoidf_(a[1]) * bfhi(pp[0]); y[2] = x[2] + sigmoidf_(a[2]) * bflo(pp[1]); y[3] = x[3] + sigmoidf_(a[3]) * bfhi(pp[1]);
                            *(f32x4*)(orow + col) = y;
                        }
                }
            }
    }
};
}
struct ColIdent { DI int operator()(int n) const { return n; } };
struct ColWin {
    DI int operator()(int n) const {
        if (n < 3072) return n;
        if (n < 4096) return 3088 + (n - 3072);
        if (n < 5632) return 4112 + (n - 4096);
        if (n < 7680) return 5696 + (n - 5632);
        if (n < 7696) return 3072 + (n - 7680);
        if (n < 7744) return 5648 + (n - 7696);
        return -1;
    }
};
template <class F> DI void tr_item(const float* W, int Nsrc, bf16* WT, int Kpitch, int k0, int n0, LAS float* scr, int lane, F srccol) {
    const int ns = srccol(n0 + (lane & 31));
#pragma unroll 8
    for (int i = 0; i < 32; ++i) { const int kk = 2 * i + (lane >> 5); scr[kk * 33 + (lane & 31)] = ns >= 0 ? W[(size_t)(k0 + kk) * Nsrc + ns] : 0.f; }
    LDS_WAIT(); asm volatile("" ::: "memory");
    const int c = lane & 7;
#pragma unroll
    for (int j = 0; j < 4; ++j) { const int n = (lane >> 3) + 8 * j; const LAS float* s = scr + (8 * c) * 33 + n;
        v4u o; o.x = cvtpk(s[0 * 33], s[1 * 33]); o.y = cvtpk(s[2 * 33], s[3 * 33]); o.z = cvtpk(s[4 * 33], s[5 * 33]); o.w = cvtpk(s[6 * 33], s[7 * 33]);
        *(v4u*)(WT + (size_t)(n0 + n) * Kpitch + k0 + 8 * c) = o; }
    LDS_WAIT(); asm volatile("" ::: "memory");
}
template <class F> DI void tr_matrix(const Ctx& C, const float* W, int K, int Nsrc, int Ndst, bf16* WT, int Kpitch, F f, int& base) {
    LAS float* scr = (LAS float*)(C.lds + C.wave * 16384);
    const int gw = C.bid * 8 + C.wave, NGW = C.G * 8, nb = Ndst / 32, items = (K / 64) * nb;
    int first = gw - (base % NGW); if (first < 0) first += NGW;
    for (int it = first; it < items; it += NGW) tr_item(W, Nsrc, WT, Kpitch, 64 * (it / nb), 32 * (it % nb), scr, C.lane, f);
    base += items;
}
DI void rms_row_bf16(const float* xrow, const float* g, bf16* orow, int lane) {
    const f32x4* xr = (const f32x4*)xrow + lane; const f32x4* gr = (const f32x4*)g + lane;
    f32x4 v[4]; float s = 0.f;
#pragma unroll
    for (int j = 0; j < 4; ++j) { v[j] = xr[64 * j]; s += (v[j][0] * v[j][0] + v[j][1] * v[j][1]) + (v[j][2] * v[j][2] + v[j][3] * v[j][3]); }
    const float rstd = rsqrtf(wave_sum(s) * (1.f / DM) + EPS);
#pragma unroll
    for (int j = 0; j < 4; ++j) { const f32x4 gg = gr[64 * j]; v2u o; o.x = cvtpk(v[j][0] * rstd * gg[0], v[j][1] * rstd * gg[1]); o.y = cvtpk(v[j][2] * rstd * gg[2], v[j][3] * rstd * gg[3]);
        *((v2u*)orow + lane + 64 * j) = o; }
}
DI void phase_prologue(const Ctx& C) {
    const int gw = C.bid * 8 + C.wave, NGW = C.G * 8, lane = C.lane;
    int base = 0;
    tr_matrix(C, C.in[15], DM, IN_COLS, NPROJ, WSP(bf16, WS_WIN_T), DM, ColWin(), base);
    tr_matrix(C, C.in[19], DM, DM, DM, WSP(bf16, WS_WGO_T), DM, ColIdent(), base);
    tr_matrix(C, C.in[25], DM, DM, DM, WSP(bf16, WS_WNO_T), DM, ColIdent(), base);
    tr_matrix(C, C.in[26], DM, DM, DM, WSP(bf16, WS_WOUT_T), DM, ColIdent(), base);
    tr_matrix(C, C.in[32], DM, DM, DM, WSP(bf16, WS_WPG_T), DM, ColIdent(), base);
    tr_matrix(C, C.in[27], DM, NUP, NUP, WSP(bf16, WS_WUP_T), DM, ColIdent(), base);
    tr_matrix(C, C.in[30], DFF, DM, DM, WSP(bf16, WS_WDN_T), DFF, ColIdent(), base);
    tr_matrix(C, C.in[31], PLE, DM, DM, WSP(bf16, WS_WPP_T), PLE, ColIdent(), base);
#pragma unroll
    for (int c = 0; c < 2; ++c)
#pragma unroll
        for (int hh = 0; hh < 2; ++hh)
            tr_matrix(C, C.in[20] + (size_t)(c * 2048 + hh * 1024) * 128, 1024, 128, 128, WSP(bf16, WS_W1_T) + (size_t)(c * 256 + hh * 128) * 1024, 1024, ColIdent(), base);
#pragma unroll
    for (int c = 0; c < 2; ++c) tr_matrix(C, C.in[22] + (size_t)c * 128 * 64, 128, 64, 64, WSP(bf16, WS_W2_T) + (size_t)c * 64 * 128, 128, ColIdent(), base);
    if (gw < 256) {
        const int c = gw >> 7, h = gw & 127; const float* w1 = C.in[20] + (size_t)c * 2048 * 128; const float* pe = C.in[24];
        float s = 0.f;
        for (int k = lane; k < 2048; k += 64) { const int pos = k >> 6, d = k & 63; s += pe[(pos * 2 + c) * 64 + d] * w1[(size_t)k * 128 + h]; }
        s = wave_sum(s);
        if (lane == 0) WSP(float, WS_B1P)[gw] = s + C.in[21][gw];
    }
    bf16* XN = WSP(bf16, WS_XN); bf16* PB = WSP(bf16, WS_PB);
    for (int m = gw; m < MP; m += NGW) {
        if (m < MTOT) {
            const float* xr = m < MPR ? C.in[0] + (size_t)m * DM : C.in[1] + (size_t)(m - MPR) * DM;
            rms_row_bf16(xr, C.in[10], XN + (size_t)m * DM, lane);
            const float* pr = m < MPR ? C.in[8] + (size_t)m * PLE : C.in[9] + (size_t)(m - MPR) * PLE;
            const f32x4 pv = *((const f32x4*)pr + lane); v2u o; o.x = cvtpk(pv[0], pv[1]); o.y = cvtpk(pv[2], pv[3]); *((v2u*)(PB + (size_t)m * PLE) + lane) = o;
        } else {
#pragma unroll
            for (int j = 0; j < 4; ++j) *((v2u*)(XN + (size_t)m * DM) + lane + 64 * j) = (v2u){0u, 0u};
            *((v2u*)(PB + (size_t)m * PLE) + lane) = (v2u){0u, 0u};
        }
    }
    for (int i = C.bid * 512 + C.tid; i < NSMP * DFF; i += C.G * 512) { const int b = i / DFF, c = i - b * DFF; C.out[O_CONV_S + (size_t)(b * 2) * DFF + c] = C.in[6][(size_t)(b * 2 + 1) * DFF + c]; }
}

DI void phase_chk_prompt(const Ctx& C) {
    const int gw = C.bid * 8 + C.wave, NGW = C.G * 8, lane = C.lane;
    const bf16* P = WSP(bf16, WS_PROJ); bf16* CHK = WSP(bf16, WS_CHK);
    const int tk = lane >> 4, ch = lane & 15, c = ch >> 3, d8 = (ch & 7) * 8;
    for (int r = gw; r < CHK_P; r += NGW) {
        const int b = r >> 11, g = (r >> 9) & 3, j = r & 511;
        const bf16* src = P + (size_t)(b * SEQ + 16 * j) * NPROJ + C_KC + g * 128 + ch * 8;
        bf16* dst = CHK + ((size_t)c * CHK_ROWS + CHK_S + r) * 1024 + d8;
#pragma unroll
        for (int i = 0; i < 4; ++i) { const int pos = 4 * i + tk; *(v4u*)(dst + pos * 64) = *(const v4u*)(src + (size_t)pos * NPROJ); }
    }
}

DI void phase_rownorm(const Ctx& C, const float* T, const float* xin_p, const float* xin_s, const float* g_post, const float* g_pre, float* xout, bf16* XN) {
    const int gw = C.bid * 8 + C.wave, NGW = C.G * 8, lane = C.lane;
    for (int m = gw; m < MTOT; m += NGW) {
        const f32x4* tr = (const f32x4*)(T + (size_t)m * DM) + lane;
        const f32x4* xr = (const f32x4*)(m < MPR ? xin_p + (size_t)m * DM : xin_s + (size_t)(m - MPR) * DM) + lane;
        f32x4 t[4], x[4]; float s = 0.f;
#pragma unroll
        for (int j = 0; j < 4; ++j) { t[j] = tr[64 * j]; x[j] = xr[64 * j]; s += (t[j][0] * t[j][0] + t[j][1] * t[j][1]) + (t[j][2] * t[j][2] + t[j][3] * t[j][3]); }
        const float r1 = rsqrtf(wave_sum(s) * (1.f / DM) + EPS); float s2 = 0.f;
#pragma unroll
        for (int j = 0; j < 4; ++j) { const f32x4 gp = *((const f32x4*)g_post + lane + 64 * j); x[j] = x[j] + t[j] * r1 * gp;
            s2 += (x[j][0] * x[j][0] + x[j][1] * x[j][1]) + (x[j][2] * x[j][2] + x[j][3] * x[j][3]); *((f32x4*)(xout + (size_t)m * DM) + lane + 64 * j) = x[j]; }
        const float r2 = rsqrtf(wave_sum(s2) * (1.f / DM) + EPS);
#pragma unroll
        for (int j = 0; j < 4; ++j) { const f32x4 gg = *((const f32x4*)g_pre + lane + 64 * j); v2u o; o.x = cvtpk(x[j][0] * r2 * gg[0], x[j][1] * r2 * gg[1]); o.y = cvtpk(x[j][2] * r2 * gg[2], x[j][3] * r2 * gg[3]);
            *((v2u*)(XN + (size_t)m * DM) + lane + 64 * j) = o; }
    }
}

DI void phase_conv(const Ctx& C) {
    const bf16* UP = WSP(bf16, WS_UP); bf16* H = WSP(bf16, WS_H);
    const float* cw = C.in[28]; const float* cb = C.in[29]; const float* st = C.in[6];
    constexpr int NV = DFF / 8;
    const int total = MTOT * NV;
    for (int i = C.bid * 512 + C.tid; i < total; i += C.G * 512) {
        const int row = i / NV, cv = (i - row * NV) * 8;
        const v4u a0 = *(const v4u*)(UP + (size_t)row * NUP + cv), gt = *(const v4u*)(UP + (size_t)row * NUP + DFF + cv);
        float am1[8], am2[8];
        if (row < MPR) {
            const int t = row & (SEQ - 1);
            v4u x1 = (v4u){0u, 0u, 0u, 0u}, x2 = x1;
            if (t >= 1) x1 = *(const v4u*)(UP + (size_t)(row - 1) * NUP + cv);
            if (t >= 2) x2 = *(const v4u*)(UP + (size_t)(row - 2) * NUP + cv);
#pragma unroll
            for (int e = 0; e < 4; ++e) { am1[2 * e] = bflo(x1[e]); am1[2 * e + 1] = bfhi(x1[e]); am2[2 * e] = bflo(x2[e]); am2[2 * e + 1] = bfhi(x2[e]); }
        } else {
            const int b = row - MPR;
#pragma unroll
            for (int e = 0; e < 8; ++e) { am2[e] = st[(size_t)(b * 2 + 0) * DFF + cv + e]; am1[e] = st[(size_t)(b * 2 + 1) * DFF + cv + e]; }
        }
        float r[8];
#pragma unroll
        for (int e = 0; e < 8; ++e) {
            const float a = (e & 1) ? bfhi(a0[e >> 1]) : bflo(a0[e >> 1]), g = (e & 1) ? bfhi(gt[e >> 1]) : bflo(gt[e >> 1]);
            const float cval = am2[e] * cw[cv + e] + am1[e] * cw[DFF + cv + e] + a * cw[2 * DFF + cv + e] + cb[cv + e];
            r[e] = gelu_tanh(cval) * g;
        }
        v4u o; o.x = cvtpk(r[0], r[1]); o.y = cvtpk(r[2], r[3]); o.z = cvtpk(r[4], r[5]); o.w = cvtpk(r[6], r[7]);
        *(v4u*)(H + (size_t)row * DFF + cv) = o;
    }
}

DI void phase_kvc(const Ctx& C) {
    const int gw = C.bid * 8 + C.wave, NGW = C.G * 8, lane = C.lane, r32 = lane & 31, hh = lane >> 5;
    const bf16* T = WSP(bf16, WS_T); bf16* KVC = WSP(bf16, WS_KVC); const bf16* W2T = WSP(bf16, WS_W2_T); const float* B1P = WSP(float, WS_B1P);
    constexpr int NT = CHK_ROWS / 32;
    for (int task = gw; task < 2 * NT; task += NGW) {
        const int c = task / NT, R0 = (task - c * NT) * 32;
        const bf16* Tc = T + (size_t)c * CHK_ROWS * 256; const bf16* w2 = W2T + (size_t)c * 64 * 128;
        f32x16 acc0 = {}, acc1 = {};
        const bf16* trow = Tc + (size_t)(R0 + r32) * 256;
#pragma unroll
        for (int s = 0; s < 8; ++s) {
            const int k0 = 16 * s + 8 * hh;
            const v4u ta = *(const v4u*)(trow + k0), tb = *(const v4u*)(trow + 256 + 128 + k0);
            const f32x4 b0 = *(const f32x4*)(B1P + c * 128 + k0), b1 = *(const f32x4*)(B1P + c * 128 + k0 + 4);
            float hv[8];
#pragma unroll
            for (int e = 0; e < 4; ++e) { hv[2 * e] = bflo(ta[e]) + bflo(tb[e]); hv[2 * e + 1] = bfhi(ta[e]) + bfhi(tb[e]); }
#pragma unroll
            for (int e = 0; e < 8; ++e) hv[e] = gelu_tanh(hv[e] + (e < 4 ? b0[e] : b1[e - 4]));
            v4u ap; ap.x = cvtpk(hv[0], hv[1]); ap.y = cvtpk(hv[2], hv[3]); ap.z = cvtpk(hv[4], hv[5]); ap.w = cvtpk(hv[6], hv[7]);
            const bf16x8 af = __builtin_bit_cast(bf16x8, ap);
            const bf16x8 bw0 = *(const bf16x8*)(w2 + (size_t)r32 * 128 + k0), bw1 = *(const bf16x8*)(w2 + (size_t)(32 + r32) * 128 + k0);
            acc0 = MFMA32(af, bw0, acc0); acc1 = MFMA32(af, bw1, acc1);
        }
        const float bb0 = C.in[23][c * 64 + r32], bb1 = C.in[23][c * 64 + 32 + r32];
        bf16* orow = KVC + ((size_t)c * CHK_ROWS + R0) * 64;
#pragma unroll
        for (int r = 0; r < 16; ++r) { const int row = crow(r, hh);
            orow[(size_t)row * 64 + r32] = (bf16)(cvtpk(acc0[r] + bb0, 0.f) & 0xffffu); orow[(size_t)row * 64 + 32 + r32] = (bf16)(cvtpk(acc1[r] + bb1, 0.f) & 0xffffu); }
    }
}
constexpr int G_KHS = 272, G_VS = 528;
DI void load_v_tile(const Ctx& C, const bf16* P, int r0, int h, LAS unsigned char* VV) {
#pragma unroll
    for (int i = 0; i < 4; ++i) { const int idx = C.tid + 512 * i, row = idx >> 5, ch = idx & 31;
        *(LAS v4u*)(VV + row * G_VS + ch * 16) = *(const v4u*)(P + (size_t)(r0 + row) * NPROJ + C_GV + h * 256 + ch * 8); }
}
DI void phase_g1(const Ctx& C) {
    const bf16* P = WSP(bf16, WS_PROJ); bf16* QT = WSP(bf16, WS_QT); bf16* KT = WSP(bf16, WS_KT); bf16* UT = WSP(bf16, WS_UT); float* DL = WSP(float, WS_DL);
    const float* wup = C.in[16]; const float* bgate = C.in[17];
    LAS float* LA = (LAS float*)C.lds;
    LAS float* GA = (LAS float*)(C.lds + 32768);
    LAS float* WU = (LAS float*)(C.lds + 36864);
    LAS unsigned char* KH = C.lds + 45056;
    LAS unsigned char* VV = C.lds + 62464;
    const int tid = C.tid, lane = C.lane, w = C.wave;
    for (int unit = C.bid; unit < NCHUNK * 4; unit += C.G) {
        const int ci = unit >> 2, h = unit & 3, r0 = 64 * ci;
        { const int t = tid >> 3, pr = tid & 7; const unsigned g2 = *(const unsigned*)(P + (size_t)(r0 + t) * NPROJ + C_GA + 2 * pr); GA[t * 16 + 2 * pr] = bflo(g2); GA[t * 16 + 2 * pr + 1] = bfhi(g2);
          const int idx = tid * 4, r = idx >> 7, dk = idx & 127; *(LAS f32x4*)(WU + idx) = *(const f32x4*)(wup + (size_t)r * 512 + h * 128 + dk); }
        load_v_tile(C, P, r0, h, VV);
        __syncthreads();
        { const int dk = tid & 127, tq = tid >> 7; float wc[16];
#pragma unroll
          for (int r = 0; r < 16; ++r) wc[r] = WU[r * 128 + dk];
          const float bias = bgate[h * 128 + dk];
          for (int i = 0; i < 16; ++i) { const int t = tq * 16 + i; float x = bias;
#pragma unroll
              for (int r = 0; r < 16; ++r) x += GA[t * 16 + r] * wc[r];
              LA[t * 128 + dk] = logsigf_(x) * (1.0f / 16.0f); } }
        __syncthreads();
        if (tid < 128) { float run = 0.f; for (int t = 0; t < 64; ++t) { run += LA[t * 128 + tid]; LA[t * 128 + tid] = run; } }
        __syncthreads();
        { const int t = tid >> 3, dk0 = (tid & 7) * 16; const size_t prow = (size_t)(r0 + t) * NPROJ;
#pragma unroll
          for (int hf = 0; hf < 2; ++hf) {
              const int dk = dk0 + 8 * hf;
              const v4u qv = *(const v4u*)(P + prow + C_GQ + h * 128 + dk), kv = *(const v4u*)(P + prow + C_GK + h * 128 + dk);
              float qo[8], ko[8], kh[8];
#pragma unroll
              for (int e = 0; e < 8; ++e) {
                  const float q = (e & 1) ? bfhi(qv[e >> 1]) : bflo(qv[e >> 1]), k = (e & 1) ? bfhi(kv[e >> 1]) : bflo(kv[e >> 1]);
                  const float b = LA[t * 128 + dk + e], bl = LA[63 * 128 + dk + e];
                  qo[e] = q * GLA_QS * __expf(b); ko[e] = k * __expf(-b); kh[e] = k * __expf(bl - b);
              }
              v4u o; o.x = cvtpk(qo[0], qo[1]); o.y = cvtpk(qo[2], qo[3]); o.z = cvtpk(qo[4], qo[5]); o.w = cvtpk(qo[6], qo[7]);
              *(v4u*)(QT + (size_t)(r0 + t) * 512 + h * 128 + dk) = o;
              o.x = cvtpk(ko[0], ko[1]); o.y = cvtpk(ko[2], ko[3]); o.z = cvtpk(ko[4], ko[5]); o.w = cvtpk(ko[6], ko[7]);
              *(v4u*)(KT + (size_t)(r0 + t) * 512 + h * 128 + dk) = o;
              o.x = cvtpk(kh[0], kh[1]); o.y = cvtpk(kh[2], kh[3]); o.z = cvtpk(kh[4], kh[5]); o.w = cvtpk(kh[6], kh[7]);
              *(LAS v4u*)(KH + t * G_KHS + dk * 2) = o;
          }
          if (tid < 128) DL[(size_t)unit * 128 + tid] = __expf(LA[63 * 128 + tid]); }
        __syncthreads();
        {
            f32x16 acc[4] = {};
#pragma unroll
            for (int s = 0; s < 4; ++s) {
                const bf16x8 af = tr_frag(VV, G_VS, 16 * s, 32 * w, lane);
#pragma unroll
                for (int nt = 0; nt < 4; ++nt) { const bf16x8 bf_ = tr_frag(KH, G_KHS, 16 * s, 32 * nt, lane); acc[nt] = MFMA32(af, bf_, acc[nt]); }
            }
            bf16* ub = UT + ((size_t)unit * 256 + 32 * w) * 128;
            const int r32 = lane & 31, hh = lane >> 5;
#pragma unroll
            for (int nt = 0; nt < 4; ++nt)
#pragma unroll
                for (int r = 0; r < 16; ++r) ub[(size_t)crow(r, hh) * 128 + 32 * nt + r32] = (bf16)(cvtpk(acc[nt][r], 0.f) & 0xffffu);
        }
        __syncthreads();
    }
}
DI void phase_g2(const Ctx& C) {
    const bf16* __restrict__ UT = WSP(bf16, WS_UT); bf16* __restrict__ ST = WSP(bf16, WS_ST); const float* __restrict__ DL = WSP(float, WS_DL);
    for (int gid = C.bid * 512 + C.tid; gid < 8 * 256 * 64; gid += C.G * 512) {
        const int bh = gid >> 14, rem = gid & 16383, dv = rem >> 6, dk = (rem & 63) * 2, b = bh >> 2, h = bh & 3;
        float s0 = 0.f, s1 = 0.f;
#pragma unroll 8
        for (int c = 0; c < 128; ++c) {
            const size_t un = (size_t)((b * 128 + c) * 4 + h); const size_t idx = (un * 256 + dv) * 128 + dk;
            const unsigned u = *(const unsigned*)(UT + idx); const f32x2 d = *(const f32x2*)(DL + un * 128 + dk);
            *(unsigned*)(ST + idx) = cvtpk(s0, s1);
            s0 = d[0] * s0 + bflo(u); s1 = d[1] * s1 + bfhi(u);
        }
        float* o = C.out + O_GLA_P + ((size_t)(bh * 128 + dk)) * 256 + dv; o[0] = s0; o[256] = s1;
    }
}
DI void phase_g3(const Ctx& C) {
    const bf16* P = WSP(bf16, WS_PROJ); const bf16* QT = WSP(bf16, WS_QT); const bf16* KT = WSP(bf16, WS_KT); const bf16* ST = WSP(bf16, WS_ST); bf16* OG = WSP(bf16, WS_OG);
    const float* gnorm = C.in[18];
    LAS unsigned char* VV = C.lds; LAS float* RED = (LAS float*)(C.lds + 34816);
    const int lane = C.lane, w = C.wave, r32 = lane & 31, hh = lane >> 5;
    for (int unit = C.bid; unit < NCHUNK * 4; unit += C.G) {
        const int ci = unit >> 2, h = unit & 3, r0 = 64 * ci, dv0 = 32 * w;
        load_v_tile(C, P, r0, h, VV);
        __syncthreads();
        f32x16 o[2];
#pragma unroll
        for (int ti = 0; ti < 2; ++ti) {
            const int tt = 32 * ti + r32;
            bf16x8 qf[8];
#pragma unroll
            for (int s = 0; s < 8; ++s) qf[s] = *(const bf16x8*)(QT + (size_t)(r0 + tt) * 512 + h * 128 + 16 * s + 8 * hh);
            f32x16 acc = {};
            const bf16* srow = ST + ((size_t)unit * 256 + dv0 + r32) * 128 + 8 * hh;
#pragma unroll
            for (int s = 0; s < 8; ++s) { const bf16x8 af = *(const bf16x8*)(srow + 16 * s); acc = MFMA32(af, qf[s], acc); }
#pragma unroll
            for (int si = 0; si <= ti; ++si) {
                f32x16 X = {};
                const bf16* krow = KT + (size_t)(r0 + 32 * si + r32) * 512 + h * 128 + 8 * hh;
#pragma unroll
                for (int s = 0; s < 8; ++s) { const bf16x8 kf = *(const bf16x8*)(krow + 16 * s); X = MFMA32(kf, qf[s], X); }
                if (si == ti) {
#pragma unroll
                    for (int r = 0; r < 16; ++r) if (crow(r, hh) > r32) X[r] = 0.f;
                }
#pragma unroll
                for (int s2 = 0; s2 < 2; ++s2) { const bf16x8 pb = pack_acc(X, s2); const bf16x8 af = tr_frag_acc(VV, G_VS, 32 * si + 16 * s2, dv0, lane); acc = MFMA32(af, pb, acc); }
            }
            o[ti] = acc;
        }
#pragma unroll
        for (int ti = 0; ti < 2; ++ti) { float ss = 0.f;
#pragma unroll
            for (int r = 0; r < 16; ++r) ss += o[ti][r] * o[ti][r];
            ss += __shfl_xor(ss, 32); if (hh == 0) RED[w * 64 + 32 * ti + r32] = ss; }
        __syncthreads();
#pragma unroll
        for (int ti = 0; ti < 2; ++ti) {
            const int tt = 32 * ti + r32; float tot = 0.f;
#pragma unroll
            for (int ww = 0; ww < 8; ++ww) tot += RED[ww * 64 + tt];
            const float rstd = rsqrtf(tot * (1.f / 256.f) + EPS);
            const size_t prow = (size_t)(r0 + tt) * NPROJ + C_GR + h * 256; bf16* orow = OG + (size_t)(r0 + tt) * DM + h * 256;
#pragma unroll
            for (int m = 0; m < 4; ++m) { const int dv = dv0 + 8 * m + 4 * hh;
                const v2u gr = *(const v2u*)(P + prow + dv); const f32x4 gn = *(const f32x4*)(gnorm + h * 256 + dv);
                const float a0 = o[ti][4 * m] * rstd * gn[0] * siluf_(bflo(gr[0])), a1 = o[ti][4 * m + 1] * rstd * gn[1] * siluf_(bfhi(gr[0]));
                const float a2 = o[ti][4 * m + 2] * rstd * gn[2] * siluf_(bflo(gr[1])), a3 = o[ti][4 * m + 3] * rstd * gn[3] * siluf_(bfhi(gr[1]));
                v2u ov; ov.x = cvtpk(a0, a1); ov.y = cvtpk(a2, a3); *(v2u*)(orow + dv) = ov; }
        }
        __syncthreads();
    }
}
DI void phase_gla_sample(const Ctx& C) {
    const bf16* P = WSP(bf16, WS_PROJ); bf16* OG = WSP(bf16, WS_OG);
    const float* wup = C.in[16]; const float* bgate = C.in[17]; const float* gnorm = C.in[18]; const float* S0 = C.in[5];
    LAS float* QS = (LAS float*)C.lds; LAS float* KS = QS + 128; LAS float* AS = KS + 128; LAS float* GAs = AS + 128; LAS float* PART = GAs + 16; LAS float* RED = PART + 8 * 256;
    const int tid = C.tid, lane = C.lane, w = C.wave;
    for (int unit = C.bid; unit < NSMP * 4; unit += C.G) {
        const int b = unit >> 2, h = unit & 3; const size_t prow = (size_t)(MPR + b) * NPROJ;
        if (tid < 16) GAs[tid] = bf2f(P[prow + C_GA + tid]);
        __syncthreads();
        if (tid < 128) { float x = bgate[h * 128 + tid];
#pragma unroll
            for (int r = 0; r < 16; ++r) x += GAs[r] * wup[(size_t)r * 512 + h * 128 + tid];
            AS[tid] = __expf(logsigf_(x) * (1.f / 16.f)); QS[tid] = bf2f(P[prow + C_GQ + h * 128 + tid]) * GLA_QS; KS[tid] = bf2f(P[prow + C_GK + h * 128 + tid]); }
        __syncthreads();
        const int dv = 4 * lane, dk0 = 16 * w;
        const v2u vv = *(const v2u*)(P + prow + C_GV + h * 256 + dv); const f32x4 v = {bflo(vv[0]), bfhi(vv[0]), bflo(vv[1]), bfhi(vv[1])};
        const float* s0 = S0 + ((size_t)unit * 128 + dk0) * 256 + dv; float* so = C.out + O_GLA_S + ((size_t)unit * 128 + dk0) * 256 + dv;
        f32x4 sv[16];
#pragma unroll
        for (int i = 0; i < 16; ++i) sv[i] = *(const f32x4*)(s0 + (size_t)i * 256);
        f32x4 o = {0.f, 0.f, 0.f, 0.f};
#pragma unroll
        for (int i = 0; i < 16; ++i) { const f32x4 s = sv[i] * AS[dk0 + i] + v * KS[dk0 + i]; *(f32x4*)(so + (size_t)i * 256) = s; o += s * QS[dk0 + i]; }
        *(LAS f32x4*)(PART + w * 256 + dv) = o;
        __syncthreads();
        float ov = 0.f, ss = 0.f;
        if (tid < 256) {
#pragma unroll
            for (int ww = 0; ww < 8; ++ww) ov += PART[ww * 256 + tid];
            ss = ov * ov; }
        ss = wave_sum(ss); if (lane == 0) RED[w] = ss;
        __syncthreads();
        if (tid < 256) { const float tot = RED[0] + RED[1] + RED[2] + RED[3]; const float rstd = rsqrtf(tot * (1.f / 256.f) + EPS);
            const float val = ov * rstd * gnorm[h * 256 + tid] * siluf_(bf2f(P[prow + C_GR + h * 256 + tid]));
            OG[(size_t)(MPR + b) * DM + h * 256 + tid] = (bf16)(cvtpk(val, 0.f) & 0xffffu); }
        __syncthreads();
    }
}
constexpr int KSTR = 144;
constexpr int KV_TILE = 64 * KSTR;
DI void qk_tile(const LAS unsigned char* Kt, const bf16x8 (&qf)[4], int r32, int hh, f32x16& p0, f32x16& p1) {
    p0 = (f32x16){}; p1 = (f32x16){};
#pragma unroll
    for (int s = 0; s < 4; ++s) {
        const bf16x8 a0 = *(const LAS bf16x8*)(Kt + r32 * KSTR + 32 * s + 16 * hh), a1 = *(const LAS bf16x8*)(Kt + (32 + r32) * KSTR + 32 * s + 16 * hh);
        p0 = MFMA32(a0, qf[s], p0); p1 = MFMA32(a1, qf[s], p1);
    }
}
DI void qk_tile_c(const LAS unsigned char* Kt, const bf16x8 (&qf)[4], const f32x16& cin, int r32, int hh, f32x16& p0, f32x16& p1) {
#pragma unroll
    for (int s = 0; s < 4; ++s) {
        const bf16x8 a0 = *(const LAS bf16x8*)(Kt + r32 * KSTR + 32 * s + 16 * hh), a1 = *(const LAS bf16x8*)(Kt + (32 + r32) * KSTR + 32 * s + 16 * hh);
        if (s == 0) { p0 = MFMA32(a0, qf[0], cin); p1 = MFMA32(a1, qf[0], cin); } else { p0 = MFMA32(a0, qf[s], p0); p1 = MFMA32(a1, qf[s], p1); }
    }
}
DI f32x16 splat16(float v) { f32x16 r;
#pragma unroll
    for (int i = 0; i < 16; ++i) r[i] = v;
    return r; }
DI void pv_tile(const LAS unsigned char* Vt, const f32x16& p0, const f32x16& p1, f32x16& o0, f32x16& o1, int lane) {
#pragma unroll
    for (int kh = 0; kh < 2; ++kh)
#pragma unroll
        for (int s2 = 0; s2 < 2; ++s2) {
            const bf16x8 pb = pack_acc(kh ? p1 : p0, s2);
            const bf16x8 a0 = tr_frag_acc(Vt, KSTR, 32 * kh + 16 * s2, 0, lane), a1 = tr_frag_acc(Vt, KSTR, 32 * kh + 16 * s2, 32, lane);
            o0 = MFMA32(a0, pb, o0); o1 = MFMA32(a1, pb, o1);
        }
}
DI float max32(const f32x16& p0, const f32x16& p1) {
    float m = fmaxf(p0[0], p1[0]);
#pragma unroll
    for (int r = 1; r < 16; ++r) m = fmaxf(m, fmaxf(p0[r], p1[r]));
    return fmaxf(m, __shfl_xor(m, 32));
}
DI v4u ld_tile_row(const bf16* base, size_t pitch, int row0, int tid) { return *(const v4u*)(base + (size_t)(row0 + (tid >> 3)) * pitch + (tid & 7) * 8); }
DI void st_tile_row(LAS unsigned char* T, int tid, v4u v) { *(LAS v4u*)(T + (tid >> 3) * KSTR + (tid & 7) * 16) = v; }

DI bool attn_order(const Ctx& C, int i, int& bg, int& qt) {
    if (C.G == 256) { if (i >= 4) return false; const int s = C.bid & 31; bg = C.bid >> 5; qt = (i == 0) ? s : (i == 1) ? 63 - s : (i == 2) ? 64 + s : 127 - s; return true; }
    const int u = C.bid + i * C.G; if (u >= 1024) return false; bg = u >> 7; qt = u & 127; return true;
}

template <int MODE> DI void phase_attn_sw(const Ctx& C) {
    const bf16* P = WSP(bf16, WS_PROJ); const unsigned* SEL = WSP(unsigned, WS_SEL);
    const bf16* OC = WSP(bf16, WS_OC); const bf16* OWr = WSP(bf16, WS_OW); bf16* OUT = MODE == 1 ? WSP(bf16, WS_ONSA) : WSP(bf16, WS_OW);
    const int tid = C.tid, lane = C.lane, w = C.wave, r32 = lane & 31, hh = lane >> 5;
    LAS unsigned char* Kb = C.lds; LAS unsigned char* Vb = C.lds + 2 * KV_TILE;
    int bg, qt;
    for (int it = 0; attn_order(C, it, bg, qt); ++it) {
        const int b = bg >> 2, g = bg & 3, t0 = 64 * qt, tl = 8 * w + (r32 >> 2), t = t0 + tl, head = 4 * g + (r32 & 3);
        const size_t rowb = (size_t)b * SEQ; const size_t qrow = (rowb + t) * NPROJ;
        const bf16* Kp = P + rowb * NPROJ + (MODE == 1 ? C_KS : C_KW) + g * 128; const bf16* Vp = Kp + 64;
        bf16x8 qf[4];
#pragma unroll
        for (int s = 0; s < 4; ++s) qf[s] = *(const bf16x8*)(P + qrow + C_NQ + head * 64 + 16 * s + 8 * hh);
        v4u selw = (v4u){0u, 0u, 0u, 0u};
        if (MODE == 1) selw = *(const v4u*)(SEL + ((size_t)bg * SEQ + t) * 4);
        const int ntile = MODE == 1 ? qt + 1 : (qt >= 8 ? 9 : qt + 1);
#define KT_OF(i) (MODE == 1 ? (i) : qt - (i))
        float mref = 0.f, l = 0.f; f32x16 o0 = {}, o1 = {}; f32x16 negm = {};
        v4u kreg = ld_tile_row(Kp, NPROJ, 64 * KT_OF(0), tid), vreg = ld_tile_row(Vp, NPROJ, 64 * KT_OF(0), tid);
        st_tile_row(Kb, tid, kreg); st_tile_row(Vb, tid, vreg);
        __syncthreads();
        for (int i = 0; i < ntile; ++i) {
            const int kt = KT_OF(i), cur = i & 1;
            if (i + 1 < ntile) { kreg = ld_tile_row(Kp, NPROJ, 64 * KT_OF(i + 1), tid); vreg = ld_tile_row(Vp, NPROJ, 64 * KT_OF(i + 1), tid); }
            bool rowsel = true;
            if (MODE == 1) { const unsigned wsel = (kt < 32) ? selw[0] : (kt < 64) ? selw[1] : (kt < 96) ? selw[2] : selw[3]; rowsel = ((wsel >> (kt & 31)) & 1u) != 0u; }
            if (MODE != 1 || __any(rowsel)) {
                f32x16 cin = negm;
                if (MODE == 1) {
#pragma unroll
                    for (int r = 0; r < 16; ++r) cin[r] = rowsel ? negm[r] : -INFINITY;
                }
                f32x16 p0, p1;
                qk_tile_c(Kb + cur * KV_TILE, qf, cin, r32, hh, p0, p1);
#define SW_MASK() do { \
                if (kt == qt) { _Pragma("unroll") for (int r = 0; r < 16; ++r) { const int kl = crow(r, hh); if (kl > tl) p0[r] = -INFINITY; if (kl + 32 > tl) p1[r] = -INFINITY; } } \
                if (MODE == 2 && kt == qt - 8) { _Pragma("unroll") for (int r = 0; r < 16; ++r) { const int kl = crow(r, hh); if (kl <= tl) p0[r] = -INFINITY; if (kl + 32 <= tl) p1[r] = -INFINITY; } } } while (0)
                SW_MASK();
                if (i == 0) {
                    const float mt = max32(p0, p1); mref = (mt == -INFINITY) ? 0.f : mt; negm = splat16(-mref);
#pragma unroll
                    for (int r = 0; r < 16; ++r) { p0[r] -= mref; p1[r] -= mref; }
                }
                float rs = 0.f;
#pragma unroll
                for (int r = 0; r < 16; ++r) { p0[r] = __builtin_amdgcn_exp2f(p0[r]); p1[r] = __builtin_amdgcn_exp2f(p1[r]); rs += p0[r] + p1[r]; }
                if (__builtin_expect(__any(!(rs < 3.0e38f)), 0)) {
                    f32x16 craw;
#pragma unroll
                    for (int r = 0; r < 16; ++r) craw[r] = rowsel ? 0.f : -INFINITY;
                    qk_tile_c(Kb + cur * KV_TILE, qf, craw, r32, hh, p0, p1);
                    SW_MASK();
                    const float mt = max32(p0, p1), mn = fmaxf(mref, mt), alpha = __builtin_amdgcn_exp2f(mref - mn);
                    l *= alpha;
#pragma unroll
                    for (int r = 0; r < 16; ++r) { o0[r] *= alpha; o1[r] *= alpha; }
                    mref = mn; negm = splat16(-mref); rs = 0.f;
#pragma unroll
                    for (int r = 0; r < 16; ++r) { p0[r] = __builtin_amdgcn_exp2f(p0[r] - mn); p1[r] = __builtin_amdgcn_exp2f(p1[r] - mn); rs += p0[r] + p1[r]; }
                }
#undef SW_MASK
                l += rs;
                pv_tile(Vb + cur * KV_TILE, p0, p1, o0, o1, lane);
            }
            if (i + 1 < ntile) { st_tile_row(Kb + (cur ^ 1) * KV_TILE, tid, kreg); st_tile_row(Vb + (cur ^ 1) * KV_TILE, tid, vreg); }
            __syncthreads();
        }
#undef KT_OF
        const float lt = l + __shfl_xor(l, 32), inv = lt > 0.f ? 1.f / lt : 0.f;
        const float gate = sigmoidf_(bf2f(P[qrow + C_NG + head * 3 + (MODE == 1 ? 1 : 2)])) * inv;
        const size_t ooff = (rowb + t) * DM + head * 64;
#pragma unroll
        for (int dt = 0; dt < 2; ++dt)
#pragma unroll
            for (int mq = 0; mq < 4; ++mq) {
                const int d = 32 * dt + 8 * mq + 4 * hh; const f32x16& o = dt ? o1 : o0;
                float a0 = o[4 * mq] * gate, a1 = o[4 * mq + 1] * gate, a2 = o[4 * mq + 2] * gate, a3 = o[4 * mq + 3] * gate;
                if (MODE == 1) { const v2u c = *(const v2u*)(OC + ooff + d), ww = *(const v2u*)(OWr + ooff + d);
                    a0 += bflo(c[0]) + bflo(ww[0]); a1 += bfhi(c[0]) + bfhi(ww[0]); a2 += bflo(c[1]) + bflo(ww[1]); a3 += bfhi(c[1]) + bfhi(ww[1]); }
                v2u ov; ov.x = cvtpk(a0, a1); ov.y = cvtpk(a2, a3); *(v2u*)(OUT + ooff + d) = ov;
            }
    }
}

DI unsigned topk_select(const LAS float* IMP, int lane, int cur) {
    const int tlw = lane >> 3, sub = lane & 7;
    unsigned key[16]; unsigned fb = 0u;
#pragma unroll
    for (int i = 0; i < 16; ++i) { const int j = 16 * sub + i; const bool forced = (j == 0) || (j == cur) || (j == cur - 1); const bool cand = (j <= cur) && !forced;
        key[i] = cand ? (__float_as_uint(fmaxf(IMP[tlw * 128 + j], 0.f)) + 1u) : 0u; if (forced && j <= cur) fb |= 1u << i; }
    const int nforced = cur == 0 ? 1 : (cur == 1 ? 2 : 3), krem = 16 - nforced;
    unsigned T = 0u;
    for (int bit = 30; bit >= 0; --bit) { const unsigned Tn = T | (1u << bit); int cnt = 0;
#pragma unroll
        for (int i = 0; i < 16; ++i) cnt += (key[i] >= Tn) ? 1 : 0;
        cnt = sum8_i(cnt); if (cnt >= krem) T = Tn; }
    unsigned bits = 0u;
    if (T == 0u) {
#pragma unroll
        for (int i = 0; i < 16; ++i) bits |= (key[i] >= 1u ? 1u : 0u) << i;
    } else {
        int ngt = 0, neq = 0;
#pragma unroll
        for (int i = 0; i < 16; ++i) { ngt += (key[i] > T) ? 1 : 0; neq += (key[i] == T) ? 1 : 0; }
        const int need = krem - sum8_i(ngt);
        int run = 0;
#pragma unroll
        for (int s = 0; s < 8; ++s) { const int c = __shfl(neq, (lane & ~7) + s); if (s < sub) run += c; }
#pragma unroll
        for (int i = 0; i < 16; ++i) { if (key[i] > T) bits |= 1u << i; else if (key[i] == T) { if (run < need) bits |= 1u << i; ++run; } }
    }
    return bits | fb;
}

DI void phase_attn_cmp(const Ctx& C) {
    const bf16* P = WSP(bf16, WS_PROJ); unsigned* SEL = WSP(unsigned, WS_SEL); bf16* OC = WSP(bf16, WS_OC);
    const bf16* KVC = WSP(bf16, WS_KVC);
    const int tid = C.tid, lane = C.lane, w = C.wave, r32 = lane & 31, hh = lane >> 5;
    LAS unsigned char* Kb = C.lds; LAS unsigned char* Vb = C.lds + 2 * KV_TILE;
    LAS float* PS = (LAS float*)(C.lds + 4 * KV_TILE + w * 6400);
    LAS float* IMP = PS + 8 * 66 + 8;
    int bg, qt;
    for (int it = 0; attn_order(C, it, bg, qt); ++it) {
        const int b = bg >> 2, g = bg & 3, t0 = 64 * qt, tl = 8 * w + (r32 >> 2), t = t0 + tl, head = 4 * g + (r32 & 3);
        const size_t rowb = (size_t)b * SEQ; const size_t qrow = (rowb + t) * NPROJ;
        const bf16* Kp = KVC + ((size_t)CHK_S + (size_t)bg * 512) * 64; const bf16* Vp = Kp + (size_t)CHK_ROWS * 64;
        bf16x8 qf[4];
#pragma unroll
        for (int s = 0; s < 4; ++s) qf[s] = *(const bf16x8*)(P + qrow + C_NQ + head * 64 + 16 * s + 8 * hh);
        const int ntiles = (((t0 + 32) >> 4) >> 6) + 1;
        const int nmax = t >= 31 ? ((t - 31) >> 4) : -1;
        for (int i = lane; i < 8 * 128; i += 64) IMP[i] = 0.f;
        if (lane < 8) PS[lane * 66] = 0.f;
        const int tw0 = t0 + 8 * w; const int nmax_w = tw0 >= 31 ? ((tw0 - 31) >> 4) : -1;
#define CMP_MASK() do { if (64 * kt + 63 > nmax_w) { _Pragma("unroll") for (int r = 0; r < 16; ++r) { const int n = 64 * kt + crow(r, hh); if (n > nmax) p0[r] = -INFINITY; if (n + 32 > nmax) p1[r] = -INFINITY; } } } while (0)
        float mref = 0.f, l = 0.f; f32x16 negm = {};
        v4u kreg = ld_tile_row(Kp, 64, 0, tid), vreg;
        st_tile_row(Kb, tid, kreg);
        __syncthreads();
        for (int kt = 0; kt < ntiles; ++kt) {
            const int cur = kt & 1;
            if (kt + 1 < ntiles) kreg = ld_tile_row(Kp, 64, 64 * (kt + 1), tid);
            f32x16 p0, p1;
            qk_tile_c(Kb + cur * KV_TILE, qf, negm, r32, hh, p0, p1);
            CMP_MASK();
            if (kt == 0) { const float mt = max32(p0, p1); mref = (mt == -INFINITY) ? 0.f : mt; negm = splat16(-mref);
#pragma unroll
                for (int r = 0; r < 16; ++r) { p0[r] -= mref; p1[r] -= mref; } }
            float rs = 0.f;
#pragma unroll
            for (int r = 0; r < 16; ++r) rs += __builtin_amdgcn_exp2f(p0[r]) + __builtin_amdgcn_exp2f(p1[r]);
            if (__builtin_expect(__any(!(rs < 3.0e38f)), 0)) {
                const f32x16 zero16 = {};
                qk_tile_c(Kb + cur * KV_TILE, qf, zero16, r32, hh, p0, p1);
                CMP_MASK();
                const float mt = max32(p0, p1), mn = fmaxf(mref, mt); l *= __builtin_amdgcn_exp2f(mref - mn); mref = mn; negm = splat16(-mref); rs = 0.f;
#pragma unroll
                for (int r = 0; r < 16; ++r) rs += __builtin_amdgcn_exp2f(p0[r] - mn) + __builtin_amdgcn_exp2f(p1[r] - mn);
            }
            l += rs;
            if (kt + 1 < ntiles) st_tile_row(Kb + (cur ^ 1) * KV_TILE, tid, kreg);
            __syncthreads();
        }
        const float lt = l + __shfl_xor(l, 32), inv = lt > 0.f ? 1.f / lt : 0.f;
        f32x16 o0 = {}, o1 = {};
        kreg = ld_tile_row(Kp, 64, 0, tid); vreg = ld_tile_row(Vp, 64, 0, tid);
        st_tile_row(Kb, tid, kreg); st_tile_row(Vb, tid, vreg);
        __syncthreads();
        for (int kt = 0; kt < ntiles; ++kt) {
            const int cur = kt & 1;
            if (kt + 1 < ntiles) { kreg = ld_tile_row(Kp, 64, 64 * (kt + 1), tid); vreg = ld_tile_row(Vp, 64, 64 * (kt + 1), tid); }
            f32x16 p0, p1;
            qk_tile_c(Kb + cur * KV_TILE, qf, negm, r32, hh, p0, p1);
            CMP_MASK();
#pragma unroll
            for (int r = 0; r < 16; ++r) { p0[r] = __builtin_amdgcn_exp2f(p0[r]) * inv; p1[r] = __builtin_amdgcn_exp2f(p1[r]) * inv; }
            pv_tile(Vb + cur * KV_TILE, p0, p1, o0, o1, lane);
#pragma unroll
            for (int r = 0; r < 16; ++r) { const float s0 = quad_sum(p0[r]), s1 = quad_sum(p1[r]);
                if ((r32 & 3) == 0) { PS[(r32 >> 2) * 66 + 1 + crow(r, hh)] = s0; PS[(r32 >> 2) * 66 + 33 + crow(r, hh)] = s1; } }
            LDS_WAIT();
            { const int tk = lane >> 3, j0 = (lane & 7) * 2;
#pragma unroll
              for (int e = 0; e < 2; ++e) { const LAS float* ps = PS + tk * 66 + 1 + 4 * (j0 + e);
                  IMP[tk * 128 + 16 * kt + j0 + e] = ps[-1] + 2.f * (ps[0] + ps[1] + ps[2]) + ps[3]; } }
            LDS_WAIT();
            if (lane < 8) PS[lane * 66] = PS[lane * 66 + 64];
            LDS_WAIT();
            if (kt + 1 < ntiles) { st_tile_row(Kb + (cur ^ 1) * KV_TILE, tid, kreg); st_tile_row(Vb + (cur ^ 1) * KV_TILE, tid, vreg); }
            __syncthreads();
        }
#undef CMP_MASK
        {
            const float gate = sigmoidf_(bf2f(P[qrow + C_NG + head * 3 + 0]));
            const size_t ooff = (rowb + t) * DM + head * 64;
#pragma unroll
            for (int dt = 0; dt < 2; ++dt)
#pragma unroll
                for (int mq = 0; mq < 4; ++mq) { const int d = 32 * dt + 8 * mq + 4 * hh; const f32x16& o = dt ? o1 : o0;
                    v2u ov; ov.x = cvtpk(o[4 * mq] * gate, o[4 * mq + 1] * gate); ov.y = cvtpk(o[4 * mq + 2] * gate, o[4 * mq + 3] * gate); *(v2u*)(OC + ooff + d) = ov; }
        }
        {
            const int sub = lane & 7, tk = lane >> 3;
            const unsigned bits = topk_select(IMP, lane, qt);
            unsigned wv = bits << (16 * (sub & 1)); wv |= (unsigned)dpp_i<0xB1>((int)wv);
            if ((sub & 1) == 0) SEL[((size_t)bg * SEQ + t0 + 8 * w + tk) * 4 + (sub >> 1)] = wv;
        }
        __syncthreads();
    }
}

DI f32x4 ld_bf4(const bf16* p) { const v2u v = *(const v2u*)p; return (f32x4){bflo(v[0]), bfhi(v[0]), bflo(v[1]), bfhi(v[1])}; }
template <int MODE> DI f32x4 smp_load(const Ctx& C, int b, int g, int n, int c, int i, const LAS long* koff) {
    if (MODE == 0) return ld_bf4(WSP(bf16, WS_KVC) + ((size_t)c * CHK_ROWS + (size_t)(b * 4 + g) * 512 + n) * 64 + 4 * i);
    if (MODE == 1) return *(const f32x4*)(C.in[3] + koff[n >> 6] + (size_t)(n & 63) * 512 + c * 64 + 4 * i);
    return *(const f32x4*)(C.in[4] + ((size_t)(b * 512 + n)) * 512 + g * 128 + c * 64 + 4 * i);
}
template <int MODE> DI void smp_branch(const Ctx& C, int b, int g, const f32x4 (&qv)[4], LAS float* SC, LAS float* RED, const LAS long* koff, float& fin) {
    constexpr int NMAIN = MODE == 0 ? 511 : MODE == 1 ? 960 : 512, N = MODE == 0 ? NMAIN : NMAIN + 1;
    const int tid = C.tid, i = tid & 15, grp = tid >> 4, lane = C.lane, w = C.wave;
    const bf16* newrow = WSP(bf16, WS_PROJ) + (size_t)(MPR + b) * NPROJ + (MODE == 1 ? C_KS : C_KW) + g * 128 + 4 * i;
    for (int n0 = grp; n0 < NMAIN; n0 += 256) {
        f32x4 kv[8];
#pragma unroll
        for (int u = 0; u < 8; ++u) { const int n = n0 + 32 * u; kv[u] = smp_load<MODE>(C, b, g, n < NMAIN ? n : NMAIN - 1, 0, i, koff); }
#pragma unroll
        for (int u = 0; u < 8; ++u) {
            const int n = n0 + 32 * u;
            float part[4];
#pragma unroll
            for (int h = 0; h < 4; ++h) part[h] = sum16_f(qv[h][0] * kv[u][0] + qv[h][1] * kv[u][1] + qv[h][2] * kv[u][2] + qv[h][3] * kv[u][3]);
            if (i == 0 && n < NMAIN) { const bool ok = MODE == 2 ? n >= 1 : true;
#pragma unroll
                for (int h = 0; h < 4; ++h) SC[h * 1056 + n] = ok ? part[h] : -INFINITY; }
        }
    }
    if (MODE != 0) { const f32x4 kx = ld_bf4(newrow);
        float part[4];
#pragma unroll
        for (int h = 0; h < 4; ++h) part[h] = sum16_f(qv[h][0] * kx[0] + qv[h][1] * kx[1] + qv[h][2] * kx[2] + qv[h][3] * kx[3]);
        if (tid == 0) {
#pragma unroll
            for (int h = 0; h < 4; ++h) SC[h * 1056 + NMAIN] = part[h]; } }
    __syncthreads();
    if (w < 4) {
        float m = -INFINITY;
        for (int n = lane; n < N; n += 64) m = fmaxf(m, SC[w * 1056 + n]);
        m = wave_max(m); const float mu = (m == -INFINITY) ? 0.f : m;
        float s = 0.f;
        for (int n = lane; n < N; n += 64) { const float e = __builtin_amdgcn_exp2f(SC[w * 1056 + n] - mu); SC[w * 1056 + n] = e; s += e; }
        s = wave_sum(s); const float inv = s > 0.f ? 1.f / s : 0.f;
        for (int n = lane; n < N; n += 64) SC[w * 1056 + n] *= inv;
    }
    __syncthreads();
    f32x4 acc[4] = {};
    for (int n0 = grp; n0 < NMAIN; n0 += 256) {
        f32x4 vv[8];
#pragma unroll
        for (int u = 0; u < 8; ++u) { const int n = n0 + 32 * u; vv[u] = smp_load<MODE>(C, b, g, n < NMAIN ? n : NMAIN - 1, 1, i, koff); }
#pragma unroll
        for (int u = 0; u < 8; ++u) {
            const int n = n0 + 32 * u;
            if (n < NMAIN) {
#pragma unroll
                for (int h = 0; h < 4; ++h) acc[h] += vv[u] * SC[h * 1056 + n];
            }
        }
    }
    if (MODE != 0 && grp == 0) { const f32x4 vx = ld_bf4(newrow + 64);
#pragma unroll
        for (int h = 0; h < 4; ++h) acc[h] += vx * SC[h * 1056 + NMAIN]; }
#pragma unroll
    for (int h = 0; h < 4; ++h) *(LAS f32x4*)(RED + (grp * 4 + h) * 64 + 4 * i) = acc[h];
    __syncthreads();
    if (tid < 256) { const int h = tid >> 6, d = tid & 63; float s = 0.f;
#pragma unroll 8
        for (int gq = 0; gq < 32; ++gq) s += RED[(gq * 4 + h) * 64 + d];
        const float gate = sigmoidf_(bf2f(WSP(bf16, WS_PROJ)[(size_t)(MPR + b) * NPROJ + C_NG + (4 * g + h) * 3 + MODE]));
        fin += gate * s; }
    __syncthreads();
}
DI void phase_nsa_sample(const Ctx& C) {
    const bf16* P = WSP(bf16, WS_PROJ); bf16* ONSA = WSP(bf16, WS_ONSA);
    LAS float* SC = (LAS float*)C.lds;
    LAS float* RED = SC + 4 * 1056;
    LAS float* IMPS = RED + 32 * 4 * 64;
    LAS float* PSM = IMPS + 8 * 128;
    LAS long* KOFF = (LAS long*)(PSM + 528);
    LAS unsigned* SELW = (LAS unsigned*)(KOFF + 16);
    const int tid = C.tid, i = tid & 15, lane = C.lane, w = C.wave;
    for (int unit = C.bid; unit < NSMP * 4; unit += C.G) {
        const int b = unit >> 2, g = unit & 3; const size_t prow = (size_t)(MPR + b) * NPROJ;
        f32x4 qv[4];
#pragma unroll
        for (int h = 0; h < 4; ++h) qv[h] = ld_bf4(P + prow + C_NQ + (4 * g + h) * 64 + 4 * i);
        float fin = 0.f;
        smp_branch<0>(C, b, g, qv, SC, RED, KOFF, fin);
        for (int n = tid; n < 528; n += 512) { const int nn = n - 4; PSM[n] = (nn >= 0 && nn < 511) ? (SC[nn] + SC[1056 + nn] + SC[2 * 1056 + nn] + SC[3 * 1056 + nn]) : 0.f; }
        __syncthreads();
        for (int j = tid; j < 8 * 128; j += 512) { const int jj = j & 127; const LAS float* ps = PSM + 4 + 4 * jj; IMPS[j] = ps[-1] + 2.f * (ps[0] + ps[1] + ps[2]) + ps[3]; }
        __syncthreads();
        if (w == 0) {
            const int sub = lane & 7; const unsigned bits = topk_select(IMPS, lane, 128);
            unsigned wv = bits << (16 * (sub & 1)); wv |= (unsigned)dpp_i<0xB1>((int)wv);
            if (lane < 8 && (sub & 1) == 0) SELW[sub >> 1] = wv;
        }
        __syncthreads();
        if (tid < 128) { const int j = tid; const unsigned w0 = SELW[0], w1 = SELW[1], w2 = SELW[2], w3 = SELW[3];
            const unsigned mine = j < 32 ? w0 : j < 64 ? w1 : j < 96 ? w2 : w3;
            if ((mine >> (j & 31)) & 1u) {
                int rank = __popc(mine & ((1u << (j & 31)) - 1u)); if (j >= 32) rank += __popc(w0); if (j >= 64) rank += __popc(w1); if (j >= 96) rank += __popc(w2);
                if (rank < 15) KOFF[rank] = ((long)((const int*)C.in[7])[b * NPAGES + (j >> 1)] * PAGE + (j & 1) * 64) * 512 + g * 128; } }
        __syncthreads();
        smp_branch<1>(C, b, g, qv, SC, RED, KOFF, fin);
        smp_branch<2>(C, b, g, qv, SC, RED, KOFF, fin);
        if (tid < 256) ONSA[(size_t)(MPR + b) * DM + (4 * g + (tid >> 6)) * 64 + (tid & 63)] = (bf16)(cvtpk(fin, 0.f) & 0xffffu);
        __syncthreads();
    }
}
constexpr int TD_A = 2 * 64 * KSTR  , TD_PGO = 2 * TD_A;
template <int MODE, int VAR = 0> DI void phase_tdirect(const Ctx& C) {
    const bf16* W1T = WSP(bf16, WS_W1_T); bf16* T = WSP(bf16, WS_T); const bf16* P = WSP(bf16, WS_PROJ);
    const float* cache = C.in[2]; const int* pt = (const int*)C.in[7];
    LAS unsigned* PGO = (LAS unsigned*)(C.lds + TD_PGO);
    const int tid = C.tid, lane = C.lane, w = C.wave, r32 = lane & 31, hh = lane >> 5;
    const int nunits = MODE == 0 ? NSMP * 32 : NBP * 32;
    const int c = w >> 2, n0 = (w & 3) * 64;
    const int ksh = (C.bid * 5) & 15;
#define PSH(p) ((((p) + ksh)) & 15)
    for (int unit = C.bid; unit < nunits; unit += C.G) {
        const int b = unit >> 5, u5 = unit & 31;
        if (MODE == 0) { if (tid < 16) PGO[tid] = ((unsigned)pt[b * NPAGES + 2 * u5 + (tid >> 3)] * PAGE + 16u * (tid & 7)) * 2048u; }
        __syncthreads();
        f32x4 areg[4][4]; v4u aregb[4][2]; bf16x8 wfr[2][2][4];
        const unsigned poff = (unsigned)(((b * SEQ + 256 * u5 + 16 * (tid >> 6)) * NPROJ + C_KC + (tid & 63) * 8) * 2);
        const unsigned woff = (unsigned)(((c * 256 + n0 + r32) * 1024 + 8 * hh) * 2);
        const unsigned aoff0 = (unsigned)((tid & 127) * 16);
        const char* cbase = (const char*)cache; const char* pb = (const char*)P; const char* wb = (const char*)W1T;
#define TD_LOADW(pos, S) do { unsigned wo_ = woff; asm volatile("" : "+v"(wo_)); \
        _Pragma("unroll") for (int nt = 0; nt < 2; ++nt) _Pragma("unroll") for (int ks = 0; ks < 4; ++ks) wfr[S][nt][ks] = *(const bf16x8*)(wb + (wo_ + (unsigned)(nt * 32 * 2048 + PSH(pos) * 128 + ks * 32))); } while (0)
#define TD_LOADA(pos, S) do { \
        if (MODE == 0) { _Pragma("unroll") for (int i = 0; i < 4; ++i) areg[S][i] = *(const f32x4*)(cbase + (PGO[i * 4 + (tid >> 7)] + aoff0 + (unsigned)(PSH(pos) * 2048))); } \
        else { unsigned po_ = poff; asm volatile("" : "+v"(po_)); _Pragma("unroll") for (int i = 0; i < 2; ++i) aregb[S][i] = *(const v4u*)(pb + (po_ + (unsigned)((i * 128 + PSH(pos)) * (NPROJ * 2)))); } } while (0)
#define TD_STOREA(buf, S) do { LAS unsigned char* Ab_ = C.lds + (buf) * TD_A; \
        if (MODE == 0) { _Pragma("unroll") for (int i = 0; i < 4; ++i) { const int ti = i * 4 + (tid >> 7), f4 = tid & 127; v2u o; o.x = cvtpk(areg[S][i][0], areg[S][i][1]); o.y = cvtpk(areg[S][i][2], areg[S][i][3]); \
                *(LAS v2u*)(Ab_ + ((f4 >> 4) & 1) * (64 * KSTR) + ((f4 >> 5) * 16 + ti) * KSTR + (f4 & 15) * 8) = o; } } \
        else { _Pragma("unroll") for (int i = 0; i < 2; ++i) { const int ti = i * 8 + (tid >> 6), ch = tid & 63; *(LAS v4u*)(Ab_ + ((ch >> 3) & 1) * (64 * KSTR) + ((ch >> 4) * 16 + ti) * KSTR + (ch & 7) * 16) = aregb[S][i]; } } } while (0)
        f32x16 acc[2][2];
#pragma unroll
        for (int nt = 0; nt < 2; ++nt)
#pragma unroll
            for (int rt = 0; rt < 2; ++rt) acc[nt][rt] = (f32x16){};
#define TD_STEP(pos, CUR, SN) do { \
            if ((pos) < 15) { TD_LOADW((pos) + 1, (CUR) ^ 1); } \
            asm volatile("" ::: "memory");     \
            if ((pos) < 15) { TD_STOREA((CUR) ^ 1, SN); } \
            asm volatile("" ::: "memory"); \
            if ((pos) < 11) { TD_LOADA((pos) + 5, SN); } \
            asm volatile("" ::: "memory"); \
            const LAS unsigned char* Ac = C.lds + (CUR) * TD_A + c * (64 * KSTR) + r32 * KSTR + 16 * hh; \
            _Pragma("unroll") for (int ks = 0; ks < 4; ++ks) { \
                bf16x8 af[2]; \
                _Pragma("unroll") for (int rt = 0; rt < 2; ++rt) af[rt] = *(const LAS bf16x8*)(Ac + rt * 32 * KSTR + 32 * ks); \
                _Pragma("unroll") for (int nt = 0; nt < 2; ++nt) _Pragma("unroll") for (int rt = 0; rt < 2; ++rt) acc[nt][rt] = MFMA32(wfr[CUR][nt][ks], af[rt], acc[nt][rt]); } \
            __syncthreads(); } while (0)
        TD_LOADW(0, 0); TD_LOADA(0, 0); TD_STOREA(0, 0); TD_LOADA(1, 1); TD_LOADA(2, 2); TD_LOADA(3, 3); TD_LOADA(4, 0);
        __syncthreads();
        for (int pos = 0; pos < 16; pos += 4) { TD_STEP(pos, 0, 1); TD_STEP(pos + 1, 1, 2); TD_STEP(pos + 2, 0, 3); TD_STEP(pos + 3, 1, 0); }
#undef TD_STEP
#undef PSH_DUMMY
#undef TD_LOADA
#undef TD_LOADW
#undef TD_STOREA
        const size_t Rb = (size_t)(MODE == 0 ? 0 : CHK_S) + (size_t)b * 2048 + 16 * u5;
#pragma unroll
        for (int nt = 0; nt < 2; ++nt)
#pragma unroll
            for (int rt = 0; rt < 2; ++rt) {
                const int rr = 32 * rt + r32; bf16* Trow = T + ((size_t)c * CHK_ROWS + Rb + (size_t)(rr >> 4) * 512 + (rr & 15)) * 256 + n0 + 32 * nt + 4 * hh;
#pragma unroll
                for (int m = 0; m < 4; ++m) { v2u o; o.x = cvtpk(acc[nt][rt][4 * m], acc[nt][rt][4 * m + 1]); o.y = cvtpk(acc[nt][rt][4 * m + 2], acc[nt][rt][4 * m + 3]); *(v2u*)(Trow + 8 * m) = o; }
            }
    }
}
#undef PSH
#ifndef MK_ONE_LAUNCH
#define MK_ONE_LAUNCH 1
#endif
#ifndef MK_DUP_MASK
#define MK_DUP_MASK 0
#endif
#ifndef MK_EXP
#define MK_EXP 0
#endif
#ifndef MK_DUPF
#define MK_DUPF 0
#endif
#define DUPF(bit, call) do { call; if constexpr (((MK_DUPF >> (bit)) & 1) != 0) { __syncthreads(); call; } } while (0)
constexpr int N_PHASES = 14;
struct Args { const float* in[33]; float* out; unsigned char* ws; int ph_lo, ph_hi; };
static_assert(sizeof(Args) == 33 * 8 + 8 + 8 + 8, "Args has no padding");

template <class Epi> DI void run_gemm(const Ctx& C, const bf16* A, const bf16* Bt, int M, int N, int K, const Epi& E) {
    pg8::Gemm g{A, Bt, M, N, K}; pg8::StaticOrder S; S.init(M, N, C.G, C.bid);
    pg8::gemm_phase<Epi, pg8::StaticOrder, true, true>(C.lds, g, S, E);
}

template <class Epi> DI void gemm_skinny(const Ctx& C, const bf16* A, const bf16* Bt, int N, int K, const Epi& E) {
    LAS f32x4* red = (LAS f32x4*)C.lds;
    const int lane = C.lane, w = C.wave, ntasks = N / 16, kper = K / 8;
    for (int t = C.bid; t < ntasks; t += C.G) {
        const int col0 = 16 * t;
        const bf16* bp = Bt + (size_t)(col0 + (lane & 15)) * K + w * kper + 8 * (lane >> 4);
        const bf16* ap = A + (size_t)(MPR + (lane & 15)) * K + w * kper + 8 * (lane >> 4);
        f32x4 acc0 = {0.f, 0.f, 0.f, 0.f}, acc1 = acc0;
#pragma unroll 4
        for (int kk = 0; kk < kper; kk += 32) {
            const bf16x8 bw = *(const bf16x8*)(bp + kk), a0 = *(const bf16x8*)(ap + kk), a1 = *(const bf16x8*)(ap + (size_t)16 * K + kk);
            acc0 = __builtin_amdgcn_mfma_f32_16x16x32_bf16(bw, a0, acc0, 0, 0, 0); acc1 = __builtin_amdgcn_mfma_f32_16x16x32_bf16(bw, a1, acc1, 0, 0, 0);
        }
        red[(w * 2 + 0) * 64 + lane] = acc0; red[(w * 2 + 1) * 64 + lane] = acc1;
        __syncthreads();
        if (w == 0) {
            f32x4 v0 = red[lane], v1 = red[64 + lane];
#pragma unroll
            for (int ww = 1; ww < 8; ++ww) { v0 += red[(ww * 2) * 64 + lane]; v1 += red[(ww * 2 + 1) * 64 + lane]; }
            E.e4(MPR + (lane & 15), col0 + 4 * (lane >> 4), v0); E.e4(MPR + 16 + (lane & 15), col0 + 4 * (lane >> 4), v1);
        }
        __syncthreads();
    }
}

__global__ void __launch_bounds__(512, 2) fwd_kernel(Args args) {
    extern __shared__ __attribute__((aligned(16))) unsigned char lds_raw[];
    Ctx C;
    C.lds = (LAS unsigned char*)lds_raw;
    C.tid = threadIdx.x; C.lane = C.tid & 63; C.wave = __builtin_amdgcn_readfirstlane(C.tid >> 6);
    C.G = gridDim.x; C.bid = blockIdx.x;
#pragma unroll
    for (int i = 0; i < 33; ++i) C.in[i] = args.in[i];
    C.out = args.out; C.ws = args.ws;
    volatile LAS unsigned* MISC = (volatile LAS unsigned*)(C.lds + MISC_OFF);
    if (C.tid < 32) MISC[C.tid] = 0u;
    __syncthreads();
    XcdBarrier bar; bar.bar = (unsigned*)(args.ws + WS_CTL) + CW_BAR; bar.x = 0; bar.st = nullptr;
    if (MK_ONE_LAUNCH) bar = xcd_barrier_post((unsigned*)(args.ws + WS_CTL) + CW_BAR, MISC + 8);
    const int lo = args.ph_lo, hi = args.ph_hi;
#define IN(k) (lo <= (k) && (k) < hi)
#define SEAM(k) do { if (IN(k) && IN((k) + 1)) { if (MK_ONE_LAUNCH) xcd_barrier(bar); } } while (0)

#define PH(k, ...) do { if (IN(k)) { __VA_ARGS__; if constexpr (((MK_DUP_MASK >> (k)) & 1) != 0) { __syncthreads(); __VA_ARGS__; } } SEAM(k); } while (0)
    PH(0, phase_prologue(C); __syncthreads());
    PH(1, { pg8::EpiProj E{WSP(bf16, WS_PROJ), C.out}; run_gemm(C, WSP(bf16, WS_XN), WSP(bf16, WS_WIN_T), MP, NPROJ, DM, E); } __syncthreads();
          { pg8::EpiStore<false> E{WSP(bf16, WS_PP), DM, nullptr}; run_gemm(C, WSP(bf16, WS_PB), WSP(bf16, WS_WPP_T), MPR, DM, PLE, E); __syncthreads(); gemm_skinny(C, WSP(bf16, WS_PB), WSP(bf16, WS_WPP_T), DM, PLE, E); });
    PH(2, DUPF(6, phase_tdirect<0>(C)); __syncthreads(); phase_tdirect<1>(C); __syncthreads(); DUPF(2, phase_g1(C)); __syncthreads(); DUPF(3, phase_attn_sw<2>(C)); __syncthreads(); DUPF(4, phase_gla_sample(C)); __syncthreads());
    PH(3, DUPF(5, phase_g2(C)); __syncthreads(); DUPF(7, phase_kvc(C)); __syncthreads());
    PH(4, DUPF(8, phase_g3(C)); __syncthreads(); DUPF(0, phase_attn_cmp(C)); __syncthreads(); DUPF(1, phase_nsa_sample(C)); __syncthreads());
    PH(5, { pg8::EpiStore<false> E{WSP(bf16, WS_YG), DM, nullptr}; run_gemm(C, WSP(bf16, WS_OG), WSP(bf16, WS_WGO_T), MPR, DM, DM, E); __syncthreads(); gemm_skinny(C, WSP(bf16, WS_OG), WSP(bf16, WS_WGO_T), DM, DM, E); } __syncthreads();
          DUPF(9, phase_attn_sw<1>(C)); __syncthreads());
    PH(6, { pg8::EpiMix E{WSP(bf16, WS_PROJ), WSP(bf16, WS_YG), WSP(bf16, WS_MIX)}; run_gemm(C, WSP(bf16, WS_ONSA), WSP(bf16, WS_WNO_T), MPR, DM, DM, E); __syncthreads(); gemm_skinny(C, WSP(bf16, WS_ONSA), WSP(bf16, WS_WNO_T), DM, DM, E); });
    PH(7, { pg8::EpiF32 E{WSP(float, WS_T1), DM}; run_gemm(C, WSP(bf16, WS_MIX), WSP(bf16, WS_WOUT_T), MPR, DM, DM, E); __syncthreads(); gemm_skinny(C, WSP(bf16, WS_MIX), WSP(bf16, WS_WOUT_T), DM, DM, E); });
    PH(8, phase_rownorm(C, WSP(float, WS_T1), C.in[0], C.in[1], C.in[11], C.in[12], WSP(float, WS_X1), WSP(bf16, WS_XN)));
    PH(9, { pg8::EpiStore<true> E{WSP(bf16, WS_UP), NUP, C.out}; run_gemm(C, WSP(bf16, WS_XN), WSP(bf16, WS_WUP_T), MP, NUP, DM, E); });
    PH(10, phase_conv(C));
    PH(11, { pg8::EpiF32 E{WSP(float, WS_T1), DM}; run_gemm(C, WSP(bf16, WS_H), WSP(bf16, WS_WDN_T), MPR, DM, DFF, E); __syncthreads(); gemm_skinny(C, WSP(bf16, WS_H), WSP(bf16, WS_WDN_T), DM, DFF, E); });
    PH(12, phase_rownorm(C, WSP(float, WS_T1), WSP(float, WS_X1), WSP(float, WS_X1) + (size_t)MPR * DM, C.in[13], C.in[14], WSP(float, WS_X2), WSP(bf16, WS_XN)));
    if (IN(13)) { pg8::EpiFinal E{WSP(float, WS_X2), WSP(bf16, WS_PP), C.out}; run_gemm(C, WSP(bf16, WS_XN), WSP(bf16, WS_WPG_T), MPR, DM, DM, E); __syncthreads(); gemm_skinny(C, WSP(bf16, WS_XN), WSP(bf16, WS_WPG_T), DM, DM, E); }
#undef PH
#undef IN
#undef SEAM
}

extern "C" void kernel_launch(void* const* d_in, const int* in_sizes, int n_in, void* d_out, int out_size, void* d_ws, size_t ws_size, hipStream_t stream) {
    static int grid = 0;
    if (grid == 0) {
        if (n_in != 33 || (size_t)out_size != O_END || ws_size < WS_END) { fprintf(stderr, "kernel_launch: unexpected shapes (n_in %d, out %d, ws %zu, need %zu)\n", n_in, out_size, ws_size, (size_t)WS_END); grid = -1; return; }
        int dev = 0, cus = 0, per_cu = 0;
        if (hipGetDevice(&dev) != hipSuccess || hipDeviceGetAttribute(&cus, hipDeviceAttributeMultiprocessorCount, dev) != hipSuccess) { grid = -1; return; }
        if (hipFuncSetAttribute((const void*)fwd_kernel, hipFuncAttributeMaxDynamicSharedMemorySize, LDS_BYTES) != hipSuccess) { fprintf(stderr, "kernel_launch: hipFuncSetAttribute failed\n"); grid = -1; return; }
        if (hipOccupancyMaxActiveBlocksPerMultiprocessor(&per_cu, (const void*)fwd_kernel, 512, LDS_BYTES) != hipSuccess || per_cu < 1) fprintf(stderr, "kernel_launch: occupancy query says %d\n", per_cu);
        (void)hipGetLastError();
        grid = cus;
    }
    if (grid < 0) return;
    (void)hipMemsetAsync((char*)d_ws + WS_CTL, 0, CTL_BYTES, stream);
    Args a{};
    for (int i = 0; i < 33; ++i) a.in[i] = (const float*)d_in[i];
    a.out = (float*)d_out; a.ws = (unsigned char*)d_ws;
#if MK_ONE_LAUNCH
    a.ph_lo = 0; a.ph_hi = N_PHASES;
    hipLaunchKernelGGL(fwd_kernel, dim3(grid), dim3(512), LDS_BYTES, stream, a);
#else
    for (int p = 0; p < N_PHASES; ++p) { a.ph_lo = p; a.ph_hi = p + 1; hipLaunchKernelGGL(fwd_kernel, dim3(grid), dim3(512), LDS_BYTES, stream, a); }
#endif
    const hipError_t le = hipPeekAtLastError();
    if (le != hipSuccess) fprintf(stderr, "kernel_launch: launch failed: %s\n", hipGetErrorName(le));
}
```

```cpp
#include <hip/hip_runtime.h>
#include <hip/hip_bf16.h>
#include <cstdio>
#include <cstdint>
#define MK_ONE_LAUNCH 1
namespace pg8 {
#define PG8_LAS __attribute__((address_space(3)))
typedef unsigned short bf16_t;
typedef short bf16x8 __attribute__((ext_vector_type(8)));
typedef float f32x4 __attribute__((ext_vector_type(4)));
typedef unsigned u32x4 __attribute__((ext_vector_type(4)));
constexpr int BM = 256, BK = 64, HALF = 128, HTB = HALF * BK * 2  , STAGE_BYTES = 8 * HTB, NXCD = 8, WGM = 8;

__host__ __device__ __forceinline__ int lds_byte(int r, int c) { const int st = (r >> 4) * 2 + (c >> 5), rr = r & 15, cc = c & 31, ob = rr * 64 + cc * 2; return st * 1024 + (ob ^ (((ob >> 9) & 1) << 5)); }
__host__ __device__ __forceinline__ void stage_rc(int b, int& R, int& C) { const int st = b / 1024, sb = b % 1024, swz = sb ^ (((sb >> 9) & 1) << 5); R = (st >> 1) * 16 + swz / 64; C = (st & 1) * 32 + (swz % 64) / 2; }
__host__ __device__ __forceinline__ int perm32(int rho) { const int n = rho >> 4, i = rho & 15; return 8 * (i >> 2) + 4 * n + (i & 3); }

struct Unit { int pm, pn; };
struct Gemm { const bf16_t* A; const bf16_t* Bt; int M, N, K; };

struct StaticOrder {
    int nM, nN, nwg, G, c;
    __host__ __device__ void init(int M, int N, int G_, int c_) { nM = M / BM; nN = N / BM; nwg = nM * nN; G = G_; c = c_; }
    __host__ __device__ bool next(int i, Unit& u) const {
        const long L = (long)i * G + c; if (L >= nwg) return false;
        int wgid = (int)L; { const int q = nwg / NXCD, r = nwg % NXCD, xcd = wgid % NXCD, off = wgid / NXCD; wgid = (xcd < r ? xcd * (q + 1) : r * (q + 1) + (xcd - r) * q) + off; }
        const int nig = WGM * nN, gid = wgid / nig, fm = gid * WGM, gsz = (nM - fm) < WGM ? (nM - fm) : WGM;
        u.pm = fm + ((wgid % nig) % gsz); u.pn = (wgid % nig) / gsz; return true;
    }
    __device__ __forceinline__ void a_ready(const Unit&) const {}
    __device__ __forceinline__ void done(const Unit&) const {}
};

__device__ __forceinline__ unsigned cvt_pk_bf16(float lo, float hi) { unsigned r; asm volatile("v_cvt_pk_bf16_f32 %0, %1, %2" : "=v"(r) : "v"(lo), "v"(hi)); return r; }
typedef float f32x2 __attribute__((ext_vector_type(2)));
template <class Epi, class Sched, bool ALIGN_EPI = false, bool SP2 = false>
__device__ __forceinline__ void gemm_phase(PG8_LAS unsigned char* lds, const Gemm g, const Sched& S, const Epi& E) {
    const int tid = threadIdx.x, wid = __builtin_amdgcn_readfirstlane(tid >> 6), lane = tid & 63, wr = wid >> 2, wc = wid & 3, fr = lane & 15, fq = lane >> 4;
    const int K = g.K, nt = K / BK;
    unsigned voffA[2], voffB[2];
#pragma unroll
    for (int i = 0; i < 2; ++i) { int R, C; stage_rc(tid * 16 + i * 8192, R, C); const int Rb = Epi::PERM ? ((R & ~31) + perm32(R & 31)) : R;
        voffA[i] = (unsigned)(R * K + C) * 2u; voffB[i] = (unsigned)(Rb * K + C) * 2u; }
    const size_t kstep = (size_t)(BK * 2);
    const size_t hstep = (size_t)HALF * K * 2;
    const size_t tstep = 2 * hstep;
    const unsigned ldsw = (unsigned)wid * 1024u;
    const int aoff = lds_byte(wr * 64 + fr, fq * 8), boff = lds_byte(wc * 32 + fr, fq * 8);
#define PG8_SA(b, h) (((b) * 2 + (h)) * HTB)
#define PG8_SB(b, h) ((4 + (b) * 2 + (h)) * HTB)
#define PG8_STAGE(bufoff, gbase, voff) do { _Pragma("unroll") for (int _i = 0; _i < 2; ++_i) \
        __builtin_amdgcn_global_load_lds((const unsigned*)((const char*)(gbase) + (voff)[_i]), (PG8_LAS unsigned*)(lds + (bufoff) + ldsw + _i * 8192), 16, 0, 0); } while (0)
#define PG8_LDA(dst, b, h) do { _Pragma("unroll") for (int m = 0; m < 4; ++m) _Pragma("unroll") for (int k = 0; k < 2; ++k) dst[m][k] = *(const PG8_LAS bf16x8*)(lds + PG8_SA(b, h) + aoff + m * 2048 + k * 1024); } while (0)
#define PG8_LDB(dst, b, h) do { _Pragma("unroll") for (int n = 0; n < 2; ++n) _Pragma("unroll") for (int k = 0; k < 2; ++k) dst[n][k] = *(const PG8_LAS bf16x8*)(lds + PG8_SB(b, h) + boff + n * 2048 + k * 1024); } while (0)
#define PG8_MMA(ai, bj, At, Bt) do { __builtin_amdgcn_s_setprio(1); _Pragma("unroll") for (int m = 0; m < 4; ++m) _Pragma("unroll") for (int n = 0; n < 2; ++n) _Pragma("unroll") for (int k = 0; k < 2; ++k) \
        acc[ai][bj][m][n] = __builtin_amdgcn_mfma_f32_16x16x32_bf16(Bt[n][k], At[m][k], acc[ai][bj][m][n], 0, 0, 0); __builtin_amdgcn_s_setprio(0); } while (0)
#define PG8_WAIT_V(n) asm volatile("s_waitcnt vmcnt(" #n ")" ::: "memory")
#define PG8_WAIT_L(n) asm volatile("s_waitcnt lgkmcnt(" #n ")" ::: "memory")
#define PG8_BAR __builtin_amdgcn_s_barrier()
#define PG8_SCHED __builtin_amdgcn_sched_barrier(0)
    Unit cur, nxt; int ui = 0;
    if (!S.next(0, cur)) return;
    f32x4 acc[2][2][4][2];
#pragma unroll
    for (int a = 0; a < 2; ++a)
#pragma unroll
        for (int b = 0; b < 2; ++b)
#pragma unroll
            for (int m = 0; m < 4; ++m)
#pragma unroll
                for (int n = 0; n < 2; ++n) acc[a][b][m][n] = (f32x4){0.f, 0.f, 0.f, 0.f};
    bf16x8 At[4][2], B0[2][2], B1[2][2];
    const char* cA = (const char*)g.A + (size_t)cur.pm * tstep; const char* cB = (const char*)g.Bt + (size_t)cur.pn * tstep;
    S.a_ready(cur);
    if constexpr (SP2) {
        PG8_STAGE(PG8_SB(0, 0), cB, voffB); PG8_STAGE(PG8_SB(0, 1), cB + hstep, voffB); PG8_STAGE(PG8_SA(0, 0), cA, voffA); PG8_STAGE(PG8_SA(0, 1), cA + hstep, voffA);
        if (wr == 1) PG8_BAR;
        PG8_WAIT_V(2); PG8_BAR;
        PG8_STAGE(PG8_SB(1, 0), cB + kstep, voffB); PG8_STAGE(PG8_SA(1, 0), cA + kstep, voffA); PG8_STAGE(PG8_SB(1, 1), cB + hstep + kstep, voffB);
        PG8_WAIT_V(6); PG8_BAR;
    } else {
        PG8_STAGE(PG8_SB(0, 0), cB, voffB); PG8_STAGE(PG8_SA(0, 0), cA, voffA); PG8_STAGE(PG8_SB(0, 1), cB + hstep, voffB); PG8_STAGE(PG8_SA(0, 1), cA + hstep, voffA);
        if (wr == 1) PG8_BAR;
        PG8_WAIT_V(4); PG8_BAR;
        PG8_STAGE(PG8_SB(1, 0), cB + kstep, voffB); PG8_STAGE(PG8_SA(1, 0), cA + kstep, voffA); PG8_STAGE(PG8_SB(1, 1), cB + hstep + kstep, voffB);
        PG8_WAIT_V(6); PG8_BAR;
    }
    for (;;) {
        const bool has_next = S.next(ui + 1, nxt);
        const char* nA = has_next ? (const char*)g.A + (size_t)nxt.pm * tstep : cA; const char* nB = has_next ? (const char*)g.Bt + (size_t)nxt.pn * tstep : cB;
        for (int t = 0; t < nt; t += 2) {
            const bool last = (t == nt - 2);
            const char* a1 = cA + (size_t)(t + 1) * kstep;
            const char* a2 = last ? nA : cA + (size_t)(t + 2) * kstep; const char* b2 = last ? nB : cB + (size_t)(t + 2) * kstep;
            const char* a3 = a2 + kstep; const char* b3 = b2 + kstep;
            if (last && has_next) S.a_ready(nxt);
            if constexpr (SP2) {
            PG8_LDB(B0, 0, 0); PG8_LDB(B1, 0, 1); PG8_SCHED; PG8_LDA(At, 0, 0); PG8_STAGE(PG8_SA(1, 1), a1 + hstep, voffA);
            PG8_WAIT_V(8); PG8_WAIT_L(0); PG8_BAR; PG8_MMA(0, 0, At, B0); PG8_MMA(0, 1, At, B1); PG8_BAR; PG8_SCHED;
            PG8_LDA(At, 0, 1); PG8_STAGE(PG8_SB(0, 0), b2, voffB); PG8_STAGE(PG8_SB(0, 1), b2 + hstep, voffB); PG8_STAGE(PG8_SA(0, 0), a2, voffA);
            PG8_WAIT_V(8); PG8_WAIT_L(0); PG8_BAR; PG8_MMA(1, 0, At, B0); PG8_MMA(1, 1, At, B1); PG8_BAR; PG8_SCHED;
            PG8_LDB(B0, 1, 0); PG8_LDB(B1, 1, 1); PG8_SCHED; PG8_LDA(At, 1, 0); PG8_STAGE(PG8_SA(0, 1), a2 + hstep, voffA);
            PG8_WAIT_V(8); PG8_WAIT_L(0); PG8_BAR; PG8_MMA(0, 0, At, B0); PG8_MMA(0, 1, At, B1); PG8_BAR; PG8_SCHED;
            PG8_LDA(At, 1, 1); PG8_STAGE(PG8_SB(1, 0), b3, voffB); PG8_STAGE(PG8_SB(1, 1), b3 + hstep, voffB); PG8_STAGE(PG8_SA(1, 0), a3, voffA);
            PG8_WAIT_V(8); PG8_WAIT_L(0); PG8_BAR; PG8_MMA(1, 0, At, B0); PG8_MMA(1, 1, At, B1); PG8_BAR; PG8_SCHED;
            } else {
            PG8_LDB(B0, 0, 0); PG8_SCHED; PG8_LDA(At, 0, 0); PG8_STAGE(PG8_SA(1, 1), a1 + hstep, voffA);
            PG8_WAIT_L(8); PG8_BAR; PG8_WAIT_L(0); PG8_MMA(0, 0, At, B0); PG8_BAR; PG8_SCHED;
            PG8_LDB(B1, 0, 1); PG8_STAGE(PG8_SB(0, 0), b2, voffB);
            PG8_BAR; PG8_WAIT_L(0); PG8_MMA(0, 1, At, B1); PG8_BAR;
            PG8_LDA(At, 0, 1); PG8_STAGE(PG8_SA(0, 0), a2, voffA);
            PG8_BAR; PG8_WAIT_L(0); PG8_MMA(1, 0, At, B0); PG8_BAR; PG8_SCHED;
            PG8_STAGE(PG8_SB(0, 1), b2 + hstep, voffB);
            PG8_WAIT_V(6); PG8_BAR; PG8_MMA(1, 1, At, B1); PG8_BAR;
            PG8_LDB(B0, 1, 0); PG8_SCHED; PG8_LDA(At, 1, 0); PG8_STAGE(PG8_SA(0, 1), a2 + hstep, voffA);
            PG8_WAIT_L(8); PG8_BAR; PG8_WAIT_L(0); PG8_MMA(0, 0, At, B0); PG8_BAR; PG8_SCHED;
            PG8_LDB(B1, 1, 1); PG8_STAGE(PG8_SB(1, 0), b3, voffB);
            PG8_BAR; PG8_WAIT_L(0); PG8_MMA(0, 1, At, B1); PG8_BAR;
            PG8_LDA(At, 1, 1); PG8_STAGE(PG8_SA(1, 0), a3, voffA);
            PG8_BAR; PG8_WAIT_L(0); PG8_MMA(1, 0, At, B0); PG8_BAR; PG8_SCHED;
            PG8_STAGE(PG8_SB(1, 1), b3 + hstep, voffB);
            PG8_WAIT_V(6); PG8_BAR; PG8_MMA(1, 1, At, B1); PG8_BAR;
            }
        }
        if constexpr (ALIGN_EPI) { if (wr == 0) PG8_BAR; }
        if constexpr (!Epi::AFTER_DRAIN) { E(acc, cur, wr, wc, fr, fq); S.done(cur); }
        if (!has_next) break;
#pragma unroll
        for (int a = 0; a < 2; ++a)
#pragma unroll
            for (int b = 0; b < 2; ++b)
#pragma unroll
                for (int m = 0; m < 4; ++m)
#pragma unroll
                    for (int n = 0; n < 2; ++n) acc[a][b][m][n] = (f32x4){0.f, 0.f, 0.f, 0.f};
        cur = nxt; cA = nA; cB = nB; ++ui;
        if constexpr (ALIGN_EPI) { if (wr == 1) PG8_BAR; }
    }
    PG8_WAIT_V(0);
    if constexpr (!ALIGN_EPI) { if (wr == 0) PG8_BAR; }
    PG8_BAR;
    if constexpr (Epi::AFTER_DRAIN) { E.fused(acc, cur, wr, wc, fr, fq, lds, wid, lane); S.done(cur); }
#undef PG8_SA
#undef PG8_SB
#undef PG8_STAGE
#undef PG8_LDA
#undef PG8_LDB
#undef PG8_MMA
#undef PG8_WAIT_V
#undef PG8_WAIT_L
#undef PG8_BAR
#undef PG8_SCHED
}
}
#define GAS __attribute__((address_space(1)))
#define LAS __attribute__((address_space(3)))
typedef unsigned short bf16;
typedef unsigned v4u __attribute__((ext_vector_type(4)));
typedef float f32x4 __attribute__((ext_vector_type(4)));
typedef short bf16x8 __attribute__((ext_vector_type(8)));
typedef GAS unsigned gu32;
typedef GAS unsigned long long gu64;
#define RLX_AGENT __ATOMIC_RELAXED, __HIP_MEMORY_SCOPE_AGENT
#define LDS_WAIT() asm volatile("s_waitcnt lgkmcnt(0)" ::: "memory")
#define VM_WAIT() asm volatile("s_waitcnt vmcnt(0)" ::: "memory")
__device__ __forceinline__ unsigned long long rt() { return __builtin_amdgcn_s_memrealtime(); }
__device__ __forceinline__ unsigned f2bf(float f) { unsigned u = __builtin_bit_cast(unsigned, f); return (u + 0x7fffu + ((u >> 16) & 1u)) >> 16; }
__device__ __forceinline__ unsigned pk2(float lo, float hi) { return f2bf(lo) | (f2bf(hi) << 16); }

#define XB_TMO      128
#define XB_XCNT(j)  (256  + 64 * (j))
#define XB_XSUB(j)  (1280 + 64 * (j))
#define XB_XGEN(j)  (2304 + 64 * (j))
#define XB_TOP      3328
#define XB_TOPGEN   3392
#define XCD_BAR_WORDS 3456
#define XB_SPIN_CAP (1u << 18)

__device__ __forceinline__ unsigned xb_ld(unsigned* p)              { return __hip_atomic_load(p, __ATOMIC_RELAXED, __HIP_MEMORY_SCOPE_AGENT); }
__device__ __forceinline__ unsigned xb_add(unsigned* p, unsigned v) { return __hip_atomic_fetch_add(p, v, __ATOMIC_RELAXED, __HIP_MEMORY_SCOPE_AGENT); }
__device__ __forceinline__ unsigned xb_xcc_id() { return (unsigned)__builtin_amdgcn_s_getreg((3 << 11) | 20) & 0xFu; }
#define XB_SPIN(cond, bar) do { unsigned _sp = 0; while (cond) { __builtin_amdgcn_s_sleep(1); \
    if ((++_sp & 255u) == 0u) { if (xb_ld(&(bar)[XB_TMO])) break; if (_sp > XB_SPIN_CAP) { atomicAdd(&(bar)[XB_TMO], 1u); break; } } } } while (0)

struct XcdBarrier {
    unsigned* bar; unsigned x;
    volatile LAS unsigned* st;
};

__device__ __forceinline__ XcdBarrier xcd_barrier_post(unsigned* bar, volatile LAS unsigned* st) {
    XcdBarrier b; b.bar = bar; b.x = xb_xcc_id(); b.st = st;
    if (threadIdx.x == 0) (void)xb_add(&bar[XB_XCNT(b.x)], 1u);
    return b;
}
__device__ __forceinline__ void xcd_barrier_complete(unsigned* bar, unsigned x, unsigned& nloc, unsigned& nx) {
    const unsigned G = gridDim.x * gridDim.y * gridDim.z;
    unsigned sum, cnt, mine, sp = 0u;
    for (;;) {
        sum = 0u; cnt = 0u; mine = 0u;
#pragma unroll
        for (unsigned j = 0; j < 16; ++j) { const unsigned c = xb_ld(&bar[XB_XCNT(j)]); sum += c; cnt += (c > 0u) ? 1u : 0u; mine = (j == x) ? c : mine; }
        if (sum == G) break;
        __builtin_amdgcn_s_sleep(1);
        if ((++sp & 255u) == 0u) { if (xb_ld(&bar[XB_TMO])) break; if (sp > XB_SPIN_CAP) { atomicAdd(&bar[XB_TMO], 1u); break; } }
    }
    nloc = mine > 0u ? mine : 1u; nx = cnt > 0u ? cnt : 1u;
}

__device__ __forceinline__ void xcd_barrier(const XcdBarrier& b) {
    asm volatile("s_waitcnt vmcnt(0)" ::: "memory");
    __syncthreads();
    if (threadIdx.x == 0) {
        unsigned* bar = b.bar;
        __builtin_amdgcn_s_waitcnt(0);
        unsigned nloc = b.st[0], nx = b.st[1];
        if (nloc == 0u) { xcd_barrier_complete(bar, b.x, nloc, nx); b.st[0] = nloc; b.st[1] = nx; }
        const unsigned old = xb_add(&bar[XB_XSUB(b.x)], 1u);
        const unsigned gen = old / nloc;
        if (old + 1u == (gen + 1u) * nloc) {
            __builtin_amdgcn_fence(__ATOMIC_RELEASE, "agent");
            asm volatile("s_waitcnt vmcnt(0)" ::: "memory");
            const unsigned og = xb_add(&bar[XB_TOP], 1u);
            const unsigned tg = og / nx;
            if (og + 1u == (tg + 1u) * nx) xb_add(&bar[XB_TOPGEN], 1u);
            else XB_SPIN(xb_ld(&bar[XB_TOPGEN]) == tg, bar);
            __builtin_amdgcn_fence(__ATOMIC_ACQUIRE, "agent");
            xb_add(&bar[XB_XGEN(b.x)], 1u);
            asm volatile("s_waitcnt vmcnt(0)" ::: "memory");
        } else {
            XB_SPIN(xb_ld(&bar[XB_XGEN(b.x)]) == gen, bar);
            __builtin_amdgcn_fence(__ATOMIC_ACQUIRE, "agent");
            asm volatile("s_waitcnt vmcnt(0)" ::: "memory");
        }
    }
    __syncthreads();
}
#define DI __device__ __forceinline__
typedef float f32x16 __attribute__((ext_vector_type(16)));
typedef float f32x2 __attribute__((ext_vector_type(2)));
typedef unsigned v2u __attribute__((ext_vector_type(2)));
typedef short s16x4 __attribute__((ext_vector_type(4)));
typedef __bf16 bf16x2_t __attribute__((ext_vector_type(2)));

constexpr int DM = 1024, SEQ = 8192, NBP = 2, MPR = NBP * SEQ  , NSMP = 32, MTOT = MPR + NSMP  , MP = 16640  ;
constexpr int PAST = 8192, NPAGES = 64, PAGE = 128;
constexpr int DFF = 2816, NUP = 2 * DFF  , PLE = 256;
constexpr int NPROJ = 7936;
constexpr int C_GQ = 0, C_GK = 512, C_GV = 1024, C_GR = 2048, C_NQ = 3072, C_KC = 4096, C_KS = 4608, C_KW = 5120, C_MG = 5632, C_MN = 6656, C_GA = 7680, C_NG = 7696;
constexpr int IN_COLS = 7744;
constexpr float EPS = 1e-6f;
constexpr float LOG2E = 1.4426950408889634f;
constexpr float QSCALE = 0.125f * LOG2E;
constexpr float GLA_QS = 0.08838834764831845f;
constexpr int NCHUNK = MPR / 64;
constexpr int CHK_S = 32 * 4 * 512  , CHK_P = 2 * 4 * 512  , CHK_ROWS = CHK_S + CHK_P  ;

constexpr size_t O_Y = 0, O_YS = 16777216, O_CMP_P = O_YS + 32768, O_CMP_S = O_CMP_P + 8388608, O_SLC_P = O_CMP_S + 16384, O_SLC_S = O_SLC_P + 8388608,
                 O_WIN_P = O_SLC_S + 16384, O_WIN_S = O_WIN_P + 524288, O_GLA_P = O_WIN_S + 16384, O_GLA_S = O_GLA_P + 262144, O_CONV_P = O_GLA_S + 4194304,
                 O_CONV_S = O_CONV_P + 11264, O_END = O_CONV_S + 180224;

constexpr size_t al256(size_t x) { return (x + 255) & ~(size_t)255; }
constexpr size_t WS_CTL = 0, CTL_BYTES = 1u << 20;
constexpr size_t WS_WIN_T = WS_CTL + CTL_BYTES;
constexpr size_t WS_WGO_T = WS_WIN_T + (size_t)NPROJ * DM * 2;
constexpr size_t WS_WNO_T = WS_WGO_T + (size_t)DM * DM * 2;
constexpr size_t WS_WOUT_T = WS_WNO_T + (size_t)DM * DM * 2;
constexpr size_t WS_WPG_T = WS_WOUT_T + (size_t)DM * DM * 2;
constexpr size_t WS_WUP_T = WS_WPG_T + (size_t)DM * DM * 2;
constexpr size_t WS_WDN_T = WS_WUP_T + (size_t)NUP * DM * 2;
constexpr size_t WS_WPP_T = WS_WDN_T + (size_t)DM * DFF * 2;
constexpr size_t WS_W1_T = WS_WPP_T + (size_t)DM * PLE * 2;
constexpr size_t WS_W2_T = WS_W1_T + (size_t)2 * 256 * 1024 * 2;
constexpr size_t WS_B1P = WS_W2_T + (size_t)2 * 64 * 128 * 2;
constexpr size_t WS_XN = al256(WS_B1P + 1024);
constexpr size_t WS_PB = WS_XN + (size_t)MP * DM * 2;
constexpr size_t WS_PROJ = WS_PB + (size_t)MP * PLE * 2;
constexpr size_t WS_PP = WS_PROJ + (size_t)MP * NPROJ * 2;
constexpr size_t WS_QT = WS_PP + (size_t)MP * DM * 2;
constexpr size_t WS_KT = WS_QT + (size_t)MPR * 512 * 2;
constexpr size_t WS_UT = WS_KT + (size_t)MPR * 512 * 2;
constexpr size_t WS_ST = WS_UT + (size_t)NCHUNK * 4 * 256 * 128 * 2;
constexpr size_t WS_DL = WS_ST + (size_t)NCHUNK * 4 * 256 * 128 * 2;
constexpr size_t WS_OG = WS_DL + (size_t)NCHUNK * 4 * 128 * 4;
constexpr size_t WS_CHK = WS_OG + (size_t)MP * DM * 2;
constexpr size_t WS_T = WS_CHK + (size_t)2 * CHK_ROWS * 1024 * 2;
constexpr size_t WS_KVC = WS_T + (size_t)2 * CHK_ROWS * 256 * 2 + 4096;
constexpr size_t WS_SEL = WS_KVC + (size_t)2 * CHK_ROWS * 64 * 2 + 4096;
constexpr size_t WS_OC = WS_SEL + (size_t)8 * SEQ * 4 * 4;
constexpr size_t WS_OW = WS_OC + (size_t)MP * DM * 2;
constexpr size_t WS_ONSA = WS_OW + (size_t)MP * DM * 2;
constexpr size_t WS_YG = WS_ONSA + (size_t)MP * DM * 2;
constexpr size_t WS_MIX = WS_YG + (size_t)MP * DM * 2;
constexpr size_t WS_T1 = WS_MIX + (size_t)MP * DM * 2;
constexpr size_t WS_X1 = WS_T1 + (size_t)MP * DM * 4;
constexpr size_t WS_X2 = WS_X1 + (size_t)MP * DM * 4;
constexpr size_t WS_UP = WS_X2 + (size_t)MP * DM * 4;
constexpr size_t WS_H = WS_UP + (size_t)MP * NUP * 2;
constexpr size_t WS_END = WS_H + (size_t)MP * DFF * 2;

constexpr int CW_BAR = 4096;
constexpr int LDS_BYTES = 147456;
constexpr int MISC_OFF = 131072 + 320;

DI float bf2f(unsigned short h) { return __uint_as_float((unsigned)h << 16); }
DI float bflo(unsigned u) { return __uint_as_float(u << 16); }
DI float bfhi(unsigned u) { return __uint_as_float(u & 0xffff0000u); }
DI unsigned cvtpk(float lo, float hi) { f32x2 v = {lo, hi}; bf16x2_t b = __builtin_convertvector(v, bf16x2_t); return __builtin_bit_cast(unsigned, b); }
DI float sigmoidf_(float x) { return 1.0f / (1.0f + __expf(-x)); }
DI float siluf_(float x) { return x / (1.0f + __expf(-x)); }
DI float gelu_tanh(float x) { const float u = 1.5957691216057308f * (x + 0.044715f * x * x * x); return x / (1.0f + __expf(-u)); }
DI float logsigf_(float x) { return fminf(x, 0.f) - log1pf(__expf(-fabsf(x))); }
DI float wave_sum(float v) {
#pragma unroll
    for (int o = 1; o < 64; o <<= 1) v += __shfl_xor(v, o);
    return v;
}
DI float wave_max(float v) {
#pragma unroll
    for (int o = 1; o < 64; o <<= 1) v = fmaxf(v, __shfl_xor(v, o));
    return v;
}
template <int CTRL> DI int dpp_i(int x) { return __builtin_amdgcn_update_dpp(0, x, CTRL, 0xf, 0xf, false); }
template <int CTRL> DI float dpp_f(float x) { return __int_as_float(__builtin_amdgcn_update_dpp(0, __float_as_int(x), CTRL, 0xf, 0xf, false)); }
DI float quad_sum(float x) { x += dpp_f<0xB1>(x); x += dpp_f<0x4E>(x); return x; }
DI int sum8_i(int x) { x += dpp_i<0xB1>(x); x += dpp_i<0x4E>(x); x += dpp_i<0x141>(x); return x; }
DI float sum16_f(float x) { x += dpp_f<0xB1>(x); x += dpp_f<0x4E>(x); x += dpp_f<0x141>(x); x += dpp_f<0x140>(x); return x; }

#define MFMA32(a, b, c) __builtin_amdgcn_mfma_f32_32x32x16_bf16((a), (b), (c), 0, 0, 0)
DI int crow(int r, int hi) { return (r & 3) + 8 * (r >> 2) + 4 * hi; }
typedef short v4i16_t __attribute__((ext_vector_type(4)));
DI s16x4 vtr(const LAS unsigned char* p) { return __builtin_bit_cast(s16x4, __builtin_amdgcn_ds_read_tr16_b64_v4i16((LAS v4i16_t*)p)); }
DI bf16x8 cat8(s16x4 lo, s16x4 hi) { return (bf16x8){lo[0], lo[1], lo[2], lo[3], hi[0], hi[1], hi[2], hi[3]}; }
DI bf16x8 tr_frag(const LAS unsigned char* T, int stride, int k0, int n0, int lane) {
    const int q = (lane & 15) >> 2, p = lane & 3, blk = (lane >> 4) & 1, hh = lane >> 5;
    const LAS unsigned char* a = T + (k0 + 8 * hh + q) * stride + (n0 + 16 * blk + 4 * p) * 2;
    return cat8(vtr(a), vtr(a + 4 * stride));
}
DI bf16x8 tr_frag_acc(const LAS unsigned char* T, int stride, int k0, int n0, int lane) {
    const int q = (lane & 15) >> 2, p = lane & 3, blk = (lane >> 4) & 1, hh = lane >> 5;
    const LAS unsigned char* a = T + (k0 + 4 * hh + q) * stride + (n0 + 16 * blk + 4 * p) * 2;
    return cat8(vtr(a), vtr(a + 8 * stride));
}
DI bf16x8 pack_acc(const f32x16& x, int s) {
    v4u p; p.x = cvtpk(x[8 * s + 0], x[8 * s + 1]); p.y = cvtpk(x[8 * s + 2], x[8 * s + 3]); p.z = cvtpk(x[8 * s + 4], x[8 * s + 5]); p.w = cvtpk(x[8 * s + 6], x[8 * s + 7]);
    return __builtin_bit_cast(bf16x8, p);
}

struct Ctx {
    LAS unsigned char* lds;
    int tid, lane, wave, G, bid;
    const float* in[33];
    float* out;
    unsigned char* ws;
};
#define WSP(T, off) ((T*)(C.ws + (off)))
namespace pg8 {
DI unsigned epk(float lo, float hi) { return ::cvtpk(lo, hi); }
DI u32x4 pack8(const f32x4& a, const f32x4& b) { u32x4 w; w.x = epk(a[0], a[1]); w.y = epk(a[2], a[3]); w.z = epk(b[0], b[1]); w.w = epk(b[2], b[3]); return w; }

struct EpiProj {
    static constexpr bool PERM = true, AFTER_DRAIN = false;
    bf16_t* P; float* out;
    DI void operator()(const f32x4 (&acc)[2][2][4][2], const Unit& u, int wr, int wc, int fr, int fq) const {
        const float sc = (u.pn >= 12 && u.pn < 16) ? QSCALE : 1.f;
        const bool kv = (u.pn >= 16 && u.pn < 22); const int which = (u.pn - 16) >> 1;
#pragma unroll
        for (int ai = 0; ai < 2; ++ai)
#pragma unroll
            for (int m = 0; m < 4; ++m) {
                const int row = u.pm * BM + ai * HALF + wr * 64 + m * 16 + fr;
#pragma unroll
                for (int bj = 0; bj < 2; ++bj) {
                    const int col = u.pn * BM + bj * HALF + wc * 32 + 8 * fq;
                    const f32x4 v0 = acc[ai][bj][m][0], v1 = acc[ai][bj][m][1];
                    *(u32x4*)(P + (size_t)row * NPROJ + col) = pack8(v0 * sc, v1 * sc);
                    if (kv) {
                        const int c512 = col - (C_KC + which * 512); float* dst = nullptr;
                        if (row < MPR) {
                            if (which == 0) dst = out + O_CMP_P + (size_t)row * 512 + c512;
                            else if (which == 1) dst = out + O_SLC_P + (size_t)row * 512 + c512;
                            else { const int t = row & (SEQ - 1); if (t >= SEQ - 512) dst = out + O_WIN_P + ((size_t)((row >> 13) * 512 + (t - (SEQ - 512)))) * 512 + c512; }
                        } else if (row < MTOT) {
                            dst = out + (which == 0 ? O_CMP_S : which == 1 ? O_SLC_S : O_WIN_S) + (size_t)(row - MPR) * 512 + c512;
                        }
                        if (dst) { *(f32x4*)dst = v0; *(f32x4*)(dst + 4) = v1; }
                    }
                }
            }
    }
};
template <bool UPCONV> struct EpiStore {
    static constexpr bool PERM = true, AFTER_DRAIN = false;
    bf16_t* O; int ldc; float* out;
    DI void e4(int row, int col, const f32x4& v) const { v2u w; w.x = epk(v[0], v[1]); w.y = epk(v[2], v[3]); *(v2u*)(O + (size_t)row * ldc + col) = w; }
    DI void operator()(const f32x4 (&acc)[2][2][4][2], const Unit& u, int wr, int wc, int fr, int fq) const {
#pragma unroll
        for (int ai = 0; ai < 2; ++ai)
#pragma unroll
            for (int m = 0; m < 4; ++m) {
                const int row = u.pm * BM + ai * HALF + wr * 64 + m * 16 + fr;
#pragma unroll
                for (int bj = 0; bj < 2; ++bj) {
                    const int col = u.pn * BM + bj * HALF + wc * 32 + 8 * fq;
                    const f32x4 v0 = acc[ai][bj][m][0], v1 = acc[ai][bj][m][1];
                    *(u32x4*)(O + (size_t)row * ldc + col) = pack8(v0, v1);
                    if (UPCONV) {
                        if (col < DFF) {
                            float* dst = nullptr; const int t = row & (SEQ - 1);
                            if (row < MPR) { if (t >= SEQ - 2) dst = out + O_CONV_P + ((size_t)((row >> 13) * 2 + (t - (SEQ - 2)))) * DFF + col; }
                            else if (row < MTOT) dst = out + O_CONV_S + ((size_t)((row - MPR) * 2 + 1)) * DFF + col;
                            if (dst) { *(f32x4*)dst = v0; *(f32x4*)(dst + 4) = v1; }
                        }
                    }
                }
            }
    }
};
struct EpiMix {
    static constexpr bool PERM = true, AFTER_DRAIN = false;
    const bf16_t* P; const bf16_t* YG; bf16_t* MIX;
    DI void e4(int row, int col, const f32x4& v) const {
        const v2u yg = *(const v2u*)(YG + (size_t)row * DM + col), mg = *(const v2u*)(P + (size_t)row * NPROJ + C_MG + col), mn = *(const v2u*)(P + (size_t)row * NPROJ + C_MN + col);
        const float r0 = sigmoidf_(bflo(mg[0])) * bflo(yg[0]) + sigmoidf_(bflo(mn[0])) * v[0], r1 = sigmoidf_(bfhi(mg[0])) * bfhi(yg[0]) + sigmoidf_(bfhi(mn[0])) * v[1];
        const float r2 = sigmoidf_(bflo(mg[1])) * bflo(yg[1]) + sigmoidf_(bflo(mn[1])) * v[2], r3 = sigmoidf_(bfhi(mg[1])) * bfhi(yg[1]) + sigmoidf_(bfhi(mn[1])) * v[3];
        v2u w; w.x = epk(r0, r1); w.y = epk(r2, r3); *(v2u*)(MIX + (size_t)row * DM + col) = w;
    }
    DI void operator()(const f32x4 (&acc)[2][2][4][2], const Unit& u, int wr, int wc, int fr, int fq) const {
#pragma unroll
        for (int ai = 0; ai < 2; ++ai)
#pragma unroll
            for (int m = 0; m < 4; ++m) {
                const int row = u.pm * BM + ai * HALF + wr * 64 + m * 16 + fr;
#pragma unroll
                for (int bj = 0; bj < 2; ++bj) {
                    const int col = u.pn * BM + bj * HALF + wc * 32 + 8 * fq;
                    const f32x4 v0 = acc[ai][bj][m][0], v1 = acc[ai][bj][m][1];
                    const u32x4 yg = *(const u32x4*)(YG + (size_t)row * DM + col);
                    const u32x4 mg = *(const u32x4*)(P + (size_t)row * NPROJ + C_MG + col);
                    const u32x4 mn = *(const u32x4*)(P + (size_t)row * NPROJ + C_MN + col);
                    float r[8];
#pragma unroll
                    for (int e = 0; e < 4; ++e) {
                        const float a0 = e < 2 ? v0[2 * e] : v1[2 * e - 4], a1 = e < 2 ? v0[2 * e + 1] : v1[2 * e - 3];
                        r[2 * e] = sigmoidf_(bflo(mg[e])) * bflo(yg[e]) + sigmoidf_(bflo(mn[e])) * a0;
                        r[2 * e + 1] = sigmoidf_(bfhi(mg[e])) * bfhi(yg[e]) + sigmoidf_(bfhi(mn[e])) * a1;
                    }
                    u32x4 w; w.x = epk(r[0], r[1]); w.y = epk(r[2], r[3]); w.z = epk(r[4], r[5]); w.w = epk(r[6], r[7]);
                    *(u32x4*)(MIX + (size_t)row * DM + col) = w;
                }
            }
    }
};
struct EpiF32 {
    static constexpr bool PERM = false, AFTER_DRAIN = false;
    float* O; int ldc;
    DI void e4(int row, int col, const f32x4& v) const { *(f32x4*)(O + (size_t)row * ldc + col) = v; }
    DI void operator()(const f32x4 (&acc)[2][2][4][2], const Unit& u, int wr, int wc, int fr, int fq) const {
#pragma unroll
        for (int ai = 0; ai < 2; ++ai)
#pragma unroll
            for (int m = 0; m < 4; ++m) {
                const int row = u.pm * BM + ai * HALF + wr * 64 + m * 16 + fr;
#pragma unroll
                for (int bj = 0; bj < 2; ++bj)
#pragma unroll
                    for (int n = 0; n < 2; ++n) { const int col = u.pn * BM + bj * HALF + wc * 32 + 16 * n + 4 * fq; *(f32x4*)(O + (size_t)row * ldc + col) = acc[ai][bj][m][n]; }
            }
    }
};
struct EpiFinal {
    static constexpr bool PERM = false, AFTER_DRAIN = false;
    const float* X2; const bf16_t* PP; float* out;
    DI void e4(int row, int col, const f32x4& a) const {
        float* orow = row < MPR ? out + O_Y + (size_t)row * DM : out + O_YS + (size_t)(row - MPR) * DM;
        const f32x4 x = *(const f32x4*)(X2 + (size_t)row * DM + col); const v2u pp = *(const v2u*)(PP + (size_t)row * DM + col);
        f32x4 y; y[0] = x[0] + sigmoidf_(a[0]) * bflo(pp[0]); y[1] = x[1] + sigmoidf_(a[1]) * bfhi(pp[0]); y[2] = x[2] + sigmoidf_(a[2]) * bflo(pp[1]); y[3] = x[3] + sigmoidf_(a[3]) * bfhi(pp[1]);
        *(f32x4*)(orow + col) = y;
    }
    DI void operator()(const f32x4 (&acc)[2][2][4][2], const Unit& u, int wr, int wc, int fr, int fq) const {
#pragma unroll
        for (int ai = 0; ai < 2; ++ai)
#pragma unroll
            for (int m = 0; m < 4; ++m) {
                const int row = u.pm * BM + ai * HALF + wr * 64 + m * 16 + fr;
                if (row < MTOT) {
                    float* orow = row < MPR ? out + O_Y + (size_t)row * DM : out + O_YS + (size_t)(row - MPR) * DM;
#pragma unroll
                    for (int bj = 0; bj < 2; ++bj)
#pragma unroll
                        for (int n = 0; n < 2; ++n) {
                            const int col = u.pn * BM + bj * HALF + wc * 32 + 16 * n + 4 * fq; const f32x4 a = acc[ai][bj][m][n];
                            const f32x4 x = *(const f32x4*)(X2 + (size_t)row * DM + col); const v2u pp = *(const v2u*)(PP + (size_t)row * DM + col);
                            f32x4 y; y[0] = x[0] + sigmoidf_(a[0]) * bflo(pp[0]); y[1] = x[1] + sigmoidf_(a[1]) * bfhi(pp[0]); y[2] = x[2] + sigmoidf_(a[2]) * bflo(pp[1]); y[3] = x[3] + sigmoidf_(a[3]) * bfhi(pp[1]);
                            *(f32x4*)(orow + col) = y;
                        }
                }
            }
    }
};
}
struct ColIdent { DI int operator()(int n) const { return n; } };
struct ColWin {
    DI int operator()(int n) const {
        if (n < 3072) return n;
        if (n < 4096) return 3088 + (n - 3072);
        if (n < 5632) return 4112 + (n - 4096);
        if (n < 7680) return 5696 + (n - 5632);
        if (n < 7696) return 3072 + (n - 7680);
        if (n < 7744) return 5648 + (n - 7696);
        return -1;
    }
};
template <class F> DI void tr_item(const float* W, int Nsrc, bf16* WT, int Kpitch, int k0, int n0, LAS float* scr, int lane, F srccol) {
    const int kr = lane >> 3, n4 = (lane & 7) * 4; const int ns = srccol(n0 + n4);
    f32x4 v[8];
#pragma unroll
    for (int i = 0; i < 8; ++i) v[i] = ns >= 0 ? *(const f32x4*)(W + (size_t)(k0 + 8 * i + kr) * Nsrc + ns) : (f32x4){0.f, 0.f, 0.f, 0.f};
#pragma unroll
    for (int i = 0; i < 8; ++i) { LAS float* d = scr + (8 * i + kr) * 33 + n4; d[0] = v[i][0]; d[1] = v[i][1]; d[2] = v[i][2]; d[3] = v[i][3]; }
    LDS_WAIT(); asm volatile("" ::: "memory");
    const int c = lane & 7;
#pragma unroll
    for (int j = 0; j < 4; ++j) { const int n = (lane >> 3) + 8 * j; const LAS float* s = scr + (8 * c) * 33 + n;
        v4u o; o.x = cvtpk(s[0 * 33], s[1 * 33]); o.y = cvtpk(s[2 * 33], s[3 * 33]); o.z = cvtpk(s[4 * 33], s[5 * 33]); o.w = cvtpk(s[6 * 33], s[7 * 33]);
        *(v4u*)(WT + (size_t)(n0 + n) * Kpitch + k0 + 8 * c) = o; }
    LDS_WAIT(); asm volatile("" ::: "memory");
}
template <class F> DI void tr_matrix(const Ctx& C, const float* W, int K, int Nsrc, int Ndst, bf16* WT, int Kpitch, F f, int& base) {
    LAS float* scr = (LAS float*)(C.lds + C.wave * 16384);
    const int gw = C.bid * 8 + C.wave, NGW = C.G * 8, nb = Ndst / 32, items = (K / 64) * nb;
    int first = gw - (base % NGW); if (first < 0) first += NGW;
    for (int it = first; it < items; it += NGW) tr_item(W, Nsrc, WT, Kpitch, 64 * (it / nb), 32 * (it % nb), scr, C.lane, f);
    base += items;
}
DI void rms_row_bf16(const float* xrow, const float* g, bf16* orow, int lane) {
    const f32x4* xr = (const f32x4*)xrow + lane; const f32x4* gr = (const f32x4*)g + lane;
    f32x4 v[4]; float s = 0.f;
#pragma unroll
    for (int j = 0; j < 4; ++j) { v[j] = xr[64 * j]; s += (v[j][0] * v[j][0] + v[j][1] * v[j][1]) + (v[j][2] * v[j][2] + v[j][3] * v[j][3]); }
    const float rstd = rsqrtf(wave_sum(s) * (1.f / DM) + EPS);
#pragma unroll
    for (int j = 0; j < 4; ++j) { const f32x4 gg = gr[64 * j]; v2u o; o.x = cvtpk(v[j][0] * rstd * gg[0], v[j][1] * rstd * gg[1]); o.y = cvtpk(v[j][2] * rstd * gg[2], v[j][3] * rstd * gg[3]);
        *((v2u*)orow + lane + 64 * j) = o; }
}
DI void phase_prologue(const Ctx& C) {
    const int gw = C.bid * 8 + C.wave, NGW = C.G * 8, lane = C.lane;
    int base = 0;
    tr_matrix(C, C.in[15], DM, IN_COLS, NPROJ, WSP(bf16, WS_WIN_T), DM, ColWin(), base);
    tr_matrix(C, C.in[19], DM, DM, DM, WSP(bf16, WS_WGO_T), DM, ColIdent(), base);
    tr_matrix(C, C.in[25], DM, DM, DM, WSP(bf16, WS_WNO_T), DM, ColIdent(), base);
    tr_matrix(C, C.in[26], DM, DM, DM, WSP(bf16, WS_WOUT_T), DM, ColIdent(), base);
    tr_matrix(C, C.in[32], DM, DM, DM, WSP(bf16, WS_WPG_T), DM, ColIdent(), base);
    tr_matrix(C, C.in[27], DM, NUP, NUP, WSP(bf16, WS_WUP_T), DM, ColIdent(), base);
    tr_matrix(C, C.in[30], DFF, DM, DM, WSP(bf16, WS_WDN_T), DFF, ColIdent(), base);
    tr_matrix(C, C.in[31], PLE, DM, DM, WSP(bf16, WS_WPP_T), PLE, ColIdent(), base);
#pragma unroll
    for (int c = 0; c < 2; ++c)
#pragma unroll
        for (int hh = 0; hh < 2; ++hh)
            tr_matrix(C, C.in[20] + (size_t)(c * 2048 + hh * 1024) * 128, 1024, 128, 128, WSP(bf16, WS_W1_T) + (size_t)(c * 256 + hh * 128) * 1024, 1024, ColIdent(), base);
#pragma unroll
    for (int c = 0; c < 2; ++c) tr_matrix(C, C.in[22] + (size_t)c * 128 * 64, 128, 64, 64, WSP(bf16, WS_W2_T) + (size_t)c * 64 * 128, 128, ColIdent(), base);
    if (gw < 256) {
        const int c = gw >> 7, h = gw & 127; const float* w1 = C.in[20] + (size_t)c * 2048 * 128; const float* pe = C.in[24];
        float s = 0.f;
        for (int k = lane; k < 2048; k += 64) { const int pos = k >> 6, d = k & 63; s += pe[(pos * 2 + c) * 64 + d] * w1[(size_t)k * 128 + h]; }
        s = wave_sum(s);
        if (lane == 0) WSP(float, WS_B1P)[gw] = s + C.in[21][gw];
    }
    bf16* XN = WSP(bf16, WS_XN); bf16* PB = WSP(bf16, WS_PB);
    for (int m = gw; m < MP; m += NGW) {
        if (m < MTOT) {
            const float* xr = m < MPR ? C.in[0] + (size_t)m * DM : C.in[1] + (size_t)(m - MPR) * DM;
            rms_row_bf16(xr, C.in[10], XN + (size_t)m * DM, lane);
            const float* pr = m < MPR ? C.in[8] + (size_t)m * PLE : C.in[9] + (size_t)(m - MPR) * PLE;
            const f32x4 pv = *((const f32x4*)pr + lane); v2u o; o.x = cvtpk(pv[0], pv[1]); o.y = cvtpk(pv[2], pv[3]); *((v2u*)(PB + (size_t)m * PLE) + lane) = o;
        } else {
#pragma unroll
            for (int j = 0; j < 4; ++j) *((v2u*)(XN + (size_t)m * DM) + lane + 64 * j) = (v2u){0u, 0u};
            *((v2u*)(PB + (size_t)m * PLE) + lane) = (v2u){0u, 0u};
        }
    }
    for (int i = C.bid * 512 + C.tid; i < NSMP * DFF; i += C.G * 512) { const int b = i / DFF, c = i - b * DFF; C.out[O_CONV_S + (size_t)(b * 2) * DFF + c] = C.in[6][(size_t)(b * 2 + 1) * DFF + c]; }
}

DI void phase_chk_prompt(const Ctx& C) {
    const int gw = C.bid * 8 + C.wave, NGW = C.G * 8, lane = C.lane;
    const bf16* P = WSP(bf16, WS_PROJ); bf16* CHK = WSP(bf16, WS_CHK);
    const int tk = lane >> 4, ch = lane & 15, c = ch >> 3, d8 = (ch & 7) * 8;
    for (int r = gw; r < CHK_P; r += NGW) {
        const int b = r >> 11, g = (r >> 9) & 3, j = r & 511;
        const bf16* src = P + (size_t)(b * SEQ + 16 * j) * NPROJ + C_KC + g * 128 + ch * 8;
        bf16* dst = CHK + ((size_t)c * CHK_ROWS + CHK_S + r) * 1024 + d8;
#pragma unroll
        for (int i = 0; i < 4; ++i) { const int pos = 4 * i + tk; *(v4u*)(dst + pos * 64) = *(const v4u*)(src + (size_t)pos * NPROJ); }
    }
}

DI void phase_rownorm(const Ctx& C, const float* T, const float* xin_p, const float* xin_s, const float* g_post, const float* g_pre, float* xout, bf16* XN) {
    const int gw = C.bid * 8 + C.wave, NGW = C.G * 8, lane = C.lane;
    for (int m = gw; m < MTOT; m += NGW) {
        const f32x4* tr = (const f32x4*)(T + (size_t)m * DM) + lane;
        const f32x4* xr = (const f32x4*)(m < MPR ? xin_p + (size_t)m * DM : xin_s + (size_t)(m - MPR) * DM) + lane;
        f32x4 t[4], x[4]; float s = 0.f;
#pragma unroll
        for (int j = 0; j < 4; ++j) { t[j] = tr[64 * j]; x[j] = xr[64 * j]; s += (t[j][0] * t[j][0] + t[j][1] * t[j][1]) + (t[j][2] * t[j][2] + t[j][3] * t[j][3]); }
        const float r1 = rsqrtf(wave_sum(s) * (1.f / DM) + EPS); float s2 = 0.f;
#pragma unroll
        for (int j = 0; j < 4; ++j) { const f32x4 gp = *((const f32x4*)g_post + lane + 64 * j); x[j] = x[j] + t[j] * r1 * gp;
            s2 += (x[j][0] * x[j][0] + x[j][1] * x[j][1]) + (x[j][2] * x[j][2] + x[j][3] * x[j][3]); *((f32x4*)(xout + (size_t)m * DM) + lane + 64 * j) = x[j]; }
        const float r2 = rsqrtf(wave_sum(s2) * (1.f / DM) + EPS);
#pragma unroll
        for (int j = 0; j < 4; ++j) { const f32x4 gg = *((const f32x4*)g_pre + lane + 64 * j); v2u o; o.x = cvtpk(x[j][0] * r2 * gg[0], x[j][1] * r2 * gg[1]); o.y = cvtpk(x[j][2] * r2 * gg[2], x[j][3] * r2 * gg[3]);
            *((v2u*)(XN + (size_t)m * DM) + lane + 64 * j) = o; }
    }
}

DI void phase_conv(const Ctx& C) {
    const bf16* UP = WSP(bf16, WS_UP); bf16* H = WSP(bf16, WS_H);
    const float* cw = C.in[28]; const float* cb = C.in[29]; const float* st = C.in[6];
    constexpr int NV = DFF / 8;
    const int total = MTOT * NV;
    for (int i = C.bid * 512 + C.tid; i < total; i += C.G * 512) {
        const int row = i / NV, cv = (i - row * NV) * 8;
        const v4u a0 = *(const v4u*)(UP + (size_t)row * NUP + cv), gt = *(const v4u*)(UP + (size_t)row * NUP + DFF + cv);
        float am1[8], am2[8];
        if (row < MPR) {
            const int t = row & (SEQ - 1);
            v4u x1 = (v4u){0u, 0u, 0u, 0u}, x2 = x1;
            if (t >= 1) x1 = *(const v4u*)(UP + (size_t)(row - 1) * NUP + cv);
            if (t >= 2) x2 = *(const v4u*)(UP + (size_t)(row - 2) * NUP + cv);
#pragma unroll
            for (int e = 0; e < 4; ++e) { am1[2 * e] = bflo(x1[e]); am1[2 * e + 1] = bfhi(x1[e]); am2[2 * e] = bflo(x2[e]); am2[2 * e + 1] = bfhi(x2[e]); }
        } else {
            const int b = row - MPR;
#pragma unroll
            for (int e = 0; e < 8; ++e) { am2[e] = st[(size_t)(b * 2 + 0) * DFF + cv + e]; am1[e] = st[(size_t)(b * 2 + 1) * DFF + cv + e]; }
        }
        float r[8];
#pragma unroll
        for (int e = 0; e < 8; ++e) {
            const float a = (e & 1) ? bfhi(a0[e >> 1]) : bflo(a0[e >> 1]), g = (e & 1) ? bfhi(gt[e >> 1]) : bflo(gt[e >> 1]);
            const float cval = am2[e] * cw[cv + e] + am1[e] * cw[DFF + cv + e] + a * cw[2 * DFF + cv + e] + cb[cv + e];
            r[e] = gelu_tanh(cval) * g;
        }
        v4u o; o.x = cvtpk(r[0], r[1]); o.y = cvtpk(r[2], r[3]); o.z = cvtpk(r[4], r[5]); o.w = cvtpk(r[6], r[7]);
        *(v4u*)(H + (size_t)row * DFF + cv) = o;
    }
}

DI void phase_kvc(const Ctx& C) {
    const int gw = C.bid * 8 + C.wave, NGW = C.G * 8, lane = C.lane, r32 = lane & 31, hh = lane >> 5;
    const bf16* T = WSP(bf16, WS_T); bf16* KVC = WSP(bf16, WS_KVC); const bf16* W2T = WSP(bf16, WS_W2_T); const float* B1P = WSP(float, WS_B1P);
    constexpr int NT = CHK_ROWS / 32;
    for (int task = gw; task < 2 * NT; task += NGW) {
        const int c = task / NT, R0 = (task - c * NT) * 32;
        const bf16* Tc = T + (size_t)c * CHK_ROWS * 256; const bf16* w2 = W2T + (size_t)c * 64 * 128;
        f32x16 acc0 = {}, acc1 = {};
        const bf16* trow = Tc + (size_t)(R0 + r32) * 256;
        v4u ta[8], tb[8];
#pragma unroll
        for (int s = 0; s < 8; ++s) { const int k0 = 16 * s + 8 * hh; ta[s] = *(const v4u*)(trow + k0); tb[s] = *(const v4u*)(trow + 256 + 128 + k0); }
#pragma unroll
        for (int s = 0; s < 8; ++s) {
            const int k0 = 16 * s + 8 * hh;
            const f32x4 b0 = *(const f32x4*)(B1P + c * 128 + k0), b1 = *(const f32x4*)(B1P + c * 128 + k0 + 4);
            float hv[8];
#pragma unroll
            for (int e = 0; e < 4; ++e) { hv[2 * e] = bflo(ta[s][e]) + bflo(tb[s][e]); hv[2 * e + 1] = bfhi(ta[s][e]) + bfhi(tb[s][e]); }
#pragma unroll
            for (int e = 0; e < 8; ++e) hv[e] = gelu_tanh(hv[e] + (e < 4 ? b0[e] : b1[e - 4]));
            v4u ap; ap.x = cvtpk(hv[0], hv[1]); ap.y = cvtpk(hv[2], hv[3]); ap.z = cvtpk(hv[4], hv[5]); ap.w = cvtpk(hv[6], hv[7]);
            const bf16x8 hf = __builtin_bit_cast(bf16x8, ap);
            const bf16x8 bw0 = *(const bf16x8*)(w2 + (size_t)r32 * 128 + k0), bw1 = *(const bf16x8*)(w2 + (size_t)(32 + r32) * 128 + k0);
            acc0 = MFMA32(bw0, hf, acc0); acc1 = MFMA32(bw1, hf, acc1);
        }
        bf16* orow = KVC + ((size_t)c * CHK_ROWS + R0 + r32) * 64;
        const float* b2 = C.in[23] + c * 64;
#pragma unroll
        for (int dt = 0; dt < 2; ++dt)
#pragma unroll
            for (int m = 0; m < 4; ++m) { const int d = 32 * dt + 8 * m + 4 * hh; const f32x4 bb = *(const f32x4*)(b2 + d); const f32x16& a = dt ? acc1 : acc0;
                v2u o; o.x = cvtpk(a[4 * m] + bb[0], a[4 * m + 1] + bb[1]); o.y = cvtpk(a[4 * m + 2] + bb[2], a[4 * m + 3] + bb[3]); *(v2u*)(orow + d) = o; }
    }
}
constexpr int G_KHS = 272, G_VS = 528;
DI void load_v_tile(const Ctx& C, const bf16* P, int r0, int h, LAS unsigned char* VV) {
#pragma unroll
    for (int i = 0; i < 4; ++i) { const int idx = C.tid + 512 * i, row = idx >> 5, ch = idx & 31;
        *(LAS v4u*)(VV + row * G_VS + ch * 16) = *(const v4u*)(P + (size_t)(r0 + row) * NPROJ + C_GV + h * 256 + ch * 8); }
}
DI void phase_g1(const Ctx& C) {
    const bf16* P = WSP(bf16, WS_PROJ); bf16* QT = WSP(bf16, WS_QT); bf16* KT = WSP(bf16, WS_KT); bf16* UT = WSP(bf16, WS_UT); float* DL = WSP(float, WS_DL);
    const float* wup = C.in[16]; const float* bgate = C.in[17];
    LAS float* LA = (LAS float*)C.lds;
    LAS float* GA = (LAS float*)(C.lds + 32768);
    LAS float* WU = (LAS float*)(C.lds + 36864);
    LAS unsigned char* KH = C.lds + 45056;
    LAS unsigned char* VV = C.lds + 62464;
    const int tid = C.tid, lane = C.lane, w = C.wave;
    for (int unit = C.bid; unit < NCHUNK * 4; unit += C.G) {
        const int ci = unit >> 2, h = unit & 3, r0 = 64 * ci;
        { const int t = tid >> 3, pr = tid & 7; const unsigned g2 = *(const unsigned*)(P + (size_t)(r0 + t) * NPROJ + C_GA + 2 * pr); GA[t * 16 + 2 * pr] = bflo(g2); GA[t * 16 + 2 * pr + 1] = bfhi(g2);
          const int idx = tid * 4, r = idx >> 7, dk = idx & 127; *(LAS f32x4*)(WU + idx) = *(const f32x4*)(wup + (size_t)r * 512 + h * 128 + dk); }
        load_v_tile(C, P, r0, h, VV);
        __syncthreads();
        { const int dk = tid & 127, tq = tid >> 7; float wc[16];
#pragma unroll
          for (int r = 0; r < 16; ++r) wc[r] = WU[r * 128 + dk];
          const float bias = bgate[h * 128 + dk];
          for (int i = 0; i < 16; ++i) { const int t = tq * 16 + i; float x = bias;
#pragma unroll
              for (int r = 0; r < 16; ++r) x += GA[t * 16 + r] * wc[r];
              LA[t * 128 + dk] = logsigf_(x) * (1.0f / 16.0f); } }
        __syncthreads();
        if (tid < 128) { float run = 0.f; for (int t = 0; t < 64; ++t) { run += LA[t * 128 + tid]; LA[t * 128 + tid] = run; } }
        __syncthreads();
        { const int t = tid >> 3, dk0 = (tid & 7) * 16; const size_t prow = (size_t)(r0 + t) * NPROJ;
#pragma unroll
          for (int hf = 0; hf < 2; ++hf) {
              const int dk = dk0 + 8 * hf;
              const v4u qv = *(const v4u*)(P + prow + C_GQ + h * 128 + dk), kv = *(const v4u*)(P + prow + C_GK + h * 128 + dk);
              float qo[8], ko[8], kh[8];
#pragma unroll
              for (int e = 0; e < 8; ++e) {
                  const float q = (e & 1) ? bfhi(qv[e >> 1]) : bflo(qv[e >> 1]), k = (e & 1) ? bfhi(kv[e >> 1]) : bflo(kv[e >> 1]);
                  const float b = LA[t * 128 + dk + e], bl = LA[63 * 128 + dk + e];
                  qo[e] = q * GLA_QS * __expf(b); ko[e] = k * __expf(-b); kh[e] = k * __expf(bl - b);
              }
              v4u o; o.x = cvtpk(qo[0], qo[1]); o.y = cvtpk(qo[2], qo[3]); o.z = cvtpk(qo[4], qo[5]); o.w = cvtpk(qo[6], qo[7]);
              *(v4u*)(QT + (size_t)(r0 + t) * 512 + h * 128 + dk) = o;
              o.x = cvtpk(ko[0], ko[1]); o.y = cvtpk(ko[2], ko[3]); o.z = cvtpk(ko[4], ko[5]); o.w = cvtpk(ko[6], ko[7]);
              *(v4u*)(KT + (size_t)(r0 + t) * 512 + h * 128 + dk) = o;
              o.x = cvtpk(kh[0], kh[1]); o.y = cvtpk(kh[2], kh[3]); o.z = cvtpk(kh[4], kh[5]); o.w = cvtpk(kh[6], kh[7]);
              *(LAS v4u*)(KH + t * G_KHS + dk * 2) = o;
          }
          if (tid < 128) DL[(size_t)unit * 128 + tid] = __expf(LA[63 * 128 + tid]); }
        __syncthreads();
        {
            f32x16 acc[4] = {};
#pragma unroll
            for (int s = 0; s < 4; ++s) {
                const bf16x8 vf = tr_frag(VV, G_VS, 16 * s, 32 * w, lane);
#pragma unroll
                for (int nt = 0; nt < 4; ++nt) { const bf16x8 kf = tr_frag(KH, G_KHS, 16 * s, 32 * nt, lane); acc[nt] = MFMA32(kf, vf, acc[nt]); }
            }
            const int r32 = lane & 31, hh = lane >> 5;
            bf16* ub = UT + ((size_t)unit * 256 + 32 * w + r32) * 128;
#pragma unroll
            for (int nt = 0; nt < 4; ++nt)
#pragma unroll
                for (int m = 0; m < 4; ++m) { v2u o; o.x = cvtpk(acc[nt][4 * m], acc[nt][4 * m + 1]); o.y = cvtpk(acc[nt][4 * m + 2], acc[nt][4 * m + 3]); *(v2u*)(ub + 32 * nt + 8 * m + 4 * hh) = o; }
        }
        __syncthreads();
    }
}
DI void phase_g2(const Ctx& C) {
    const bf16* __restrict__ UT = WSP(bf16, WS_UT); bf16* __restrict__ ST = WSP(bf16, WS_ST); const float* __restrict__ DL = WSP(float, WS_DL);
    for (int gid = C.bid * 512 + C.tid; gid < 8 * 256 * 64; gid += C.G * 512) {
        const int bh = gid >> 14, rem = gid & 16383, dv = rem >> 6, dk = (rem & 63) * 2, b = bh >> 2, h = bh & 3;
        float s0 = 0.f, s1 = 0.f;
#pragma unroll 8
        for (int c = 0; c < 128; ++c) {
            const size_t un = (size_t)((b * 128 + c) * 4 + h); const size_t idx = (un * 256 + dv) * 128 + dk;
            const unsigned u = *(const unsigned*)(UT + idx); const f32x2 d = *(const f32x2*)(DL + un * 128 + dk);
            *(unsigned*)(ST + idx) = cvtpk(s0, s1);
            s0 = d[0] * s0 + bflo(u); s1 = d[1] * s1 + bfhi(u);
        }
        float* o = C.out + O_GLA_P + ((size_t)(bh * 128 + dk)) * 256 + dv; o[0] = s0; o[256] = s1;
    }
}
DI void phase_g3(const Ctx& C) {
    const bf16* P = WSP(bf16, WS_PROJ); const bf16* QT = WSP(bf16, WS_QT); const bf16* KT = WSP(bf16, WS_KT); const bf16* ST = WSP(bf16, WS_ST); bf16* OG = WSP(bf16, WS_OG);
    const float* gnorm = C.in[18];
    LAS unsigned char* VV = C.lds; LAS float* RED = (LAS float*)(C.lds + 34816);
    const int lane = C.lane, w = C.wave, r32 = lane & 31, hh = lane >> 5;
    for (int unit = C.bid; unit < NCHUNK * 4; unit += C.G) {
        const int ci = unit >> 2, h = unit & 3, r0 = 64 * ci, dv0 = 32 * w;
        load_v_tile(C, P, r0, h, VV);
        __syncthreads();
        f32x16 o[2];
#pragma unroll
        for (int ti = 0; ti < 2; ++ti) {
            const int tt = 32 * ti + r32;
            bf16x8 qf[8];
#pragma unroll
            for (int s = 0; s < 8; ++s) qf[s] = *(const bf16x8*)(QT + (size_t)(r0 + tt) * 512 + h * 128 + 16 * s + 8 * hh);
            f32x16 acc = {};
            const bf16* srow = ST + ((size_t)unit * 256 + dv0 + r32) * 128 + 8 * hh;
#pragma unroll
            for (int s = 0; s < 8; ++s) { const bf16x8 af = *(const bf16x8*)(srow + 16 * s); acc = MFMA32(af, qf[s], acc); }
#pragma unroll
            for (int si = 0; si <= ti; ++si) {
                f32x16 X = {};
                const bf16* krow = KT + (size_t)(r0 + 32 * si + r32) * 512 + h * 128 + 8 * hh;
#pragma unroll
                for (int s = 0; s < 8; ++s) { const bf16x8 kf = *(const bf16x8*)(krow + 16 * s); X = MFMA32(kf, qf[s], X); }
                if (si == ti) {
#pragma unroll
                    for (int r = 0; r < 16; ++r) if (crow(r, hh) > r32) X[r] = 0.f;
                }
#pragma unroll
                for (int s2 = 0; s2 < 2; ++s2) { const bf16x8 pb = pack_acc(X, s2); const bf16x8 af = tr_frag_acc(VV, G_VS, 32 * si + 16 * s2, dv0, lane); acc = MFMA32(af, pb, acc); }
            }
            o[ti] = acc;
        }
#pragma unroll
        for (int ti = 0; ti < 2; ++ti) { float ss = 0.f;
#pragma unroll
            for (int r = 0; r < 16; ++r) ss += o[ti][r] * o[ti][r];
            ss += __shfl_xor(ss, 32); if (hh == 0) RED[w * 64 + 32 * ti + r32] = ss; }
        __syncthreads();
#pragma unroll
        for (int ti = 0; ti < 2; ++ti) {
            const int tt = 32 * ti + r32; float tot = 0.f;
#pragma unroll
            for (int ww = 0; ww < 8; ++ww) tot += RED[ww * 64 + tt];
            const float rstd = rsqrtf(tot * (1.f / 256.f) + EPS);
            const size_t prow = (size_t)(r0 + tt) * NPROJ + C_GR + h * 256; bf16* orow = OG + (size_t)(r0 + tt) * DM + h * 256;
#pragma unroll
            for (int m = 0; m < 4; ++m) { const int dv = dv0 + 8 * m + 4 * hh;
                const v2u gr = *(const v2u*)(P + prow + dv); const f32x4 gn = *(const f32x4*)(gnorm + h * 256 + dv);
                const float a0 = o[ti][4 * m] * rstd * gn[0] * siluf_(bflo(gr[0])), a1 = o[ti][4 * m + 1] * rstd * gn[1] * siluf_(bfhi(gr[0]));
                const float a2 = o[ti][4 * m + 2] * rstd * gn[2] * siluf_(bflo(gr[1])), a3 = o[ti][4 * m + 3] * rstd * gn[3] * siluf_(bfhi(gr[1]));
                v2u ov; ov.x = cvtpk(a0, a1); ov.y = cvtpk(a2, a3); *(v2u*)(orow + dv) = ov; }
        }
        __syncthreads();
    }
}
DI void phase_gla_sample(const Ctx& C) {
    const bf16* P = WSP(bf16, WS_PROJ); bf16* OG = WSP(bf16, WS_OG);
    const float* wup = C.in[16]; const float* bgate = C.in[17]; const float* gnorm = C.in[18]; const float* S0 = C.in[5];
    LAS float* QS = (LAS float*)C.lds; LAS float* KS = QS + 128; LAS float* AS = KS + 128; LAS float* GAs = AS + 128; LAS float* PART = GAs + 16; LAS float* RED = PART + 8 * 256;
    const int tid = C.tid, lane = C.lane, w = C.wave;
    for (int unit = C.bid; unit < NSMP * 4; unit += C.G) {
        const int b = unit >> 2, h = unit & 3; const size_t prow = (size_t)(MPR + b) * NPROJ;
        if (tid < 16) GAs[tid] = bf2f(P[prow + C_GA + tid]);
        __syncthreads();
        if (tid < 128) { float x = bgate[h * 128 + tid];
#pragma unroll
            for (int r = 0; r < 16; ++r) x += GAs[r] * wup[(size_t)r * 512 + h * 128 + tid];
            AS[tid] = __expf(logsigf_(x) * (1.f / 16.f)); QS[tid] = bf2f(P[prow + C_GQ + h * 128 + tid]) * GLA_QS; KS[tid] = bf2f(P[prow + C_GK + h * 128 + tid]); }
        __syncthreads();
        const int dv = 4 * lane, dk0 = 16 * w;
        const v2u vv = *(const v2u*)(P + prow + C_GV + h * 256 + dv); const f32x4 v = {bflo(vv[0]), bfhi(vv[0]), bflo(vv[1]), bfhi(vv[1])};
        const float* s0 = S0 + ((size_t)unit * 128 + dk0) * 256 + dv; float* so = C.out + O_GLA_S + ((size_t)unit * 128 + dk0) * 256 + dv;
        f32x4 sv[16];
#pragma unroll
        for (int i = 0; i < 16; ++i) sv[i] = *(const f32x4*)(s0 + (size_t)i * 256);
        f32x4 o = {0.f, 0.f, 0.f, 0.f};
#pragma unroll
        for (int i = 0; i < 16; ++i) { const f32x4 s = sv[i] * AS[dk0 + i] + v * KS[dk0 + i]; *(f32x4*)(so + (size_t)i * 256) = s; o += s * QS[dk0 + i]; }
        *(LAS f32x4*)(PART + w * 256 + dv) = o;
        __syncthreads();
        float ov = 0.f, ss = 0.f;
        if (tid < 256) {
#pragma unroll
            for (int ww = 0; ww < 8; ++ww) ov += PART[ww * 256 + tid];
            ss = ov * ov; }
        ss = wave_sum(ss); if (lane == 0) RED[w] = ss;
        __syncthreads();
        if (tid < 256) { const float tot = RED[0] + RED[1] + RED[2] + RED[3]; const float rstd = rsqrtf(tot * (1.f / 256.f) + EPS);
            const float val = ov * rstd * gnorm[h * 256 + tid] * siluf_(bf2f(P[prow + C_GR + h * 256 + tid]));
            OG[(size_t)(MPR + b) * DM + h * 256 + tid] = (bf16)(cvtpk(val, 0.f) & 0xffffu); }
        __syncthreads();
    }
}
constexpr int KSTR = 144;
constexpr int KV_TILE = 64 * KSTR;
DI void qk_tile(const LAS unsigned char* Kt, const bf16x8 (&qf)[4], int r32, int hh, f32x16& p0, f32x16& p1) {
    p0 = (f32x16){}; p1 = (f32x16){};
#pragma unroll
    for (int s = 0; s < 4; ++s) {
        const bf16x8 a0 = *(const LAS bf16x8*)(Kt + r32 * KSTR + 32 * s + 16 * hh), a1 = *(const LAS bf16x8*)(Kt + (32 + r32) * KSTR + 32 * s + 16 * hh);
        p0 = MFMA32(a0, qf[s], p0); p1 = MFMA32(a1, qf[s], p1);
    }
}
DI void qk_tile_c(const LAS unsigned char* Kt, const bf16x8 (&qf)[4], const f32x16& cin, int r32, int hh, f32x16& p0, f32x16& p1) {
#pragma unroll
    for (int s = 0; s < 4; ++s) {
        const bf16x8 a0 = *(const LAS bf16x8*)(Kt + r32 * KSTR + 32 * s + 16 * hh), a1 = *(const LAS bf16x8*)(Kt + (32 + r32) * KSTR + 32 * s + 16 * hh);
        if (s == 0) { p0 = MFMA32(a0, qf[0], cin); p1 = MFMA32(a1, qf[0], cin); } else { p0 = MFMA32(a0, qf[s], p0); p1 = MFMA32(a1, qf[s], p1); }
    }
}
DI f32x16 splat16(float v) { f32x16 r;
#pragma unroll
    for (int i = 0; i < 16; ++i) r[i] = v;
    return r; }
DI void pv_tile(const LAS unsigned char* Vt, const f32x16& p0, const f32x16& p1, f32x16& o0, f32x16& o1, int lane) {
#pragma unroll
    for (int kh = 0; kh < 2; ++kh)
#pragma unroll
        for (int s2 = 0; s2 < 2; ++s2) {
            const bf16x8 pb = pack_acc(kh ? p1 : p0, s2);
            const bf16x8 a0 = tr_frag_acc(Vt, KSTR, 32 * kh + 16 * s2, 0, lane), a1 = tr_frag_acc(Vt, KSTR, 32 * kh + 16 * s2, 32, lane);
            o0 = MFMA32(a0, pb, o0); o1 = MFMA32(a1, pb, o1);
        }
}
DI float max32(const f32x16& p0, const f32x16& p1) {
    float m = fmaxf(p0[0], p1[0]);
#pragma unroll
    for (int r = 1; r < 16; ++r) m = fmaxf(m, fmaxf(p0[r], p1[r]));
    return fmaxf(m, __shfl_xor(m, 32));
}
DI v4u ld_tile_row(const bf16* base, size_t pitch, int row0, int tid) { return *(const v4u*)(base + (size_t)(row0 + (tid >> 3)) * pitch + (tid & 7) * 8); }
DI void st_tile_row(LAS unsigned char* T, int tid, v4u v) { *(LAS v4u*)(T + (tid >> 3) * KSTR + (tid & 7) * 16) = v; }

DI bool attn_order(const Ctx& C, int i, int& bg, int& qt) {
    if (C.G == 256) { if (i >= 4) return false; const int s = C.bid & 31; bg = C.bid >> 5; qt = (i == 0) ? s : (i == 1) ? 63 - s : (i == 2) ? 64 + s : 127 - s; return true; }
    const int u = C.bid + i * C.G; if (u >= 1024) return false; bg = u >> 7; qt = u & 127; return true;
}

template <int MODE> DI void phase_attn_sw(const Ctx& C) {
    const bf16* P = WSP(bf16, WS_PROJ); const unsigned* SEL = WSP(unsigned, WS_SEL);
    const bf16* OC = WSP(bf16, WS_OC); const bf16* OWr = WSP(bf16, WS_OW); bf16* OUT = MODE == 1 ? WSP(bf16, WS_ONSA) : WSP(bf16, WS_OW);
    const int tid = C.tid, lane = C.lane, w = C.wave, r32 = lane & 31, hh = lane >> 5;
    LAS unsigned char* Kb = C.lds; LAS unsigned char* Vb = C.lds + 2 * KV_TILE;
    int bg, qt;
    for (int it = 0; attn_order(C, it, bg, qt); ++it) {
        const int b = bg >> 2, g = bg & 3, t0 = 64 * qt, tl = 8 * w + (r32 >> 2), t = t0 + tl, head = 4 * g + (r32 & 3);
        const size_t rowb = (size_t)b * SEQ; const size_t qrow = (rowb + t) * NPROJ;
        const bf16* Kp = P + rowb * NPROJ + (MODE == 1 ? C_KS : C_KW) + g * 128; const bf16* Vp = Kp + 64;
        bf16x8 qf[4];
#pragma unroll
        for (int s = 0; s < 4; ++s) qf[s] = *(const bf16x8*)(P + qrow + C_NQ + head * 64 + 16 * s + 8 * hh);
        v4u selw = (v4u){0u, 0u, 0u, 0u};
        if (MODE == 1) selw = *(const v4u*)(SEL + ((size_t)bg * SEQ + t) * 4);
        const int ntile = MODE == 1 ? qt + 1 : (qt >= 8 ? 9 : qt + 1);
#define KT_OF(i) (MODE == 1 ? (i) : qt - (i))
        float mref = 0.f, l = 0.f; f32x16 o0 = {}, o1 = {}; f32x16 negm = {};
        v4u kreg = ld_tile_row(Kp, NPROJ, 64 * KT_OF(0), tid), vreg = ld_tile_row(Vp, NPROJ, 64 * KT_OF(0), tid);
        st_tile_row(Kb, tid, kreg); st_tile_row(Vb, tid, vreg);
        __syncthreads();
        for (int i = 0; i < ntile; ++i) {
            const int kt = KT_OF(i), cur = i & 1;
            if (i + 1 < ntile) { kreg = ld_tile_row(Kp, NPROJ, 64 * KT_OF(i + 1), tid); vreg = ld_tile_row(Vp, NPROJ, 64 * KT_OF(i + 1), tid); }
            bool rowsel = true;
            if (MODE == 1) { const unsigned wsel = (kt < 32) ? selw[0] : (kt < 64) ? selw[1] : (kt < 96) ? selw[2] : selw[3]; rowsel = ((wsel >> (kt & 31)) & 1u) != 0u; }
            if (MODE != 1 || __any(rowsel)) {
                f32x16 cin = negm;
                if (MODE == 1) {
#pragma unroll
                    for (int r = 0; r < 16; ++r) cin[r] = rowsel ? negm[r] : -INFINITY;
                }
                f32x16 p0, p1;
                qk_tile_c(Kb + cur * KV_TILE, qf, cin, r32, hh, p0, p1);
#define SW_MASK() do { \
                if (kt == qt) { _Pragma("unroll") for (int r = 0; r < 16; ++r) { const int kl = crow(r, hh); if (kl > tl) p0[r] = -INFINITY; if (kl + 32 > tl) p1[r] = -INFINITY; } } \
                if (MODE == 2 && kt == qt - 8) { _Pragma("unroll") for (int r = 0; r < 16; ++r) { const int kl = crow(r, hh); if (kl <= tl) p0[r] = -INFINITY; if (kl + 32 <= tl) p1[r] = -INFINITY; } } } while (0)
                SW_MASK();
                if (i == 0) {
                    const float mt = max32(p0, p1); mref = (mt == -INFINITY) ? 0.f : mt; negm = splat16(-mref);
#pragma unroll
                    for (int r = 0; r < 16; ++r) { p0[r] -= mref; p1[r] -= mref; }
                }
                float rs = 0.f;
#pragma unroll
                for (int r = 0; r < 16; ++r) { p0[r] = __builtin_amdgcn_exp2f(p0[r]); p1[r] = __builtin_amdgcn_exp2f(p1[r]); rs += p0[r] + p1[r]; }
                if (__builtin_expect(__any(!(rs < 3.0e38f)), 0)) {
                    f32x16 craw;
#pragma unroll
                    for (int r = 0; r < 16; ++r) craw[r] = rowsel ? 0.f : -INFINITY;
                    qk_tile_c(Kb + cur * KV_TILE, qf, craw, r32, hh, p0, p1);
                    SW_MASK();
                    const float mt = max32(p0, p1), mn = fmaxf(mref, mt), alpha = __builtin_amdgcn_exp2f(mref - mn);
                    l *= alpha;
#pragma unroll
                    for (int r = 0; r < 16; ++r) { o0[r] *= alpha; o1[r] *= alpha; }
                    mref = mn; negm = splat16(-mref); rs = 0.f;
#pragma unroll
                    for (int r = 0; r < 16; ++r) { p0[r] = __builtin_amdgcn_exp2f(p0[r] - mn); p1[r] = __builtin_amdgcn_exp2f(p1[r] - mn); rs += p0[r] + p1[r]; }
                }
#undef SW_MASK
                l += rs;
                pv_tile(Vb + cur * KV_TILE, p0, p1, o0, o1, lane);
            }
            if (i + 1 < ntile) { st_tile_row(Kb + (cur ^ 1) * KV_TILE, tid, kreg); st_tile_row(Vb + (cur ^ 1) * KV_TILE, tid, vreg); }
            __syncthreads();
        }
#undef KT_OF
        const float lt = l + __shfl_xor(l, 32), inv = lt > 0.f ? 1.f / lt : 0.f;
        const float gate = sigmoidf_(bf2f(P[qrow + C_NG + head * 3 + (MODE == 1 ? 1 : 2)])) * inv;
        const size_t ooff = (rowb + t) * DM + head * 64;
#pragma unroll
        for (int dt = 0; dt < 2; ++dt)
#pragma unroll
            for (int mq = 0; mq < 4; ++mq) {
                const int d = 32 * dt + 8 * mq + 4 * hh; const f32x16& o = dt ? o1 : o0;
                float a0 = o[4 * mq] * gate, a1 = o[4 * mq + 1] * gate, a2 = o[4 * mq + 2] * gate, a3 = o[4 * mq + 3] * gate;
                if (MODE == 1) { const v2u c = *(const v2u*)(OC + ooff + d), ww = *(const v2u*)(OWr + ooff + d);
                    a0 += bflo(c[0]) + bflo(ww[0]); a1 += bfhi(c[0]) + bfhi(ww[0]); a2 += bflo(c[1]) + bflo(ww[1]); a3 += bfhi(c[1]) + bfhi(ww[1]); }
                v2u ov; ov.x = cvtpk(a0, a1); ov.y = cvtpk(a2, a3); *(v2u*)(OUT + ooff + d) = ov;
            }
    }
}

DI unsigned topk_select(const LAS float* IMP, int lane, int cur) {
    const int tlw = lane >> 3, sub = lane & 7;
    unsigned key[16]; unsigned fb = 0u;
#pragma unroll
    for (int i = 0; i < 16; ++i) { const int j = 16 * sub + i; const bool forced = (j == 0) || (j == cur) || (j == cur - 1); const bool cand = (j <= cur) && !forced;
        key[i] = cand ? (__float_as_uint(fmaxf(IMP[tlw * 128 + j], 0.f)) + 1u) : 0u; if (forced && j <= cur) fb |= 1u << i; }
    const int nforced = cur == 0 ? 1 : (cur == 1 ? 2 : 3), krem = 16 - nforced;
    unsigned T = 0u;
    for (int bit = 30; bit >= 0; --bit) { const unsigned Tn = T | (1u << bit); int cnt = 0;
#pragma unroll
        for (int i = 0; i < 16; ++i) cnt += (key[i] >= Tn) ? 1 : 0;
        cnt = sum8_i(cnt); if (cnt >= krem) T = Tn; }
    unsigned bits = 0u;
    if (T == 0u) {
#pragma unroll
        for (int i = 0; i < 16; ++i) bits |= (key[i] >= 1u ? 1u : 0u) << i;
    } else {
        int ngt = 0, neq = 0;
#pragma unroll
        for (int i = 0; i < 16; ++i) { ngt += (key[i] > T) ? 1 : 0; neq += (key[i] == T) ? 1 : 0; }
        const int need = krem - sum8_i(ngt);
        int run = 0;
#pragma unroll
        for (int s = 0; s < 8; ++s) { const int c = __shfl(neq, (lane & ~7) + s); if (s < sub) run += c; }
#pragma unroll
        for (int i = 0; i < 16; ++i) { if (key[i] > T) bits |= 1u << i; else if (key[i] == T) { if (run < need) bits |= 1u << i; ++run; } }
    }
    return bits | fb;
}

DI void phase_attn_cmp(const Ctx& C) {
    const bf16* P = WSP(bf16, WS_PROJ); unsigned* SEL = WSP(unsigned, WS_SEL); bf16* OC = WSP(bf16, WS_OC);
    const bf16* KVC = WSP(bf16, WS_KVC);
    const int tid = C.tid, lane = C.lane, w = C.wave, r32 = lane & 31, hh = lane >> 5;
    LAS unsigned char* Kb = C.lds; LAS unsigned char* Vb = C.lds + 2 * KV_TILE;
    LAS float* PS = (LAS float*)(C.lds + 4 * KV_TILE + w * 6400);
    LAS float* IMP = PS + 8 * 66 + 8;
    int bg, qt;
    for (int it = 0; attn_order(C, it, bg, qt); ++it) {
        const int b = bg >> 2, g = bg & 3, t0 = 64 * qt, tl = 8 * w + (r32 >> 2), t = t0 + tl, head = 4 * g + (r32 & 3);
        const size_t rowb = (size_t)b * SEQ; const size_t qrow = (rowb + t) * NPROJ;
        const bf16* Kp = KVC + ((size_t)CHK_S + (size_t)bg * 512) * 64; const bf16* Vp = Kp + (size_t)CHK_ROWS * 64;
        bf16x8 qf[4];
#pragma unroll
        for (int s = 0; s < 4; ++s) qf[s] = *(const bf16x8*)(P + qrow + C_NQ + head * 64 + 16 * s + 8 * hh);
        const int ntiles = (((t0 + 32) >> 4) >> 6) + 1;
        const int nmax = t >= 31 ? ((t - 31) >> 4) : -1;
        for (int i = lane; i < 8 * 128; i += 64) IMP[i] = 0.f;
        if (lane < 8) PS[lane * 66] = 0.f;
        const int tw0 = t0 + 8 * w; const int nmax_w = tw0 >= 31 ? ((tw0 - 31) >> 4) : -1;
#define CMP_MASK() do { if (64 * kt + 63 > nmax_w) { _Pragma("unroll") for (int r = 0; r < 16; ++r) { const int n = 64 * kt + crow(r, hh); if (n > nmax) p0[r] = -INFINITY; if (n + 32 > nmax) p1[r] = -INFINITY; } } } while (0)
        float mref = 0.f, l = 0.f; f32x16 negm = {};
        v4u kreg = ld_tile_row(Kp, 64, 0, tid), vreg;
        st_tile_row(Kb, tid, kreg);
        __syncthreads();
        for (int kt = 0; kt < ntiles; ++kt) {
            const int cur = kt & 1;
            if (kt + 1 < ntiles) kreg = ld_tile_row(Kp, 64, 64 * (kt + 1), tid);
            f32x16 p0, p1;
            qk_tile_c(Kb + cur * KV_TILE, qf, negm, r32, hh, p0, p1);
            CMP_MASK();
            if (kt == 0) { const float mt = max32(p0, p1); mref = (mt == -INFINITY) ? 0.f : mt; negm = splat16(-mref);
#pragma unroll
                for (int r = 0; r < 16; ++r) { p0[r] -= mref; p1[r] -= mref; } }
            float rs = 0.f;
#pragma unroll
            for (int r = 0; r < 16; ++r) rs += __builtin_amdgcn_exp2f(p0[r]) + __builtin_amdgcn_exp2f(p1[r]);
            if (__builtin_expect(__any(!(rs < 3.0e38f)), 0)) {
                const f32x16 zero16 = {};
                qk_tile_c(Kb + cur * KV_TILE, qf, zero16, r32, hh, p0, p1);
                CMP_MASK();
                const float mt = max32(p0, p1), mn = fmaxf(mref, mt); l *= __builtin_amdgcn_exp2f(mref - mn); mref = mn; negm = splat16(-mref); rs = 0.f;
#pragma unroll
                for (int r = 0; r < 16; ++r) rs += __builtin_amdgcn_exp2f(p0[r] - mn) + __builtin_amdgcn_exp2f(p1[r] - mn);
            }
            l += rs;
            if (kt + 1 < ntiles) st_tile_row(Kb + (cur ^ 1) * KV_TILE, tid, kreg);
            __syncthreads();
        }
        const float lt = l + __shfl_xor(l, 32), inv = lt > 0.f ? 1.f / lt : 0.f;
        f32x16 o0 = {}, o1 = {};
        kreg = ld_tile_row(Kp, 64, 0, tid); vreg = ld_tile_row(Vp, 64, 0, tid);
        st_tile_row(Kb, tid, kreg); st_tile_row(Vb, tid, vreg);
        __syncthreads();
        for (int kt = 0; kt < ntiles; ++kt) {
            const int cur = kt & 1;
            if (kt + 1 < ntiles) { kreg = ld_tile_row(Kp, 64, 64 * (kt + 1), tid); vreg = ld_tile_row(Vp, 64, 64 * (kt + 1), tid); }
            f32x16 p0, p1;
            qk_tile_c(Kb + cur * KV_TILE, qf, negm, r32, hh, p0, p1);
            CMP_MASK();
#pragma unroll
            for (int r = 0; r < 16; ++r) { p0[r] = __builtin_amdgcn_exp2f(p0[r]) * inv; p1[r] = __builtin_amdgcn_exp2f(p1[r]) * inv; }
            pv_tile(Vb + cur * KV_TILE, p0, p1, o0, o1, lane);
#pragma unroll
            for (int r = 0; r < 16; ++r) { const float s0 = quad_sum(p0[r]), s1 = quad_sum(p1[r]);
                if ((r32 & 3) == 0) { PS[(r32 >> 2) * 66 + 1 + crow(r, hh)] = s0; PS[(r32 >> 2) * 66 + 33 + crow(r, hh)] = s1; } }
            LDS_WAIT();
            { const int tk = lane >> 3, j0 = (lane & 7) * 2;
#pragma unroll
              for (int e = 0; e < 2; ++e) { const LAS float* ps = PS + tk * 66 + 1 + 4 * (j0 + e);
                  IMP[tk * 128 + 16 * kt + j0 + e] = ps[-1] + 2.f * (ps[0] + ps[1] + ps[2]) + ps[3]; } }
            LDS_WAIT();
            if (lane < 8) PS[lane * 66] = PS[lane * 66 + 64];
            LDS_WAIT();
            if (kt + 1 < ntiles) { st_tile_row(Kb + (cur ^ 1) * KV_TILE, tid, kreg); st_tile_row(Vb + (cur ^ 1) * KV_TILE, tid, vreg); }
            __syncthreads();
        }
#undef CMP_MASK
        {
            const float gate = sigmoidf_(bf2f(P[qrow + C_NG + head * 3 + 0]));
            const size_t ooff = (rowb + t) * DM + head * 64;
#pragma unroll
            for (int dt = 0; dt < 2; ++dt)
#pragma unroll
                for (int mq = 0; mq < 4; ++mq) { const int d = 32 * dt + 8 * mq + 4 * hh; const f32x16& o = dt ? o1 : o0;
                    v2u ov; ov.x = cvtpk(o[4 * mq] * gate, o[4 * mq + 1] * gate); ov.y = cvtpk(o[4 * mq + 2] * gate, o[4 * mq + 3] * gate); *(v2u*)(OC + ooff + d) = ov; }
        }
        {
            const int sub = lane & 7, tk = lane >> 3;
            const unsigned bits = topk_select(IMP, lane, qt);
            unsigned wv = bits << (16 * (sub & 1)); wv |= (unsigned)dpp_i<0xB1>((int)wv);
            if ((sub & 1) == 0) SEL[((size_t)bg * SEQ + t0 + 8 * w + tk) * 4 + (sub >> 1)] = wv;
        }
        __syncthreads();
    }
}

DI f32x4 ld_bf4(const bf16* p) { const v2u v = *(const v2u*)p; return (f32x4){bflo(v[0]), bfhi(v[0]), bflo(v[1]), bfhi(v[1])}; }
template <int MODE> DI f32x4 smp_load(const Ctx& C, int b, int g, int n, int c, int i, const LAS long* koff) {
    if (MODE == 0) return ld_bf4(WSP(bf16, WS_KVC) + ((size_t)c * CHK_ROWS + (size_t)(b * 4 + g) * 512 + n) * 64 + 4 * i);
    if (MODE == 1) return *(const f32x4*)(C.in[3] + koff[n >> 6] + (size_t)(n & 63) * 512 + c * 64 + 4 * i);
    return *(const f32x4*)(C.in[4] + ((size_t)(b * 512 + n)) * 512 + g * 128 + c * 64 + 4 * i);
}
template <int MODE> DI void smp_branch(const Ctx& C, int b, int g, const f32x4 (&qv)[4], LAS float* SC, LAS float* RED, const LAS long* koff, float& fin) {
    constexpr int NMAIN = MODE == 0 ? 511 : MODE == 1 ? 960 : 512, N = MODE == 0 ? NMAIN : NMAIN + 1;
    const int tid = C.tid, i = tid & 15, grp = tid >> 4, lane = C.lane, w = C.wave;
    const bf16* newrow = WSP(bf16, WS_PROJ) + (size_t)(MPR + b) * NPROJ + (MODE == 1 ? C_KS : C_KW) + g * 128 + 4 * i;
    for (int n0 = grp; n0 < NMAIN; n0 += 256) {
        f32x4 kv[8];
#pragma unroll
        for (int u = 0; u < 8; ++u) { const int n = n0 + 32 * u; kv[u] = smp_load<MODE>(C, b, g, n < NMAIN ? n : NMAIN - 1, 0, i, koff); }
#pragma unroll
        for (int u = 0; u < 8; ++u) {
            const int n = n0 + 32 * u;
            float part[4];
#pragma unroll
            for (int h = 0; h < 4; ++h) part[h] = sum16_f(qv[h][0] * kv[u][0] + qv[h][1] * kv[u][1] + qv[h][2] * kv[u][2] + qv[h][3] * kv[u][3]);
            if (i == 0 && n < NMAIN) { const bool ok = MODE == 2 ? n >= 1 : true;
#pragma unroll
                for (int h = 0; h < 4; ++h) SC[h * 1056 + n] = ok ? part[h] : -INFINITY; }
        }
    }
    if (MODE != 0) { const f32x4 kx = ld_bf4(newrow);
        float part[4];
#pragma unroll
        for (int h = 0; h < 4; ++h) part[h] = sum16_f(qv[h][0] * kx[0] + qv[h][1] * kx[1] + qv[h][2] * kx[2] + qv[h][3] * kx[3]);
        if (tid == 0) {
#pragma unroll
            for (int h = 0; h < 4; ++h) SC[h * 1056 + NMAIN] = part[h]; } }
    __syncthreads();
    if (w < 4) {
        float m = -INFINITY;
        for (int n = lane; n < N; n += 64) m = fmaxf(m, SC[w * 1056 + n]);
        m = wave_max(m); const float mu = (m == -INFINITY) ? 0.f : m;
        float s = 0.f;
        for (int n = lane; n < N; n += 64) { const float e = __builtin_amdgcn_exp2f(SC[w * 1056 + n] - mu); SC[w * 1056 + n] = e; s += e; }
        s = wave_sum(s); const float inv = s > 0.f ? 1.f / s : 0.f;
        for (int n = lane; n < N; n += 64) SC[w * 1056 + n] *= inv;
    }
    __syncthreads();
    f32x4 acc[4] = {};
    for (int n0 = grp; n0 < NMAIN; n0 += 256) {
        f32x4 vv[8];
#pragma unroll
        for (int u = 0; u < 8; ++u) { const int n = n0 + 32 * u; vv[u] = smp_load<MODE>(C, b, g, n < NMAIN ? n : NMAIN - 1, 1, i, koff); }
#pragma unroll
        for (int u = 0; u < 8; ++u) {
            const int n = n0 + 32 * u;
            if (n < NMAIN) {
#pragma unroll
                for (int h = 0; h < 4; ++h) acc[h] += vv[u] * SC[h * 1056 + n];
            }
        }
    }
    if (MODE != 0 && grp == 0) { const f32x4 vx = ld_bf4(newrow + 64);
#pragma unroll
        for (int h = 0; h < 4; ++h) acc[h] += vx * SC[h * 1056 + NMAIN]; }
#pragma unroll
    for (int h = 0; h < 4; ++h) *(LAS f32x4*)(RED + (grp * 4 + h) * 64 + 4 * i) = acc[h];
    __syncthreads();
    if (tid < 256) { const int h = tid >> 6, d = tid & 63; float s = 0.f;
#pragma unroll 8
        for (int gq = 0; gq < 32; ++gq) s += RED[(gq * 4 + h) * 64 + d];
        const float gate = sigmoidf_(bf2f(WSP(bf16, WS_PROJ)[(size_t)(MPR + b) * NPROJ + C_NG + (4 * g + h) * 3 + MODE]));
        fin += gate * s; }
    __syncthreads();
}
DI void phase_nsa_sample(const Ctx& C) {
    const bf16* P = WSP(bf16, WS_PROJ); bf16* ONSA = WSP(bf16, WS_ONSA);
    LAS float* SC = (LAS float*)C.lds;
    LAS float* RED = SC + 4 * 1056;
    LAS float* IMPS = RED + 32 * 4 * 64;
    LAS float* PSM = IMPS + 8 * 128;
    LAS long* KOFF = (LAS long*)(PSM + 528);
    LAS unsigned* SELW = (LAS unsigned*)(KOFF + 16);
    const int tid = C.tid, i = tid & 15, lane = C.lane, w = C.wave;
    for (int unit = C.bid; unit < NSMP * 4; unit += C.G) {
        const int b = unit >> 2, g = unit & 3; const size_t prow = (size_t)(MPR + b) * NPROJ;
        f32x4 qv[4];
#pragma unroll
        for (int h = 0; h < 4; ++h) qv[h] = ld_bf4(P + prow + C_NQ + (4 * g + h) * 64 + 4 * i);
        float fin = 0.f;
        smp_branch<0>(C, b, g, qv, SC, RED, KOFF, fin);
        for (int n = tid; n < 528; n += 512) { const int nn = n - 4; PSM[n] = (nn >= 0 && nn < 511) ? (SC[nn] + SC[1056 + nn] + SC[2 * 1056 + nn] + SC[3 * 1056 + nn]) : 0.f; }
        __syncthreads();
        for (int j = tid; j < 8 * 128; j += 512) { const int jj = j & 127; const LAS float* ps = PSM + 4 + 4 * jj; IMPS[j] = ps[-1] + 2.f * (ps[0] + ps[1] + ps[2]) + ps[3]; }
        __syncthreads();
        if (w == 0) {
            const int sub = lane & 7; const unsigned bits = topk_select(IMPS, lane, 128);
            unsigned wv = bits << (16 * (sub & 1)); wv |= (unsigned)dpp_i<0xB1>((int)wv);
            if (lane < 8 && (sub & 1) == 0) SELW[sub >> 1] = wv;
        }
        __syncthreads();
        if (tid < 128) { const int j = tid; const unsigned w0 = SELW[0], w1 = SELW[1], w2 = SELW[2], w3 = SELW[3];
            const unsigned mine = j < 32 ? w0 : j < 64 ? w1 : j < 96 ? w2 : w3;
            if ((mine >> (j & 31)) & 1u) {
                int rank = __popc(mine & ((1u << (j & 31)) - 1u)); if (j >= 32) rank += __popc(w0); if (j >= 64) rank += __popc(w1); if (j >= 96) rank += __popc(w2);
                if (rank < 15) KOFF[rank] = ((long)((const int*)C.in[7])[b * NPAGES + (j >> 1)] * PAGE + (j & 1) * 64) * 512 + g * 128; } }
        __syncthreads();
        smp_branch<1>(C, b, g, qv, SC, RED, KOFF, fin);
        smp_branch<2>(C, b, g, qv, SC, RED, KOFF, fin);
        if (tid < 256) ONSA[(size_t)(MPR + b) * DM + (4 * g + (tid >> 6)) * 64 + (tid & 63)] = (bf16)(cvtpk(fin, 0.f) & 0xffffu);
        __syncthreads();
    }
}
constexpr int TD_A = 2 * 64 * KSTR  , TD_PGO = 2 * TD_A;
template <int MODE, int VAR = 0> DI void phase_tdirect(const Ctx& C) {
    const bf16* W1T = WSP(bf16, WS_W1_T); bf16* T = WSP(bf16, WS_T); const bf16* P = WSP(bf16, WS_PROJ);
    const float* cache = C.in[2]; const int* pt = (const int*)C.in[7];
    LAS unsigned* PGO = (LAS unsigned*)(C.lds + TD_PGO);
    const int tid = C.tid, lane = C.lane, w = C.wave, r32 = lane & 31, hh = lane >> 5;
    const int nunits = MODE == 0 ? NSMP * 32 : NBP * 32;
    const int c = w >> 2, n0 = (w & 3) * 64;
    const int ksh = (C.bid * 5) & 15;
#define PSH(p) ((((p) + ksh)) & 15)
    for (int unit = C.bid; unit < nunits; unit += C.G) {
        const int b = unit >> 5, u5 = unit & 31;
        if (MODE == 0) { if (tid < 16) PGO[tid] = ((unsigned)pt[b * NPAGES + 2 * u5 + (tid >> 3)] * PAGE + 16u * (tid & 7)) * 2048u; }
        __syncthreads();
        f32x4 areg[4][4]; v4u aregb[4][2]; bf16x8 wfr[2][2][4];
        const unsigned poff = (unsigned)(((b * SEQ + 256 * u5 + 16 * (tid >> 6)) * NPROJ + C_KC + (tid & 63) * 8) * 2);
        const unsigned woff = (unsigned)(((c * 256 + n0 + r32) * 1024 + 8 * hh) * 2);
        const unsigned aoff0 = (unsigned)((tid & 127) * 16);
        const char* cbase = (const char*)cache; const char* pb = (const char*)P; const char* wb = (const char*)W1T;
#define TD_LOADW(pos, S) do { unsigned wo_ = woff; asm volatile("" : "+v"(wo_)); \
        _Pragma("unroll") for (int nt = 0; nt < 2; ++nt) _Pragma("unroll") for (int ks = 0; ks < 4; ++ks) wfr[S][nt][ks] = *(const bf16x8*)(wb + (wo_ + (unsigned)(nt * 32 * 2048 + PSH(pos) * 128 + ks * 32))); } while (0)
#define TD_LOADA(pos, S) do { \
        if (MODE == 0) { _Pragma("unroll") for (int i = 0; i < 4; ++i) areg[S][i] = *(const f32x4*)(cbase + (PGO[i * 4 + (tid >> 7)] + aoff0 + (unsigned)(PSH(pos) * 2048))); } \
        else { unsigned po_ = poff; asm volatile("" : "+v"(po_)); _Pragma("unroll") for (int i = 0; i < 2; ++i) aregb[S][i] = *(const v4u*)(pb + (po_ + (unsigned)((i * 128 + PSH(pos)) * (NPROJ * 2)))); } } while (0)
#define TD_STOREA(buf, S) do { LAS unsigned char* Ab_ = C.lds + (buf) * TD_A; \
        if (MODE == 0) { _Pragma("unroll") for (int i = 0; i < 4; ++i) { const int ti = i * 4 + (tid >> 7), f4 = tid & 127; v2u o; o.x = cvtpk(areg[S][i][0], areg[S][i][1]); o.y = cvtpk(areg[S][i][2], areg[S][i][3]); \
                *(LAS v2u*)(Ab_ + ((f4 >> 4) & 1) * (64 * KSTR) + ((f4 >> 5) * 16 + ti) * KSTR + (f4 & 15) * 8) = o; } } \
        else { _Pragma("unroll") for (int i = 0; i < 2; ++i) { const int ti = i * 8 + (tid >> 6), ch = tid & 63; *(LAS v4u*)(Ab_ + ((ch >> 3) & 1) * (64 * KSTR) + ((ch >> 4) * 16 + ti) * KSTR + (ch & 7) * 16) = aregb[S][i]; } } } while (0)
        f32x16 acc[2][2];
#pragma unroll
        for (int nt = 0; nt < 2; ++nt)
#pragma unroll
            for (int rt = 0; rt < 2; ++rt) acc[nt][rt] = (f32x16){};
#define TD_STEP(pos, CUR, SN) do { \
            if ((pos) < 15) { TD_LOADW((pos) + 1, (CUR) ^ 1); } \
            asm volatile("" ::: "memory");     \
            if ((pos) < 15) { TD_STOREA((CUR) ^ 1, SN); } \
            asm volatile("" ::: "memory"); \
            if ((pos) < 11) { TD_LOADA((pos) + 5, SN); } \
            asm volatile("" ::: "memory"); \
            const LAS unsigned char* Ac = C.lds + (CUR) * TD_A + c * (64 * KSTR) + r32 * KSTR + 16 * hh; \
            _Pragma("unroll") for (int ks = 0; ks < 4; ++ks) { \
                bf16x8 af[2]; \
                _Pragma("unroll") for (int rt = 0; rt < 2; ++rt) af[rt] = *(const LAS bf16x8*)(Ac + rt * 32 * KSTR + 32 * ks); \
                _Pragma("unroll") for (int nt = 0; nt < 2; ++nt) _Pragma("unroll") for (int rt = 0; rt < 2; ++rt) acc[nt][rt] = MFMA32(wfr[CUR][nt][ks], af[rt], acc[nt][rt]); } \
            __syncthreads(); } while (0)
        TD_LOADW(0, 0); TD_LOADA(0, 0); TD_STOREA(0, 0); TD_LOADA(1, 1); TD_LOADA(2, 2); TD_LOADA(3, 3); TD_LOADA(4, 0);
        __syncthreads();
        for (int pos = 0; pos < 16; pos += 4) { TD_STEP(pos, 0, 1); TD_STEP(pos + 1, 1, 2); TD_STEP(pos + 2, 0, 3); TD_STEP(pos + 3, 1, 0); }
#undef TD_STEP
#undef PSH_DUMMY
#undef TD_LOADA
#undef TD_LOADW
#undef TD_STOREA
        const size_t Rb = (size_t)(MODE == 0 ? 0 : CHK_S) + (size_t)b * 2048 + 16 * u5;
#pragma unroll
        for (int nt = 0; nt < 2; ++nt)
#pragma unroll
            for (int rt = 0; rt < 2; ++rt) {
                const int rr = 32 * rt + r32; bf16* Trow = T + ((size_t)c * CHK_ROWS + Rb + (size_t)(rr >> 4) * 512 + (rr & 15)) * 256 + n0 + 32 * nt + 4 * hh;
#pragma unroll
                for (int m = 0; m < 4; ++m) { v2u o; o.x = cvtpk(acc[nt][rt][4 * m], acc[nt][rt][4 * m + 1]); o.y = cvtpk(acc[nt][rt][4 * m + 2], acc[nt][rt][4 * m + 3]); *(v2u*)(Trow + 8 * m) = o; }
            }
    }
}
#undef PSH

constexpr int TD2_TILE = 256 * 128, TD2_PGO = 131072 + 1024;
DI void phase_tdirect256(const Ctx& C) {
    const bf16* W1T = WSP(bf16, WS_W1_T); bf16* T = WSP(bf16, WS_T);
    const int* pt = (const int*)C.in[7];
    LAS unsigned* PGO = (LAS unsigned*)(C.lds + TD2_PGO);
    const int tid = C.tid, lane = C.lane, w = C.wave, r32 = lane & 31, hh = lane >> 5;
    const int n0 = (w & 3) * 64, row0 = (w >> 2) * 128, fsw = (r32 >> 1) & 7;
    const char* cbase = (const char*)C.in[2]; const char* wb = (const char*)W1T;
    for (int unit = C.bid; unit < NSMP * 16; unit += C.G) {
        const int b = unit >> 4, g = (unit >> 2) & 3, half = (unit >> 1) & 1, c = unit & 1;
        const int R0 = (b * 4 + g) * 512 + 256 * half;
        if (tid < 256) PGO[tid] = ((unsigned)pt[b * NPAGES + 32 * half + (tid >> 3)] * PAGE + 16u * (tid & 7)) * 2048u + (unsigned)((g * 128 + c * 64) * 4);
        __syncthreads();
        f32x4 areg[8]; v4u breg[4];
        const unsigned aoff0 = (unsigned)((tid & 15) * 16);
        const unsigned woff = (unsigned)(((c * 256 + (tid >> 3)) * 1024 + (tid & 7) * 8) * 2);
        const int ajr0 = tid >> 4, ach = (tid & 15) >> 1, asub = (tid & 1) * 8;
        const int bn0 = tid >> 3, bch = tid & 7;
#define T2_LOAD(pos) do { unsigned wo_ = woff; asm volatile("" : "+v"(wo_)); \
        _Pragma("unroll") for (int i = 0; i < 4; ++i) breg[i] = *(const v4u*)(wb + (wo_ + (unsigned)(i * 64 * 2048 + (pos) * 128))); \
        _Pragma("unroll") for (int i = 0; i < 8; ++i) areg[i] = *(const f32x4*)(cbase + (PGO[i * 32 + ajr0] + aoff0 + (unsigned)((pos) * 2048))); } while (0)
#define T2_STORE(buf) do { LAS unsigned char* Ab_ = C.lds + (buf) * TD2_TILE; LAS unsigned char* Bb_ = C.lds + 2 * TD2_TILE + (buf) * TD2_TILE; \
        _Pragma("unroll") for (int i = 0; i < 8; ++i) { const int jr = i * 32 + ajr0; v2u o; o.x = cvtpk(areg[i][0], areg[i][1]); o.y = cvtpk(areg[i][2], areg[i][3]); \
            *(LAS v2u*)(Ab_ + jr * 128 + ((ach ^ ((jr >> 1) & 7)) * 16) + asub) = o; } \
        _Pragma("unroll") for (int i = 0; i < 4; ++i) { const int n = i * 64 + bn0; *(LAS v4u*)(Bb_ + n * 128 + ((bch ^ ((n >> 1) & 7)) * 16)) = breg[i]; } } while (0)
        f32x16 acc[2][4];
#pragma unroll
        for (int nt = 0; nt < 2; ++nt)
#pragma unroll
            for (int rt = 0; rt < 4; ++rt) acc[nt][rt] = (f32x16){};
        T2_LOAD(0); T2_STORE(0); T2_LOAD(1);
        __syncthreads();
        for (int pos = 0; pos < 16; ++pos) {
            const int cur = pos & 1;
            if (pos < 15) { T2_STORE(cur ^ 1); }
            if (pos < 14) { T2_LOAD(pos + 2); }
            const LAS unsigned char* Ac = C.lds + cur * TD2_TILE + (row0 + r32) * 128; const LAS unsigned char* Bc = C.lds + 2 * TD2_TILE + cur * TD2_TILE + (n0 + r32) * 128;
#pragma unroll
            for (int ks = 0; ks < 4; ++ks) {
                const int xo = ((2 * ks + hh) ^ fsw) * 16;
                bf16x8 wf[2], af[4];
#pragma unroll
                for (int nt = 0; nt < 2; ++nt) wf[nt] = *(const LAS bf16x8*)(Bc + nt * 32 * 128 + xo);
#pragma unroll
                for (int rt = 0; rt < 4; ++rt) af[rt] = *(const LAS bf16x8*)(Ac + rt * 32 * 128 + xo);
#pragma unroll
                for (int nt = 0; nt < 2; ++nt)
#pragma unroll
                    for (int rt = 0; rt < 4; ++rt) acc[nt][rt] = MFMA32(wf[nt], af[rt], acc[nt][rt]);
            }
            __syncthreads();
        }
#undef T2_LOAD
#undef T2_STORE
        bf16* Tc = T + ((size_t)c * CHK_ROWS + R0 + row0) * 256;
#pragma unroll
        for (int nt = 0; nt < 2; ++nt)
#pragma unroll
            for (int rt = 0; rt < 4; ++rt)
#pragma unroll
                for (int m = 0; m < 4; ++m) { v2u o; o.x = cvtpk(acc[nt][rt][4 * m], acc[nt][rt][4 * m + 1]); o.y = cvtpk(acc[nt][rt][4 * m + 2], acc[nt][rt][4 * m + 3]);
                    *(v2u*)(Tc + (size_t)(32 * rt + r32) * 256 + n0 + 32 * nt + 8 * m + 4 * hh) = o; }
    }
}
#ifndef MK_ONE_LAUNCH
#define MK_ONE_LAUNCH 1
#endif
#ifndef MK_DUP_MASK
#define MK_DUP_MASK 0
#endif
#ifndef MK_EXP
#define MK_EXP 0
#endif
#ifndef MK_DUPF
#define MK_DUPF 0
#endif
#define DUPF(bit, call) do { call; if constexpr (((MK_DUPF >> (bit)) & 1) != 0) { __syncthreads(); call; } } while (0)
constexpr int N_PHASES = 14;
struct Args { const float* in[33]; float* out; unsigned char* ws; int ph_lo, ph_hi; };
static_assert(sizeof(Args) == 33 * 8 + 8 + 8 + 8, "Args has no padding");

template <class Epi> DI void run_gemm(const Ctx& C, const bf16* A, const bf16* Bt, int M, int N, int K, const Epi& E) {
    pg8::Gemm g{A, Bt, M, N, K}; pg8::StaticOrder S; S.init(M, N, C.G, C.bid);
    pg8::gemm_phase<Epi, pg8::StaticOrder, true, true>(C.lds, g, S, E);
}

template <class Epi> DI void gemm_skinny(const Ctx& C, const bf16* A, const bf16* Bt, int N, int K, const Epi& E) {
    LAS f32x4* red = (LAS f32x4*)C.lds;
    const int lane = C.lane, w = C.wave, ntasks = N / 16, kper = K / 8;
    for (int t = C.bid; t < ntasks; t += C.G) {
        const int col0 = 16 * t;
        const bf16* bp = Bt + (size_t)(col0 + (lane & 15)) * K + w * kper + 8 * (lane >> 4);
        const bf16* ap = A + (size_t)(MPR + (lane & 15)) * K + w * kper + 8 * (lane >> 4);
        f32x4 acc0 = {0.f, 0.f, 0.f, 0.f}, acc1 = acc0;
#pragma unroll 4
        for (int kk = 0; kk < kper; kk += 32) {
            const bf16x8 bw = *(const bf16x8*)(bp + kk), a0 = *(const bf16x8*)(ap + kk), a1 = *(const bf16x8*)(ap + (size_t)16 * K + kk);
            acc0 = __builtin_amdgcn_mfma_f32_16x16x32_bf16(bw, a0, acc0, 0, 0, 0); acc1 = __builtin_amdgcn_mfma_f32_16x16x32_bf16(bw, a1, acc1, 0, 0, 0);
        }
        red[(w * 2 + 0) * 64 + lane] = acc0; red[(w * 2 + 1) * 64 + lane] = acc1;
        __syncthreads();
        if (w == 0) {
            f32x4 v0 = red[lane], v1 = red[64 + lane];
#pragma unroll
            for (int ww = 1; ww < 8; ++ww) { v0 += red[(ww * 2) * 64 + lane]; v1 += red[(ww * 2 + 1) * 64 + lane]; }
            E.e4(MPR + (lane & 15), col0 + 4 * (lane >> 4), v0); E.e4(MPR + 16 + (lane & 15), col0 + 4 * (lane >> 4), v1);
        }
        __syncthreads();
    }
}

__global__ void __launch_bounds__(512, 2) fwd_kernel(Args args) {
    extern __shared__ __attribute__((aligned(16))) unsigned char lds_raw[];
    Ctx C;
    C.lds = (LAS unsigned char*)lds_raw;
    C.tid = threadIdx.x; C.lane = C.tid & 63; C.wave = __builtin_amdgcn_readfirstlane(C.tid >> 6);
    C.G = gridDim.x; C.bid = blockIdx.x;
#pragma unroll
    for (int i = 0; i < 33; ++i) C.in[i] = args.in[i];
    C.out = args.out; C.ws = args.ws;
    volatile LAS unsigned* MISC = (volatile LAS unsigned*)(C.lds + MISC_OFF);
    if (C.tid < 32) MISC[C.tid] = 0u;
    __syncthreads();
    XcdBarrier bar; bar.bar = (unsigned*)(args.ws + WS_CTL) + CW_BAR; bar.x = 0; bar.st = nullptr;
    if (MK_ONE_LAUNCH) bar = xcd_barrier_post((unsigned*)(args.ws + WS_CTL) + CW_BAR, MISC + 8);
    const int lo = args.ph_lo, hi = args.ph_hi;
#define IN(k) (lo <= (k) && (k) < hi)
#define SEAM(k) do { if (IN(k) && IN((k) + 1)) { if (MK_ONE_LAUNCH) xcd_barrier(bar); } } while (0)

#define PH(k, ...) do { if (IN(k)) { __VA_ARGS__; if constexpr (((MK_DUP_MASK >> (k)) & 1) != 0) { __syncthreads(); __VA_ARGS__; } } SEAM(k); } while (0)
    PH(0, phase_prologue(C); __syncthreads());
    PH(1, { pg8::EpiProj E{WSP(bf16, WS_PROJ), C.out}; run_gemm(C, WSP(bf16, WS_XN), WSP(bf16, WS_WIN_T), MP, NPROJ, DM, E); } __syncthreads();
          { pg8::EpiStore<false> E{WSP(bf16, WS_PP), DM, nullptr}; run_gemm(C, WSP(bf16, WS_PB), WSP(bf16, WS_WPP_T), MPR, DM, PLE, E); __syncthreads(); gemm_skinny(C, WSP(bf16, WS_PB), WSP(bf16, WS_WPP_T), DM, PLE, E); });
    PH(2, DUPF(6, phase_tdirect256(C)); __syncthreads(); phase_tdirect<1>(C); __syncthreads(); DUPF(2, phase_g1(C)); __syncthreads(); DUPF(3, phase_attn_sw<2>(C)); __syncthreads(); DUPF(4, phase_gla_sample(C)); __syncthreads());
    PH(3, DUPF(5, phase_g2(C)); __syncthreads(); DUPF(7, phase_kvc(C)); __syncthreads());
    PH(4, DUPF(8, phase_g3(C)); __syncthreads(); DUPF(0, phase_attn_cmp(C)); __syncthreads(); DUPF(1, phase_nsa_sample(C)); __syncthreads());
    PH(5, { pg8::EpiStore<false> E{WSP(bf16, WS_YG), DM, nullptr}; run_gemm(C, WSP(bf16, WS_OG), WSP(bf16, WS_WGO_T), MPR, DM, DM, E); __syncthreads(); gemm_skinny(C, WSP(bf16, WS_OG), WSP(bf16, WS_WGO_T), DM, DM, E); } __syncthreads();
          DUPF(9, phase_attn_sw<1>(C)); __syncthreads());
    PH(6, { pg8::EpiMix E{WSP(bf16, WS_PROJ), WSP(bf16, WS_YG), WSP(bf16, WS_MIX)}; run_gemm(C, WSP(bf16, WS_ONSA), WSP(bf16, WS_WNO_T), MPR, DM, DM, E); __syncthreads(); gemm_skinny(C, WSP(bf16, WS_ONSA), WSP(bf16, WS_WNO_T), DM, DM, E); });
    PH(7, { pg8::EpiF32 E{WSP(float, WS_T1), DM}; run_gemm(C, WSP(bf16, WS_MIX), WSP(bf16, WS_WOUT_T), MPR, DM, DM, E); __syncthreads(); gemm_skinny(C, WSP(bf16, WS_MIX), WSP(bf16, WS_WOUT_T), DM, DM, E); });
    PH(8, phase_rownorm(C, WSP(float, WS_T1), C.in[0], C.in[1], C.in[11], C.in[12], WSP(float, WS_X1), WSP(bf16, WS_XN)));
    PH(9, { pg8::EpiStore<true> E{WSP(bf16, WS_UP), NUP, C.out}; run_gemm(C, WSP(bf16, WS_XN), WSP(bf16, WS_WUP_T), MP, NUP, DM, E); });
    PH(10, phase_conv(C));
    PH(11, { pg8::EpiF32 E{WSP(float, WS_T1), DM}; run_gemm(C, WSP(bf16, WS_H), WSP(bf16, WS_WDN_T), MPR, DM, DFF, E); __syncthreads(); gemm_skinny(C, WSP(bf16, WS_H), WSP(bf16, WS_WDN_T), DM, DFF, E); });
    PH(12, phase_rownorm(C, WSP(float, WS_T1), WSP(float, WS_X1), WSP(float, WS_X1) + (size_t)MPR * DM, C.in[13], C.in[14], WSP(float, WS_X2), WSP(bf16, WS_XN)));
    if (IN(13)) { pg8::EpiFinal E{WSP(float, WS_X2), WSP(bf16, WS_PP), C.out}; run_gemm(C, WSP(bf16, WS_XN), WSP(bf16, WS_WPG_T), MPR, DM, DM, E); __syncthreads(); gemm_skinny(C, WSP(bf16, WS_XN), WSP(bf16, WS_WPG_T), DM, DM, E); }
#undef PH
#undef IN
#undef SEAM
}

extern "C" void kernel_launch(void* const* d_in, const int* in_sizes, int n_in, void* d_out, int out_size, void* d_ws, size_t ws_size, hipStream_t stream) {
    static int grid = 0;
    if (grid == 0) {
        if (n_in != 33 || (size_t)out_size != O_END || ws_size < WS_END) { fprintf(stderr, "kernel_launch: unexpected shapes (n_in %d, out %d, ws %zu, need %zu)\n", n_in, out_size, ws_size, (size_t)WS_END); grid = -1; return; }
        int dev = 0, cus = 0, per_cu = 0;
        if (hipGetDevice(&dev) != hipSuccess || hipDeviceGetAttribute(&cus, hipDeviceAttributeMultiprocessorCount, dev) != hipSuccess) { grid = -1; return; }
        if (hipFuncSetAttribute((const void*)fwd_kernel, hipFuncAttributeMaxDynamicSharedMemorySize, LDS_BYTES) != hipSuccess) { fprintf(stderr, "kernel_launch: hipFuncSetAttribute failed\n"); grid = -1; return; }
        if (hipOccupancyMaxActiveBlocksPerMultiprocessor(&per_cu, (const void*)fwd_kernel, 512, LDS_BYTES) != hipSuccess || per_cu < 1) fprintf(stderr, "kernel_launch: occupancy query says %d\n", per_cu);
        (void)hipGetLastError();
        grid = cus;
    }
    if (grid < 0) return;
    (void)hipMemsetAsync((char*)d_ws + WS_CTL, 0, CTL_BYTES, stream);
    Args a{};
    for (int i = 0; i < 33; ++i) a.in[i] = (const float*)d_in[i];
    a.out = (float*)d_out; a.ws = (unsigned char*)d_ws;
#if MK_ONE_LAUNCH
    a.ph_lo = 0; a.ph_hi = N_PHASES;
    hipLaunchKernelGGL(fwd_kernel, dim3(grid), dim3(512), LDS_BYTES, stream, a);
#else
    for (int p = 0; p < N_PHASES; ++p) { a.ph_lo = p; a.ph_hi = p + 1; hipLaunchKernelGGL(fwd_kernel, dim3(grid), dim3(512), LDS_BYTES, stream, a); }
#endif
    const hipError_t le = hipPeekAtLastError();
    if (le != hipSuccess) fprintf(stderr, "kernel_launch: launch failed: %s\n", hipGetErrorName(le));
}
```
